# Optimizing an MI355X kernel written in HIP

```python
import jax
import jax.numpy as jnp
from jax import lax
import numpy as np

D_MODEL = 1024
BATCH = 16
SEQ = 256
DEPTH = 4
DEC_BATCH = 8
DEC_SEQ = 1024
PAST_LEN = 256

GRID_W = 64
HEAD_DIM = 64
NA_HEADS = 4
GQA_Q_HEADS = 8
GQA_KV_HEADS = 2
MLSTM_HEADS = 4
NA_WIN_ROWS = 8
NA_WIN_COLS = 16
Q_BLOCK = 128
MLSTM_CHUNK = 64
ROPE_BASE = 10000.0
EPS = 1e-6
NEG = -1e30
NA_W = NA_HEADS * HEAD_DIM
GQA_QW = GQA_Q_HEADS * HEAD_DIM
GQA_KW = GQA_KV_HEADS * HEAD_DIM
ML_W = MLSTM_HEADS * HEAD_DIM
N_GATES = 4 * MLSTM_HEADS
MIX_WIDTH = NA_W + GQA_QW + ML_W
IN_SIZES = (NA_W, NA_W, NA_W, GQA_QW, GQA_KW, GQA_KW, ML_W, ML_W, ML_W, ML_W, N_GATES)
IN_WIDTH = 3 * NA_W + GQA_QW + 2 * GQA_KW + 4 * ML_W + N_GATES
FF_HIDDEN = ((8 * D_MODEL + 3 * 256 - 1) // (3 * 256)) * 256

kernel_name = 'hybrid_na_gqa_mlstm_diffusion_step'


def rms_norm(x, g):
    xf = x.astype(jnp.float32)
    y = xf * lax.rsqrt(jnp.mean(xf * xf, axis=-1, keepdims=True) + EPS)
    return (y * g.astype(jnp.float32)).astype(x.dtype)


def modulate(h, shift, scale):
    return h * (1 + scale) + shift


def adaln(cvec, w, b):
    mod = jnp.einsum('nd,de->ne', jax.nn.silu(cvec), w) + b
    return jnp.split(mod[:, None, :], 6, axis=-1)


def split_heads(x, n_heads):
    B, T, _ = x.shape
    return x.reshape(B, T, n_heads, HEAD_DIM).transpose(0, 2, 1, 3)


def merge_heads(x):
    B, H, T, d = x.shape
    return x.transpose(0, 2, 1, 3).reshape(B, T, H * d)


def rope_2d(x):
    T = x.shape[2]
    half = HEAD_DIM // 2
    quarter = half // 2
    inv = 1.0 / (ROPE_BASE ** (jnp.arange(quarter, dtype=jnp.float32) / quarter))
    t = jnp.arange(T)
    row = (t // GRID_W).astype(jnp.float32)
    col = (t % GRID_W).astype(jnp.float32)

    def rot(xh, pos):
        ang = pos[:, None] * inv[None, :]
        cos, sin = jnp.cos(ang), jnp.sin(ang)
        x1 = xh[..., :quarter].astype(jnp.float32)
        x2 = xh[..., quarter:].astype(jnp.float32)
        return jnp.concatenate([x1 * cos - x2 * sin, x2 * cos + x1 * sin], axis=-1)

    out = jnp.concatenate([rot(x[..., :half], row), rot(x[..., half:], col)], axis=-1)
    return out.astype(x.dtype)


def block_attention(q, k, v):
    B, Hq, T, d = q.shape
    Hk = k.shape[1]
    G = Hq // Hk
    NB = T // Q_BLOCK
    qb = q.reshape(B, Hk, G, NB, Q_BLOCK, d).transpose(3, 0, 1, 2, 4, 5)
    scale = d ** -0.5

    def one_block(qi):
        s = jnp.einsum('bhgqd,bhkd->bhgqk', qi, k).astype(jnp.float32) * scale
        p = jax.nn.softmax(s, axis=-1).astype(v.dtype)
        return jnp.einsum('bhgqk,bhkd->bhgqd', p, v)

    o = lax.map(one_block, qb)
    return o.transpose(1, 2, 3, 0, 4, 5).reshape(B, Hq, T, d)


def na_geometry(rows):
    kr = min(NA_WIN_ROWS, rows)
    r = np.arange(rows)
    r0 = np.clip(r - kr // 2, 0, rows - kr)
    row_idx = r0[:, None] + np.arange(kr)[None, :]
    cq = np.arange(GRID_W)
    c0 = np.clip(cq - NA_WIN_COLS // 2, 0, GRID_W - NA_WIN_COLS)
    col_mask = (cq[None, :] >= c0[:, None]) & (cq[None, :] < c0[:, None] + NA_WIN_COLS)
    dr = row_idx - r[:, None] + NA_WIN_ROWS - 1
    dc = np.clip(cq[None, :] - cq[:, None], -(NA_WIN_COLS - 1), NA_WIN_COLS - 1) + NA_WIN_COLS - 1
    return row_idx, col_mask, dr, dc


def na_latent(q, k, v, kc, vc, bias_table):
    B, H, T, d = q.shape
    rows = T // GRID_W
    row_idx, col_mask, dr, dc = na_geometry(rows)
    kr = row_idx.shape[1]
    scale = d ** -0.5
    qg = q.reshape(B, H, rows, GRID_W, d)
    kg = k.reshape(B, H, rows, GRID_W, d)[:, :, row_idx]
    vg = v.reshape(B, H, rows, GRID_W, d)[:, :, row_idx]
    s_win = jnp.einsum('bhrqd,bhrkwd->bhrqkw', qg, kg).astype(jnp.float32) * scale
    bias = bias_table[:, dr[:, :, None, None], dc[None, None, :, :]].transpose(0, 1, 3, 2, 4)
    s_win = jnp.where(col_mask[:, None, :], s_win + bias.astype(jnp.float32), NEG)
    s_ctx = jnp.einsum('bhrqd,bhld->bhrql', qg, kc).astype(jnp.float32) * scale
    nw = kr * GRID_W
    s = jnp.concatenate([s_win.reshape(B, H, rows, GRID_W, nw), s_ctx], axis=-1)
    p = jax.nn.softmax(s, axis=-1).astype(v.dtype)
    p_win = p[..., :nw].reshape(B, H, rows, GRID_W, kr, GRID_W)
    o = (jnp.einsum('bhrqkw,bhrkwd->bhrqd', p_win, vg)
         + jnp.einsum('bhrql,bhld->bhrqd', p[..., nw:], vc))
    return o.reshape(B, H, T, d)


def mlstm_scan(q, k, v, log_i, log_f, C0, n0, m0):
    B, H, T, d = q.shape
    L = MLSTM_CHUNK
    NC = T // L
    to_chunks = lambda x: jnp.moveaxis(x.reshape(B, H, NC, L, *x.shape[3:]), 2, 0)
    causal = jnp.tril(jnp.ones((L, L), dtype=bool))

    def chunk_step(carry, inp):
        C, n, m = carry
        qc, kc, vc, ic, fc = inp
        b = jnp.cumsum(fc, axis=-1)
        logw = jnp.where(causal, b[..., :, None] - b[..., None, :] + ic[..., None, :], -jnp.inf)
        m_inter = b + m[..., None]
        m_t = jnp.maximum(jnp.max(logw, axis=-1), m_inter)
        w = jnp.exp(logw - m_t[..., None])
        s = jnp.einsum('bhtk,bhsk->bhts', qc, kc) * w
        decay = jnp.exp(m_inter - m_t)
        num = (jnp.einsum('bhts,bhsv->bhtv', s, vc)
               + decay[..., None] * jnp.einsum('bhvk,bhtk->bhtv', C, qc))
        den = jnp.sum(s, axis=-1) + decay * jnp.einsum('bhk,bhtk->bht', n, qc)
        h = num / jnp.maximum(jnp.abs(den), jnp.exp(-m_t))[..., None]
        b_end = b[..., -1]
        logw_end = b_end[..., None] - b + ic
        m_new = jnp.maximum(b_end + m, jnp.max(logw_end, axis=-1))
        w_end = jnp.exp(logw_end - m_new[..., None])
        carry_decay = jnp.exp(b_end + m - m_new)
        C_new = carry_decay[..., None, None] * C + jnp.einsum('bhs,bhsv,bhsk->bhvk', w_end, vc, kc)
        n_new = carry_decay[..., None] * n + jnp.einsum('bhs,bhsk->bhk', w_end, kc)
        return (C_new, n_new, m_new), h

    xs = (to_chunks(q), to_chunks(k), to_chunks(v), to_chunks(log_i), to_chunks(log_f))
    (C, n, m), hs = lax.scan(chunk_step, (C0, n0, m0), xs)
    h = jnp.moveaxis(hs, 0, 2).reshape(B, H, T, d)
    return h, (C, n, m)


def mlstm_bidir(q, k, v, gates, st_fwd, st_bwd):
    B, T, _ = gates.shape
    g = gates.astype(jnp.float32).reshape(B, T, 4, MLSTM_HEADS).transpose(2, 0, 3, 1)
    f32 = lambda st: tuple(s.astype(jnp.float32) for s in st)
    h_f, fin_f = mlstm_scan(q, k, v, g[0], jax.nn.log_sigmoid(g[1]), *f32(st_fwd))
    flip = lambda x: jnp.flip(x, axis=2)
    h_b, fin_b = mlstm_scan(flip(q), flip(k), flip(v), flip(g[2]), flip(jax.nn.log_sigmoid(g[3])), *f32(st_bwd))
    return h_f + flip(h_b), fin_f, fin_b


def mlstm_output(h, o_pre, gain):
    B, H, T, d = h.shape
    hf = h.transpose(0, 2, 1, 3)
    hn = hf * lax.rsqrt(jnp.mean(hf * hf, axis=-1, keepdims=True) + EPS) * gain.reshape(H, d).astype(jnp.float32)
    return (hn.reshape(B, T, H * d) * jax.nn.sigmoid(o_pre.astype(jnp.float32))).astype(o_pre.dtype)


def token_mixers(h, w_in_l, b_gates_l, w_out_l, g_qk_l, g_ml_l, na_bias_l, ctx):
    offs = [int(o) for o in np.cumsum(IN_SIZES)[:-1]]
    z = jnp.einsum('btd,de->bte', h, w_in_l)
    nq, nk, nv, gq, gk, gv, mq, mk, mv, mo, mg = jnp.split(z, offs, axis=-1)
    mg = mg + b_gates_l
    nq, nk, nv = split_heads(nq, NA_HEADS), split_heads(nk, NA_HEADS), split_heads(nv, NA_HEADS)
    gq = rms_norm(split_heads(gq, GQA_Q_HEADS), g_qk_l[0])
    gk = rms_norm(split_heads(gk, GQA_KV_HEADS), g_qk_l[1])
    gv = split_heads(gv, GQA_KV_HEADS)
    mq = split_heads(mq, MLSTM_HEADS).astype(jnp.float32)
    mk = split_heads(mk, MLSTM_HEADS).astype(jnp.float32) * (HEAD_DIM ** -0.5)
    mv = split_heads(mv, MLSTM_HEADS).astype(jnp.float32)
    B = h.shape[0]
    if ctx is None:
        o_na = block_attention(nq, nk, nv)
        o_gqa = block_attention(gq, gk, gv)
        zero = (jnp.zeros((B, MLSTM_HEADS, HEAD_DIM, HEAD_DIM), jnp.float32),
                jnp.zeros((B, MLSTM_HEADS, HEAD_DIM), jnp.float32),
                jnp.zeros((B, MLSTM_HEADS), jnp.float32))
        st_f0, st_b0 = zero, zero
    else:
        na_kv, gqa_kv, C, n, m = ctx
        o_na = na_latent(nq, nk, nv, na_kv[:, 0], na_kv[:, 1], na_bias_l)
        k_all = jnp.concatenate([rope_2d(gk), gqa_kv[:, 0].astype(gk.dtype)], axis=2)
        v_all = jnp.concatenate([gv, gqa_kv[:, 1].astype(gv.dtype)], axis=2)
        o_gqa = block_attention(rope_2d(gq), k_all, v_all)
        st_f0 = (C[:, 0], n[:, 0], m[:, 0])
        st_b0 = (C[:, 1], n[:, 1], m[:, 1])
    h_ml, fin_f, fin_b = mlstm_bidir(mq, mk, mv, mg, st_f0, st_b0)
    o_ml = mlstm_output(h_ml, mo, g_ml_l)
    mix = jnp.concatenate([merge_heads(o_na), merge_heads(o_gqa), o_ml], axis=-1)
    out = jnp.einsum('bte,ed->btd', mix, w_out_l)
    if ctx is None:
        new_ctx = (jnp.stack([nk, nv], axis=1), jnp.stack([gk, gv], axis=1),
                   jnp.stack([fin_f[0], fin_b[0]], axis=1), jnp.stack([fin_f[1], fin_b[1]], axis=1),
                   jnp.stack([fin_f[2], fin_b[2]], axis=1))
    else:
        new_ctx = None
    return out, new_ctx


def swiglu(h, w_gu, w_down):
    gate, up = jnp.split(jnp.einsum('btd,df->btf', h, w_gu), 2, axis=-1)
    return jnp.einsum('btf,fd->btd', jax.nn.silu(gate) * up, w_down)


def trunk_layer(x, mods, mixer_w, g_norm_l, w_gu_l, w_down_l, ctx):
    sh1, sc1, ga1, sh2, sc2, ga2 = mods
    h = modulate(rms_norm(x, g_norm_l[0]), sh1, sc1)
    mix, new_ctx = token_mixers(h, *mixer_w, ctx)
    x = x + ga1 * rms_norm(mix, g_norm_l[1])
    f = swiglu(modulate(rms_norm(x, g_norm_l[2]), sh2, sc2), w_gu_l, w_down_l)
    x = x + ga2 * rms_norm(f, g_norm_l[3])
    return x, new_ctx


def setup_inputs(seed: int = 0) -> dict:
    key = jax.random.key(seed)
    ks = jax.random.split(key, 20)
    nrm = lambda k, shape, s: jax.random.normal(k, shape, jnp.float32) * s
    gate_offset = jnp.array([0.0, 3.0, 0.0, 3.0], jnp.float32)[None, :, None]
    return {
        'x_prompt': nrm(ks[0], (BATCH, SEQ, D_MODEL), 1.0),
        'x_sample': nrm(ks[1], (DEC_BATCH, DEC_SEQ, D_MODEL), 1.0),
        'cache_na_kv': nrm(ks[2], (DEC_BATCH, DEPTH, 2, NA_HEADS, PAST_LEN, HEAD_DIM), 1.0),
        'cache_gqa_kv': nrm(ks[3], (DEC_BATCH, DEPTH, 2, GQA_KV_HEADS, PAST_LEN, HEAD_DIM), 1.0),
        'state_mlstm_C': nrm(ks[4], (DEC_BATCH, DEPTH, 2, MLSTM_HEADS, HEAD_DIM, HEAD_DIM), HEAD_DIM ** -0.5),
        'state_mlstm_n': nrm(ks[5], (DEC_BATCH, DEPTH, 2, MLSTM_HEADS, HEAD_DIM), 0.5),
        'state_mlstm_m': nrm(ks[6], (DEC_BATCH, DEPTH, 2, MLSTM_HEADS), 1.0),
        'c': nrm(ks[7], (DEC_BATCH, D_MODEL), 1.0),
        'c_ctx': nrm(ks[8], (D_MODEL,), 1.0),
        'w_in': nrm(ks[9], (DEPTH, D_MODEL, IN_WIDTH), D_MODEL ** -0.5),
        'b_gates': (nrm(ks[10], (DEPTH, 4, MLSTM_HEADS), 0.1) + gate_offset).reshape(DEPTH, N_GATES),
        'w_out': nrm(ks[11], (DEPTH, MIX_WIDTH, D_MODEL), MIX_WIDTH ** -0.5),
        'g_norm': 1.0 + nrm(ks[12], (DEPTH, 4, D_MODEL), 0.02),
        'g_qk': 1.0 + nrm(ks[13], (DEPTH, 2, HEAD_DIM), 0.02),
        'g_mlstm': 1.0 + nrm(ks[14], (DEPTH, ML_W), 0.02),
        'na_bias': nrm(ks[15], (DEPTH, NA_HEADS, 2 * NA_WIN_ROWS - 1, 2 * NA_WIN_COLS - 1), 0.02),
        'w_ada': nrm(ks[16], (DEPTH, D_MODEL, 6 * D_MODEL), 0.5 * D_MODEL ** -0.5),
        'b_ada': nrm(ks[17], (DEPTH, 6 * D_MODEL), 0.02),
        'w_gu': nrm(ks[18], (DEPTH, D_MODEL, 2 * FF_HIDDEN), D_MODEL ** -0.5),
        'w_down': nrm(ks[19], (DEPTH, FF_HIDDEN, D_MODEL), FF_HIDDEN ** -0.5),
    }


def reference(x_prompt, x_sample, cache_na_kv, cache_gqa_kv, state_mlstm_C, state_mlstm_n, state_mlstm_m,
              c, c_ctx, w_in, b_gates, w_out, g_norm, g_qk, g_mlstm, na_bias, w_ada, b_ada, w_gu, w_down):
    xp, xs = x_prompt, x_sample
    na_l, gqa_l, C_l, n_l, m_l = [], [], [], [], []
    for l in range(DEPTH):
        mixer_w = (w_in[l], b_gates[l], w_out[l], g_qk[l], g_mlstm[l], na_bias[l])
        xp, (na_kv, gqa_kv, Cs, ns, ms) = trunk_layer(
            xp, adaln(c_ctx[None, :], w_ada[l], b_ada[l]), mixer_w, g_norm[l], w_gu[l], w_down[l], None)
        na_l.append(na_kv)
        gqa_l.append(gqa_kv)
        C_l.append(Cs)
        n_l.append(ns)
        m_l.append(ms)
        ctx = (cache_na_kv[:, l], cache_gqa_kv[:, l], state_mlstm_C[:, l], state_mlstm_n[:, l], state_mlstm_m[:, l])
        xs, _ = trunk_layer(xs, adaln(c, w_ada[l], b_ada[l]), mixer_w, g_norm[l], w_gu[l], w_down[l], ctx)
    new_na_kv = jnp.stack(na_l, axis=1)
    new_gqa_kv = jnp.stack(gqa_l, axis=1)
    new_C = jnp.stack(C_l, axis=1)
    new_n = jnp.stack(n_l, axis=1)
    new_m = jnp.stack(m_l, axis=1)
    return (xp, xs, new_na_kv, new_gqa_kv, new_C, new_n, new_m)
```

```cpp
#include <hip/hip_runtime.h>
#include <hip/hip_cooperative_groups.h>
#include <stdint.h>
#include <stdio.h>
namespace cg = cooperative_groups;

#ifndef ONE_LAUNCH
#define ONE_LAUNCH 0
#endif

#define DI __device__ __forceinline__
typedef unsigned short u16;
typedef __attribute__((ext_vector_type(8))) short bf16x8;
typedef __attribute__((ext_vector_type(4))) float f32x4;

constexpr int TP = 4096, TS = 8192, TT = 12288, ZW = 2560, NIN = 2688, FF = 2816;
constexpr float EPS = 1e-6f;
constexpr size_t O_YP = 0, O_NA = 12582912, O_GQA = 20971520, O_C = 25165824, O_N = 27262976, O_M = 27295744;
constexpr int SMEM_BYTES = 73728;

struct P {
  const float *x_prompt, *x_sample, *cache_na, *cache_gqa, *stC, *stn, *stm, *c, *c_ctx, *w_in, *b_gates, *w_out,
      *g_norm, *g_qk, *g_ml, *na_bias, *w_ada, *b_ada, *w_gu, *w_down;
  float* out;
  u16 *wt_in, *wt_out, *wt_gu, *wt_down;
  float *mods, *rope;
  u16 *kc_na, *vct_na, *kc_gqa, *vct_gqa;
  u16 *hn, *zb, *act, *vt_na, *vt_gqa, *kt_ml, *vt_ml, *mix;
  float *gates, *obuf;
  float *ml_chat, *ml_nhat, *ml_ab, *ml_nst, *ml_mst;
  u16* ml_cst;
};

DI u16 f2bf(float x) { unsigned u = __float_as_uint(x); u += 0x7fffu + ((u >> 16) & 1u); return (u16)(u >> 16); }
DI float bf2f(u16 h) { return __uint_as_float(((unsigned)h) << 16); }
DI unsigned pack2(float a, float b) { return (unsigned)f2bf(a) | ((unsigned)f2bf(b) << 16); }
DI float wave_sum(float v) { for (int o = 32; o >= 1; o >>= 1) v += __shfl_xor(v, o); return v; }
DI float wave_max(float v) { for (int o = 32; o >= 1; o >>= 1) v = fmaxf(v, __shfl_xor(v, o)); return v; }
DI void wave_sync() { __builtin_amdgcn_fence(__ATOMIC_RELEASE, "wavefront"); __builtin_amdgcn_wave_barrier(); __builtin_amdgcn_fence(__ATOMIC_ACQUIRE, "wavefront"); }
#define MFMA16(a, b, c) __builtin_amdgcn_mfma_f32_16x16x32_bf16((a), (b), (c), 0, 0, 0)
DI bf16x8 ld8(const u16* p) { return *(const bf16x8*)p; }
DI bf16x8 ld4x2(const u16* p0, const u16* p1) {
  uint2 a = *(const uint2*)p0, b = *(const uint2*)p1;
  uint4 r; r.x = a.x; r.y = a.y; r.z = b.x; r.w = b.y;
  return __builtin_bit_cast(bf16x8, r);
}
DI bf16x8 pack8(const f32x4& a, const f32x4& b) {
  uint4 r; r.x = pack2(a[0], a[1]); r.y = pack2(a[2], a[3]); r.z = pack2(b[0], b[1]); r.w = pack2(b[2], b[3]);
  return __builtin_bit_cast(bf16x8, r);
}
DI f32x4 zero4() { f32x4 z = {0.f, 0.f, 0.f, 0.f}; return z; }

DI size_t vt_index(int row, int H, int h, int d) {
  if (row < TP) { int b = row >> 8, t = row & 255; return ((size_t)((b * H + h) * 64 + d)) * 256 + t; }
  int r = row - TP; int b = r >> 10, t = r & 1023;
  return (size_t)16 * H * 64 * 256 + ((size_t)((b * H + h) * 64 + d)) * 1024 + t;
}

DI void transpose_tile(const float* __restrict__ src, int ldsrc, int k0, int n0, int mode, int nvalid,
                       u16* __restrict__ dst, int ldd, float* tile) {
  const int tid = threadIdx.x;
  const int nn = tid & 63, kq = tid >> 6;
  int rr = n0 + nn, col;
  if (mode == 1) {
    int jt = rr >> 7, c = rr & 127, wn = c >> 6, sub = (c & 63) >> 4, idx = c & 15;
    col = jt * 64 + wn * 32 + (sub >> 1) * 16 + idx + (sub & 1) * FF;
  } else col = rr < nvalid ? rr : -1;
#pragma unroll
  for (int i = 0; i < 16; ++i) {
    int kk = i * 4 + kq;
    tile[kk * 65 + nn] = col >= 0 ? src[(size_t)(k0 + kk) * ldsrc + col] : 0.f;
  }
  __syncthreads();
  const int k2 = (tid & 31) * 2, nq = tid >> 5;
#pragma unroll
  for (int i = 0; i < 8; ++i) {
    int n = i * 8 + nq;
    *(unsigned*)(dst + (size_t)(n0 + n) * ldd + k0 + k2) = pack2(tile[k2 * 65 + n], tile[(k2 + 1) * 65 + n]);
  }
  __syncthreads();
}

DI void phase_init(const P& p, char* smem) {
  float* tile = (float*)smem;
  const int tid = threadIdx.x;
  const int NTR = 12160, NCV = 768, NADA = 384;
  const int total = NTR + NCV + NADA + 1;
  for (int it = blockIdx.x; it < total; it += gridDim.x) {
    if (it < NTR) {
      int l = it / 3040, r = it % 3040;
      if (r < 672) {
        int kt = r / 42, nt = r % 42;
        transpose_tile(p.w_in + (size_t)l * 1024 * 2576, 2576, kt * 64, nt * 64, 0, 2576, p.wt_in + (size_t)l * NIN * 1024, 1024, tile);
      } else if (r < 928) {
        int x = r - 672, kt = x / 16, nt = x % 16;
        transpose_tile(p.w_out + (size_t)l * 1024 * 1024, 1024, kt * 64, nt * 64, 0, 1024, p.wt_out + (size_t)l * 1024 * 1024, 1024, tile);
      } else if (r < 2336) {
        int x = r - 928, kt = x / 88, nt = x % 88;
        transpose_tile(p.w_gu + (size_t)l * 1024 * 5632, 5632, kt * 64, nt * 64, 1, 5632, p.wt_gu + (size_t)l * 5632 * 1024, 1024, tile);
      } else {
        int x = r - 2336, kt = x / 16, nt = x % 16;
        transpose_tile(p.w_down + (size_t)l * FF * 1024, 1024, kt * 64, nt * 64, 0, 1024, p.wt_down + (size_t)l * 1024 * FF, FF, tile);
      }
    } else if (it < NTR + NCV) {
      int it2 = it - NTR;
      if (it2 < 512) {
        int idx = it2 >> 2, tt = it2 & 3, bl = idx >> 2, h = idx & 3;
        transpose_tile(p.cache_na + (size_t)((bl * 2 + 1) * 4 + h) * 16384, 64, tt * 64, 0, 0, 64, p.vct_na + (size_t)idx * 16384, 256, tile);
      } else {
        int it3 = it2 - 512;
        int idx = it3 >> 2, tt = it3 & 3, bl = idx >> 1, h = idx & 1;
        transpose_tile(p.cache_gqa + (size_t)((bl * 2 + 1) * 2 + h) * 16384, 64, tt * 64, 0, 0, 64, p.vct_gqa + (size_t)idx * 16384, 256, tile);
      }
    } else if (it < NTR + NCV + NADA) {
      int ia = it - NTR - NCV;
      int l = ia / 96, colbase = (ia % 96) * 64;
      float* sl = (float*)smem;
      for (int i = tid; i < 9 * 1024; i += 256) {
        int n = i >> 10, d = i & 1023;
        float cv = n == 0 ? p.c_ctx[d] : p.c[(n - 1) * 1024 + d];
        sl[i] = cv / (1.f + __expf(-cv));
      }
      __syncthreads();
      const int col = tid & 63, kg = tid >> 6;
      float acc[9];
#pragma unroll
      for (int n = 0; n < 9; ++n) acc[n] = 0.f;
      const float* w = p.w_ada + ((size_t)l * 1024 + kg * 256) * 6144 + colbase + col;
#pragma unroll 4
      for (int k = 0; k < 256; ++k) {
        float wv = w[(size_t)k * 6144];
#pragma unroll
        for (int n = 0; n < 9; ++n) acc[n] += sl[n * 1024 + kg * 256 + k] * wv;
      }
      float* red = sl + 9216;
#pragma unroll
      for (int n = 0; n < 9; ++n) red[(kg * 9 + n) * 64 + col] = acc[n];
      __syncthreads();
      for (int i = tid; i < 576; i += 256) {
        int n = i >> 6, cc = i & 63;
        float s = red[(0 * 9 + n) * 64 + cc] + red[(1 * 9 + n) * 64 + cc] + red[(2 * 9 + n) * 64 + cc] + red[(3 * 9 + n) * 64 + cc];
        p.mods[(size_t)(l * 9 + n) * 6144 + colbase + cc] = s + p.b_ada[l * 6144 + colbase + cc];
      }
      __syncthreads();
    } else {
      for (int i = tid; i < 1024; i += 256) {
        int pos = i >> 4, fi = i & 15;
        float inv = __builtin_amdgcn_exp2f(-(float)fi * 0.8304820237f);
        float ang = (float)pos * inv;
        p.rope[i] = __cosf(ang);
        p.rope[1024 + i] = __sinf(ang);
      }
    }
  }
  const int gtid = blockIdx.x * 256 + tid, gsz = gridDim.x * 256;
  for (int i = gtid; i < 128 * 4096; i += gsz) {
    int idx = i >> 12, e = (i & 4095) * 4, bl = idx >> 2, h = idx & 3;
    float4 v = *(const float4*)(p.cache_na + (size_t)((bl * 2 + 0) * 4 + h) * 16384 + e);
    uint2 o; o.x = pack2(v.x, v.y); o.y = pack2(v.z, v.w);
    *(uint2*)(p.kc_na + (size_t)idx * 16384 + e) = o;
  }
  for (int i = gtid; i < 64 * 4096; i += gsz) {
    int idx = i >> 12, e = (i & 4095) * 4, bl = idx >> 1, h = idx & 1;
    float4 v = *(const float4*)(p.cache_gqa + (size_t)((bl * 2 + 0) * 2 + h) * 16384 + e);
    uint2 o; o.x = pack2(v.x, v.y); o.y = pack2(v.z, v.w);
    *(uint2*)(p.kc_gqa + (size_t)idx * 16384 + e) = o;
  }
}

DI void phase_row(const P& p, int mode, int l) {
  const int tid = threadIdx.x, lane = tid & 63, wid = tid >> 6;
  for (int row = blockIdx.x * 4 + wid; row < TT; row += gridDim.x * 4) {
    const int nidx = row < TP ? 0 : 1 + ((row - TP) >> 10);
    float4 x[4];
    float* xrow = p.out + (size_t)row * 1024;
    if (mode == 0) {
      const float* src = row < TP ? p.x_prompt + (size_t)row * 1024 : p.x_sample + (size_t)(row - TP) * 1024;
#pragma unroll
      for (int i = 0; i < 4; ++i) { x[i] = *(const float4*)(src + i * 256 + lane * 4); *(float4*)(xrow + i * 256 + lane * 4) = x[i]; }
    } else {
      const float* orow = p.obuf + (size_t)row * 1024;
      float4 o[4];
      float ss = 0.f;
#pragma unroll
      for (int i = 0; i < 4; ++i) { o[i] = *(const float4*)(orow + i * 256 + lane * 4); ss += o[i].x * o[i].x + o[i].y * o[i].y + o[i].z * o[i].z + o[i].w * o[i].w; }
      ss = wave_sum(ss);
      const float rs = rsqrtf(ss * (1.f / 1024.f) + EPS);
      const float* ga = p.mods + ((size_t)(l * 9 + nidx) * 6 + (mode == 1 ? 2 : 5)) * 1024;
      const float* g = p.g_norm + (size_t)(l * 4 + (mode == 1 ? 1 : 3)) * 1024;
#pragma unroll
      for (int i = 0; i < 4; ++i) {
        const int cidx = i * 256 + lane * 4;
        float4 xv = *(const float4*)(xrow + cidx), gav = *(const float4*)(ga + cidx), gv = *(const float4*)(g + cidx);
        xv.x += gav.x * (o[i].x * rs * gv.x); xv.y += gav.y * (o[i].y * rs * gv.y);
        xv.z += gav.z * (o[i].z * rs * gv.z); xv.w += gav.w * (o[i].w * rs * gv.w);
        x[i] = xv;
        *(float4*)(xrow + cidx) = xv;
      }
    }
    if (mode == 2 && l == 3) continue;
    const int ln = mode == 1 ? l : (mode == 0 ? 0 : l + 1);
    const int gi = mode == 1 ? 2 : 0, shi = mode == 1 ? 3 : 0;
    float ss2 = 0.f;
#pragma unroll
    for (int i = 0; i < 4; ++i) ss2 += x[i].x * x[i].x + x[i].y * x[i].y + x[i].z * x[i].z + x[i].w * x[i].w;
    ss2 = wave_sum(ss2);
    const float rs2 = rsqrtf(ss2 * (1.f / 1024.f) + EPS);
    const float* g = p.g_norm + (size_t)(ln * 4 + gi) * 1024;
    const float* sh = p.mods + ((size_t)(ln * 9 + nidx) * 6 + shi) * 1024;
    const float* sc = sh + 1024;
#pragma unroll
    for (int i = 0; i < 4; ++i) {
      const int cidx = i * 256 + lane * 4;
      float4 gv = *(const float4*)(g + cidx), shv = *(const float4*)(sh + cidx), scv = *(const float4*)(sc + cidx);
      float h0 = x[i].x * rs2 * gv.x * (1.f + scv.x) + shv.x;
      float h1 = x[i].y * rs2 * gv.y * (1.f + scv.y) + shv.y;
      float h2 = x[i].z * rs2 * gv.z * (1.f + scv.z) + shv.z;
      float h3 = x[i].w * rs2 * gv.w * (1.f + scv.w) + shv.w;
      uint2 o2; o2.x = pack2(h0, h1); o2.y = pack2(h2, h3);
      *(uint2*)(p.hn + (size_t)row * 1024 + cidx) = o2;
    }
  }
}

DI void epi_in(const P& p, int l, f32x4 (&acc)[4][4], int m0, int n0, int wm, int wn, int fr, int fq) {
  const int c0 = n0 + wn * 64;
  const int rbase = m0 + wm * 64;
  const bool prm = rbase < TP;
  if (c0 >= 2560) {
    if (c0 == 2560) {
      const float bg = p.b_gates[l * 16 + fr];
#pragma unroll
      for (int mt = 0; mt < 4; ++mt)
#pragma unroll
        for (int j = 0; j < 4; ++j) {
          int row = rbase + mt * 16 + fq * 4 + j;
          p.gates[(size_t)row * 16 + fr] = acc[mt][0][j] + bg;
        }
    }
    return;
  }
  int region, hh;
  if (c0 < 256) { region = 0; hh = c0 >> 6; }
  else if (c0 < 512) { region = 1; hh = (c0 - 256) >> 6; }
  else if (c0 < 768) { region = 2; hh = (c0 - 512) >> 6; }
  else if (c0 < 1280) { region = 3; hh = (c0 - 768) >> 6; }
  else if (c0 < 1408) { region = 4; hh = (c0 - 1280) >> 6; }
  else if (c0 < 1536) { region = 5; hh = (c0 - 1408) >> 6; }
  else if (c0 < 1792) { region = 6; hh = (c0 - 1536) >> 6; }
  else if (c0 < 2048) { region = 7; hh = (c0 - 1792) >> 6; }
  else if (c0 < 2304) { region = 8; hh = (c0 - 2048) >> 6; }
  else { region = 9; hh = (c0 - 2304) >> 6; }

  if (region == 2 || region == 5 || region == 7 || region == 8) {
    u16* vt = region == 2 ? p.vt_na : (region == 5 ? p.vt_gqa : (region == 7 ? p.kt_ml : p.vt_ml));
    const int H = region == 5 ? 2 : 4;
    const float mul = region == 7 ? 0.125f : 1.f;
#pragma unroll
    for (int mt = 0; mt < 4; ++mt) {
      const int row0 = rbase + mt * 16 + fq * 4;
#pragma unroll
      for (int nt = 0; nt < 4; ++nt) {
        uint2 o; o.x = pack2(acc[mt][nt][0] * mul, acc[mt][nt][1] * mul); o.y = pack2(acc[mt][nt][2] * mul, acc[mt][nt][3] * mul);
        *(uint2*)(vt + vt_index(row0, H, hh, nt * 16 + fr)) = o;
      }
    }
  }
  if (prm && (region == 1 || region == 2 || region == 5)) {
#pragma unroll
    for (int mt = 0; mt < 4; ++mt)
#pragma unroll
      for (int j = 0; j < 4; ++j) {
        const int row = rbase + mt * 16 + fq * 4 + j;
        const int b = row >> 8, t = row & 255;
        size_t base;
        if (region == 5) base = O_GQA + ((size_t)((((b * 4 + l) * 2 + 1) * 2 + hh) * 256 + t)) * 64;
        else base = O_NA + ((size_t)((((b * 4 + l) * 2 + (region == 2 ? 1 : 0)) * 4 + hh) * 256 + t)) * 64;
#pragma unroll
        for (int nt = 0; nt < 4; ++nt) p.out[base + nt * 16 + fr] = acc[mt][nt][j];
      }
  }
  if (region == 2 || region == 5 || region == 8) return;
#pragma unroll
  for (int mt = 0; mt < 4; ++mt)
#pragma unroll
    for (int j = 0; j < 4; ++j) {
      const int row = rbase + mt * 16 + fq * 4 + j;
      float v[4];
#pragma unroll
      for (int nt = 0; nt < 4; ++nt) v[nt] = acc[mt][nt][j];
      if (region == 3 || region == 4) {
        float ss = v[0] * v[0] + v[1] * v[1] + v[2] * v[2] + v[3] * v[3];
        ss += __shfl_xor(ss, 1); ss += __shfl_xor(ss, 2); ss += __shfl_xor(ss, 4); ss += __shfl_xor(ss, 8);
        const float rs = rsqrtf(ss * (1.f / 64.f) + EPS);
        const float* gq = p.g_qk + (size_t)(l * 2 + (region == 4 ? 1 : 0)) * 64;
#pragma unroll
        for (int nt = 0; nt < 4; ++nt) v[nt] *= rs * gq[nt * 16 + fr];
        if (prm) {
          if (region == 4) {
            const int b = row >> 8, t = row & 255;
            const size_t base = O_GQA + ((size_t)((((b * 4 + l) * 2 + 0) * 2 + hh) * 256 + t)) * 64;
#pragma unroll
            for (int nt = 0; nt < 4; ++nt) p.out[base + nt * 16 + fr] = v[nt];
          }
        } else {
          const int t = (row - TP) & 1023, pr = t >> 6, pc = t & 63;
          const float c1 = p.rope[pr * 16 + fr], s1 = p.rope[1024 + pr * 16 + fr];
          const float c2 = p.rope[pc * 16 + fr], s2 = p.rope[1024 + pc * 16 + fr];
          float x1 = v[0], x2 = v[1];
          v[0] = x1 * c1 - x2 * s1; v[1] = x2 * c1 + x1 * s1;
          x1 = v[2]; x2 = v[3];
          v[2] = x1 * c2 - x2 * s2; v[3] = x2 * c2 + x1 * s2;
        }
      }
      const float mul = region == 7 ? 0.125f : 1.f;
#pragma unroll
      for (int nt = 0; nt < 4; ++nt) p.zb[(size_t)row * ZW + c0 + nt * 16 + fr] = f2bf(v[nt] * mul);
    }
}

template <int EPI>
DI void gemm_tile(const P& p, int l, const u16* __restrict__ A, int lda, const u16* __restrict__ Bt, int ldb, int K,
                  int m0, int n0, int ntile, char* smem) {
  u16* As = (u16*)smem;
  u16* Bs = As + 2 * 128 * 72;
  const int tid = threadIdx.x, lane = tid & 63, wid = tid >> 6, wm = wid >> 1, wn = wid & 1, fr = lane & 15, fq = lane >> 4;
  f32x4 acc[4][4];
#pragma unroll
  for (int i = 0; i < 4; ++i)
#pragma unroll
    for (int j = 0; j < 4; ++j) acc[i][j] = zero4();
  const int lr = tid >> 3, lc = (tid & 7) * 8;
  const u16* Ag = A + (size_t)(m0 + lr) * lda + lc;
  const u16* Bg = Bt + (size_t)(n0 + lr) * ldb + lc;
  uint4 ra[4], rb[4];
#pragma unroll
  for (int i = 0; i < 4; ++i) { ra[i] = *(const uint4*)(Ag + (size_t)i * 32 * lda); rb[i] = *(const uint4*)(Bg + (size_t)i * 32 * ldb); }
#pragma unroll
  for (int i = 0; i < 4; ++i) { *(uint4*)(As + (lr + i * 32) * 72 + lc) = ra[i]; *(uint4*)(Bs + (lr + i * 32) * 72 + lc) = rb[i]; }
  __syncthreads();
  const int nk = K >> 6;
  for (int kt = 0; kt < nk; ++kt) {
    const int buf = kt & 1;
    if (kt + 1 < nk) {
      const int k0 = (kt + 1) * 64;
#pragma unroll
      for (int i = 0; i < 4; ++i) { ra[i] = *(const uint4*)(Ag + (size_t)i * 32 * lda + k0); rb[i] = *(const uint4*)(Bg + (size_t)i * 32 * ldb + k0); }
    }
    const u16* Ab = As + buf * 9216 + (wm * 64 + fr) * 72 + fq * 8;
    const u16* Bb = Bs + buf * 9216 + (wn * 64 + fr) * 72 + fq * 8;
#pragma unroll
    for (int ks = 0; ks < 2; ++ks) {
      bf16x8 a[4], b[4];
#pragma unroll
      for (int i = 0; i < 4; ++i) { a[i] = ld8(Ab + i * 16 * 72 + ks * 32); b[i] = ld8(Bb + i * 16 * 72 + ks * 32); }
#pragma unroll
      for (int i = 0; i < 4; ++i)
#pragma unroll
        for (int j = 0; j < 4; ++j) acc[i][j] = MFMA16(a[i], b[j], acc[i][j]);
    }
    if (kt + 1 < nk) {
      u16* Aw = As + (buf ^ 1) * 9216;
      u16* Bw = Bs + (buf ^ 1) * 9216;
#pragma unroll
      for (int i = 0; i < 4; ++i) { *(uint4*)(Aw + (lr + i * 32) * 72 + lc) = ra[i]; *(uint4*)(Bw + (lr + i * 32) * 72 + lc) = rb[i]; }
    }
    __syncthreads();
  }
  if (EPI == 0) {
    epi_in(p, l, acc, m0, n0, wm, wn, fr, fq);
  } else if (EPI == 1) {
#pragma unroll
    for (int mt = 0; mt < 4; ++mt)
#pragma unroll
      for (int j = 0; j < 4; ++j) {
        const int row = m0 + wm * 64 + mt * 16 + fq * 4 + j;
#pragma unroll
        for (int nt = 0; nt < 4; ++nt) p.obuf[(size_t)row * 1024 + n0 + wn * 64 + nt * 16 + fr] = acc[mt][nt][j];
      }
  } else {
#pragma unroll
    for (int mt = 0; mt < 4; ++mt)
#pragma unroll
      for (int j = 0; j < 4; ++j) {
        const int row = m0 + wm * 64 + mt * 16 + fq * 4 + j;
#pragma unroll
        for (int pr = 0; pr < 2; ++pr) {
          const float g = acc[mt][2 * pr][j], u = acc[mt][2 * pr + 1][j];
          const float a = g / (1.f + __expf(-g)) * u;
          p.act[(size_t)row * FF + ntile * 64 + wn * 32 + pr * 16 + fr] = f2bf(a);
        }
      }
  }
}

template <bool WIN>
DI void attn_seg(const u16* __restrict__ K, int ldk, const u16* __restrict__ V, int ldv, int nkeys, const bf16x8 (&qf)[4][2],
                 f32x4 (&o)[4][4], float (&m)[4], float (&lsum)[4], const float* __restrict__ bias, int rdelta, int fr, int fq) {
  const float L2E = 1.44269504f;
  for (int key0 = 0; key0 < nkeys; key0 += 32) {
    bf16x8 kf[2][2];
#pragma unroll
    for (int mt = 0; mt < 2; ++mt)
#pragma unroll
      for (int ks = 0; ks < 2; ++ks) kf[mt][ks] = ld8(K + (size_t)(key0 + mt * 16 + fr) * ldk + ks * 32 + fq * 8);
    bf16x8 va[4];
#pragma unroll
    for (int dt = 0; dt < 4; ++dt) {
      const u16* vp = V + (size_t)(dt * 16 + fr) * ldv + key0 + fq * 4;
      va[dt] = ld4x2(vp, vp + 16);
    }
    f32x4 s[2][4];
#pragma unroll
    for (int mt = 0; mt < 2; ++mt)
#pragma unroll
      for (int nt = 0; nt < 4; ++nt) {
        s[mt][nt] = zero4();
#pragma unroll
        for (int ks = 0; ks < 2; ++ks) s[mt][nt] = MFMA16(kf[mt][ks], qf[nt][ks], s[mt][nt]);
      }
    if (WIN) {
      const int krel = key0 >> 6, ckb = key0 & 63;
      const float* brow = bias + (rdelta + krel) * 31;
#pragma unroll
      for (int nt = 0; nt < 4; ++nt) {
        const int cq = nt * 16 + fr;
        const int cw = min(max(cq - 8, 0), 48);
#pragma unroll
        for (int mt = 0; mt < 2; ++mt)
#pragma unroll
          for (int j = 0; j < 4; ++j) {
            const int ck = ckb + mt * 16 + fq * 4 + j;
            const bool valid = (ck >= cw) && (ck < cw + 16);
            const int dc = min(max(ck - cq, -15), 15) + 15;
            const float bv = brow[dc];
            s[mt][nt][j] = valid ? (s[mt][nt][j] * 0.125f + bv) * L2E : -INFINITY;
          }
      }
    } else {
#pragma unroll
      for (int mt = 0; mt < 2; ++mt)
#pragma unroll
        for (int nt = 0; nt < 4; ++nt) s[mt][nt] *= (0.125f * L2E);
    }
    bf16x8 pb[4];
#pragma unroll
    for (int nt = 0; nt < 4; ++nt) {
      float tm = fmaxf(fmaxf(fmaxf(s[0][nt][0], s[0][nt][1]), fmaxf(s[0][nt][2], s[0][nt][3])),
                       fmaxf(fmaxf(s[1][nt][0], s[1][nt][1]), fmaxf(s[1][nt][2], s[1][nt][3])));
      tm = fmaxf(tm, __shfl_xor(tm, 16));
      tm = fmaxf(tm, __shfl_xor(tm, 32));
      const float mn = fmaxf(m[nt], tm);
      const float alpha = __builtin_amdgcn_exp2f(m[nt] - mn);
      m[nt] = mn;
      float ps = 0.f;
#pragma unroll
      for (int mt = 0; mt < 2; ++mt)
#pragma unroll
        for (int j = 0; j < 4; ++j) { float pv = __builtin_amdgcn_exp2f(s[mt][nt][j] - mn); s[mt][nt][j] = pv; ps += pv; }
      lsum[nt] = lsum[nt] * alpha + ps;
#pragma unroll
      for (int dt = 0; dt < 4; ++dt) o[dt][nt] *= alpha;
      pb[nt] = pack8(s[0][nt], s[1][nt]);
    }
#pragma unroll
    for (int dt = 0; dt < 4; ++dt)
#pragma unroll
      for (int nt = 0; nt < 4; ++nt) o[dt][nt] = MFMA16(va[dt], pb[nt], o[dt][nt]);
  }
}

template <bool WIN>
DI void attn_wave(const u16* Q, int ldq, const u16* K0, int ldk0, const u16* V0, int ldv0, int n0, const u16* K1, int ldk1,
                  const u16* V1, int ldv1, int n1, u16* O, int ldo, const float* bias, int rdelta, int lane) {
  const int fr = lane & 15, fq = lane >> 4;
  bf16x8 qf[4][2];
#pragma unroll
  for (int nt = 0; nt < 4; ++nt)
#pragma unroll
    for (int ks = 0; ks < 2; ++ks) qf[nt][ks] = ld8(Q + (size_t)(nt * 16 + fr) * ldq + ks * 32 + fq * 8);
  f32x4 o[4][4];
  float m[4], lsum[4];
#pragma unroll
  for (int i = 0; i < 4; ++i) {
    m[i] = -1e30f; lsum[i] = 0.f;
#pragma unroll
    for (int j = 0; j < 4; ++j) o[i][j] = zero4();
  }
  attn_seg<WIN>(K0, ldk0, V0, ldv0, n0, qf, o, m, lsum, bias, rdelta, fr, fq);
  if (n1 > 0) attn_seg<false>(K1, ldk1, V1, ldv1, n1, qf, o, m, lsum, bias, rdelta, fr, fq);
#pragma unroll
  for (int nt = 0; nt < 4; ++nt) {
    float lt = lsum[nt];
    lt += __shfl_xor(lt, 16);
    lt += __shfl_xor(lt, 32);
    const float inv = 1.f / lt;
#pragma unroll
    for (int dt = 0; dt < 4; ++dt) {
      uint2 w; w.x = pack2(o[dt][nt][0] * inv, o[dt][nt][1] * inv); w.y = pack2(o[dt][nt][2] * inv, o[dt][nt][3] * inv);
      *(uint2*)(O + (size_t)(nt * 16 + fr) * ldo + dt * 16 + fq * 4) = w;
    }
  }
}

DI float logsig(float x) { return fminf(x, 0.f) - __logf(1.f + __expf(-fabsf(x))); }

DI void mlstm_item(const P& p, int l, int u, char* smem, int tid) {
  const int wid = tid >> 6;
  const bool samp = u < 32;
  int b, h, NC, rowbase, ldT, cs0;
  size_t tb;
  if (samp) { b = u >> 2; h = u & 3; NC = 16; rowbase = TP + b * 1024; ldT = 1024; tb = 1048576 + (size_t)((b * 4 + h) * 64) * 1024; cs0 = u * 32; }
  else { int v = u - 32; b = v >> 2; h = v & 3; NC = 4; rowbase = b * 256; ldT = 256; tb = (size_t)((b * 4 + h) * 64) * 256; cs0 = 1024 + v * 8; }
  float* fl = (float*)smem + wid * 768;
  float* W = fl;
  float* U = fl + 64;
  float* MX = fl + 192;
  float* DEC = fl + 320;
  float* EN = fl + 448;
  float* NQ = fl + 576;

#ifndef MLS
#define MLS 7
#endif
  if (MLS & 1)
  for (int cd = wid; cd < NC * 2; cd += 4) {
    int lane = tid & 63;
    asm volatile("" : "+v"(lane));
    const int fr = lane & 15, fq = lane >> 4;
    const int j = cd >> 1, dir = cd & 1;
    const int cs = cs0 + dir * NC + j;
    const int row = rowbase + j * 64 + lane;
    const float gi = p.gates[(size_t)row * 16 + dir * 8 + h], gf = p.gates[(size_t)row * 16 + dir * 8 + 4 + h];
    float bb = logsig(gf);
    if (dir == 0) {
#pragma unroll
      for (int off = 1; off < 64; off <<= 1) { float t = __shfl_up(bb, off); if (lane >= off) bb += t; }
    } else {
#pragma unroll
      for (int off = 1; off < 64; off <<= 1) { float t = __shfl_down(bb, off); if (lane + off < 64) bb += t; }
    }
    const float bend = __shfl(bb, dir ? 0 : 63);
    const float lw = bend - bb + gi;
    const float a = wave_max(lw);
    W[lane] = __expf(lw - a);
    wave_sync();
    f32x4 acc[4][4];
#pragma unroll
    for (int i = 0; i < 4; ++i)
#pragma unroll
      for (int jj = 0; jj < 4; ++jj) acc[i][jj] = zero4();
    const u16* vt = p.vt_ml + tb + j * 64;
    const u16* kt = p.kt_ml + tb + j * 64;
#pragma unroll 1
    for (int ks = 0; ks < 2; ++ks) {
      const float4 w0 = *(const float4*)(W + ks * 32 + fq * 8), w1 = *(const float4*)(W + ks * 32 + fq * 8 + 4);
      bf16x8 af[4], bfr[4];
#pragma unroll
      for (int mt = 0; mt < 4; ++mt) {
        bf16x8 raw = ld8(vt + (size_t)(mt * 16 + fr) * ldT + ks * 32 + fq * 8);
        f32x4 lo, hi;
        lo[0] = bf2f((u16)raw[0]) * w0.x; lo[1] = bf2f((u16)raw[1]) * w0.y; lo[2] = bf2f((u16)raw[2]) * w0.z; lo[3] = bf2f((u16)raw[3]) * w0.w;
        hi[0] = bf2f((u16)raw[4]) * w1.x; hi[1] = bf2f((u16)raw[5]) * w1.y; hi[2] = bf2f((u16)raw[6]) * w1.z; hi[3] = bf2f((u16)raw[7]) * w1.w;
        af[mt] = pack8(lo, hi);
      }
#pragma unroll
      for (int nt = 0; nt < 4; ++nt) bfr[nt] = ld8(kt + (size_t)(nt * 16 + fr) * ldT + ks * 32 + fq * 8);
#pragma unroll
      for (int mt = 0; mt < 4; ++mt)
#pragma unroll
        for (int nt = 0; nt < 4; ++nt) acc[mt][nt] = MFMA16(af[mt], bfr[nt], acc[mt][nt]);
    }
    float* ch = p.ml_chat + (size_t)cs * 4096;
#pragma unroll
    for (int mt = 0; mt < 4; ++mt)
#pragma unroll
      for (int nt = 0; nt < 4; ++nt)
#pragma unroll
        for (int jj = 0; jj < 4; ++jj) ch[(mt * 16 + fq * 4 + jj) * 64 + nt * 16 + fr] = acc[mt][nt][jj];
    float nh = 0.f;
    const u16* kr = kt + (size_t)lane * ldT;
#pragma unroll 1
    for (int c8 = 0; c8 < 8; ++c8) {
      bf16x8 kk = ld8(kr + c8 * 8);
      const float4 wa = *(const float4*)(W + c8 * 8), wb = *(const float4*)(W + c8 * 8 + 4);
      nh += bf2f((u16)kk[0]) * wa.x + bf2f((u16)kk[1]) * wa.y + bf2f((u16)kk[2]) * wa.z + bf2f((u16)kk[3]) * wa.w;
      nh += bf2f((u16)kk[4]) * wb.x + bf2f((u16)kk[5]) * wb.y + bf2f((u16)kk[6]) * wb.z + bf2f((u16)kk[7]) * wb.w;
    }
    p.ml_nhat[(size_t)cs * 64 + lane] = nh;
    if (lane == 0) { p.ml_ab[cs * 2] = a; p.ml_ab[cs * 2 + 1] = bend; }
    wave_sync();
  }
  __syncthreads();

  if (MLS & 2) {
    const int e0 = tid * 16;
    for (int dir = 0; dir < 2; ++dir) {
      float C[16];
      float n = 0.f, m = 0.f;
      const int sidx = ((b * 4 + l) * 2 + dir) * 4 + h;
      if (samp) {
#pragma unroll
        for (int i = 0; i < 4; ++i) {
          float4 v = *(const float4*)(p.stC + (size_t)sidx * 4096 + e0 + i * 4);
          C[i * 4] = v.x; C[i * 4 + 1] = v.y; C[i * 4 + 2] = v.z; C[i * 4 + 3] = v.w;
        }
        if (tid < 64) n = p.stn[sidx * 64 + tid];
        m = p.stm[sidx];
      } else {
#pragma unroll
        for (int i = 0; i < 16; ++i) C[i] = 0.f;
      }
      for (int c = 0; c < NC; ++c) {
        const int j = dir ? NC - 1 - c : c;
        const int cs = cs0 + dir * NC + j;
        uint4 w0, w1;
        w0.x = pack2(C[0], C[1]); w0.y = pack2(C[2], C[3]); w0.z = pack2(C[4], C[5]); w0.w = pack2(C[6], C[7]);
        w1.x = pack2(C[8], C[9]); w1.y = pack2(C[10], C[11]); w1.z = pack2(C[12], C[13]); w1.w = pack2(C[14], C[15]);
        *(uint4*)(p.ml_cst + (size_t)cs * 4096 + e0) = w0;
        *(uint4*)(p.ml_cst + (size_t)cs * 4096 + e0 + 8) = w1;
        if (tid < 64) p.ml_nst[(size_t)cs * 64 + tid] = n;
        if (tid == 0) p.ml_mst[cs] = m;
        const float a = p.ml_ab[cs * 2], be = p.ml_ab[cs * 2 + 1];
        const float mn = fmaxf(be + m, a);
        const float carry = __expf(be + m - mn), beta = __expf(a - mn);
        const float* ch = p.ml_chat + (size_t)cs * 4096 + e0;
#pragma unroll
        for (int i = 0; i < 4; ++i) {
          float4 v = *(const float4*)(ch + i * 4);
          C[i * 4] = carry * C[i * 4] + beta * v.x; C[i * 4 + 1] = carry * C[i * 4 + 1] + beta * v.y;
          C[i * 4 + 2] = carry * C[i * 4 + 2] + beta * v.z; C[i * 4 + 3] = carry * C[i * 4 + 3] + beta * v.w;
        }
        if (tid < 64) n = carry * n + beta * p.ml_nhat[(size_t)cs * 64 + tid];
        m = mn;
      }
      if (!samp) {
        float* oc = p.out + O_C + (size_t)sidx * 4096 + e0;
#pragma unroll
        for (int i = 0; i < 4; ++i) { float4 v; v.x = C[i * 4]; v.y = C[i * 4 + 1]; v.z = C[i * 4 + 2]; v.w = C[i * 4 + 3]; *(float4*)(oc + i * 4) = v; }
        if (tid < 64) p.out[O_N + (size_t)sidx * 64 + tid] = n;
        if (tid == 0) p.out[O_M + sidx] = m;
      }
    }
  }
  __syncthreads();

  if (MLS & 4)
  for (int j = wid; j < NC; j += 4) {
    int lane = tid & 63;
    asm volatile("" : "+v"(lane));
    const int fr = lane & 15, fq = lane >> 4;
    const int row = rowbase + j * 64 + lane;
    for (int dir = 0; dir < 2; ++dir) {
      const int cs = cs0 + dir * NC + j;
      const float m0 = p.ml_mst[cs];
      const float gi = p.gates[(size_t)row * 16 + dir * 8 + h], gf = p.gates[(size_t)row * 16 + dir * 8 + 4 + h];
      float bb = logsig(gf);
      if (dir == 0) {
#pragma unroll
        for (int off = 1; off < 64; off <<= 1) { float t = __shfl_up(bb, off); if (lane >= off) bb += t; }
      } else {
#pragma unroll
        for (int off = 1; off < 64; off <<= 1) { float t = __shfl_down(bb, off); if (lane + off < 64) bb += t; }
      }
      const float uu = gi - bb;
      float cm = uu;
      if (dir == 0) {
#pragma unroll
        for (int off = 1; off < 64; off <<= 1) { float t = __shfl_up(cm, off); if (lane >= off) cm = fmaxf(cm, t); }
      } else {
#pragma unroll
        for (int off = 1; off < 64; off <<= 1) { float t = __shfl_down(cm, off); if (lane + off < 64) cm = fmaxf(cm, t); }
      }
      const float M = fmaxf(cm, m0);
      U[dir * 64 + lane] = uu;
      MX[dir * 64 + lane] = M;
      DEC[dir * 64 + lane] = __expf(m0 - M);
      EN[dir * 64 + lane] = __expf(-(bb + M));
      const u16* qr = p.zb + (size_t)row * ZW + 1536 + h * 64;
      const float* ns = p.ml_nst + (size_t)cs * 64;
      float nq = 0.f;
#pragma unroll
      for (int c8 = 0; c8 < 8; ++c8) {
        bf16x8 qq = ld8(qr + c8 * 8);
#pragma unroll
        for (int jj = 0; jj < 8; ++jj) nq += bf2f((u16)qq[jj]) * ns[c8 * 8 + jj];
      }
      NQ[dir * 64 + lane] = nq;
    }
    wave_sync();
#pragma unroll 1
    for (int half = 0; half < 2; ++half) {
      bf16x8 qf[2][2];
#pragma unroll
      for (int nt = 0; nt < 2; ++nt)
#pragma unroll
        for (int ks = 0; ks < 2; ++ks)
          qf[nt][ks] = ld8(p.zb + (size_t)(rowbase + j * 64 + half * 32 + nt * 16 + fr) * ZW + 1536 + h * 64 + ks * 32 + fq * 8);
      f32x4 hs[4][2];
#pragma unroll
      for (int i = 0; i < 4; ++i) { hs[i][0] = zero4(); hs[i][1] = zero4(); }
#pragma unroll 1
      for (int dir = 0; dir < 2; ++dir) {
        const int cs = cs0 + dir * NC + j;
        f32x4 acc[4][2];
#pragma unroll
        for (int i = 0; i < 4; ++i) { acc[i][0] = zero4(); acc[i][1] = zero4(); }
        const u16* cst = p.ml_cst + (size_t)cs * 4096;
#pragma unroll
        for (int ks = 0; ks < 2; ++ks)
#pragma unroll
          for (int dt = 0; dt < 4; ++dt) {
            bf16x8 cf = ld8(cst + (dt * 16 + fr) * 64 + ks * 32 + fq * 8);
#pragma unroll
            for (int nt = 0; nt < 2; ++nt) acc[dt][nt] = MFMA16(cf, qf[nt][ks], acc[dt][nt]);
          }
        float dec[2], Mt[2], dsum[2];
#pragma unroll
        for (int nt = 0; nt < 2; ++nt) {
          const int t = half * 32 + nt * 16 + fr;
          dec[nt] = DEC[dir * 64 + t]; Mt[nt] = MX[dir * 64 + t]; dsum[nt] = 0.f;
#pragma unroll
          for (int dt = 0; dt < 4; ++dt) acc[dt][nt] *= dec[nt];
        }
#pragma unroll 1
        for (int sk = 0; sk < 2; ++sk) {
          bf16x8 kf[2][2];
#pragma unroll
          for (int mt = 0; mt < 2; ++mt)
#pragma unroll
            for (int ks = 0; ks < 2; ++ks)
              kf[mt][ks] = ld8(p.zb + (size_t)(rowbase + j * 64 + sk * 32 + mt * 16 + fr) * ZW + 1792 + h * 64 + ks * 32 + fq * 8);
          f32x4 s[2][2];
#pragma unroll
          for (int mt = 0; mt < 2; ++mt)
#pragma unroll
            for (int nt = 0; nt < 2; ++nt) {
              s[mt][nt] = zero4();
#pragma unroll
              for (int ks = 0; ks < 2; ++ks) s[mt][nt] = MFMA16(kf[mt][ks], qf[nt][ks], s[mt][nt]);
            }
#pragma unroll
          for (int mt = 0; mt < 2; ++mt) {
            const float4 u4 = *(const float4*)(U + dir * 64 + sk * 32 + mt * 16 + fq * 4);
            const float uv[4] = {u4.x, u4.y, u4.z, u4.w};
#pragma unroll
            for (int jj = 0; jj < 4; ++jj) {
              const int stok = sk * 32 + mt * 16 + fq * 4 + jj;
#pragma unroll
              for (int nt = 0; nt < 2; ++nt) {
                const int t = half * 32 + nt * 16 + fr;
                const bool valid = dir ? (stok >= t) : (stok <= t);
                const float w = valid ? __expf(uv[jj] - Mt[nt]) : 0.f;
                const float pv = s[mt][nt][jj] * w;
                s[mt][nt][jj] = pv;
                dsum[nt] += pv;
              }
            }
          }
          bf16x8 pb[2];
#pragma unroll
          for (int nt = 0; nt < 2; ++nt) pb[nt] = pack8(s[0][nt], s[1][nt]);
#pragma unroll
          for (int dt = 0; dt < 4; ++dt) {
            const u16* vp = p.vt_ml + tb + (size_t)(dt * 16 + fr) * ldT + j * 64 + sk * 32 + fq * 4;
            bf16x8 va = ld4x2(vp, vp + 16);
#pragma unroll
            for (int nt = 0; nt < 2; ++nt) acc[dt][nt] = MFMA16(va, pb[nt], acc[dt][nt]);
          }
        }
#pragma unroll
        for (int nt = 0; nt < 2; ++nt) {
          const int t = half * 32 + nt * 16 + fr;
          float ds = dsum[nt];
          ds += __shfl_xor(ds, 16);
          ds += __shfl_xor(ds, 32);
          const float den = ds + dec[nt] * NQ[dir * 64 + t];
          const float dv = 1.f / fmaxf(fabsf(den), EN[dir * 64 + t]);
#pragma unroll
          for (int dt = 0; dt < 4; ++dt) hs[dt][nt] += acc[dt][nt] * dv;
        }
      }
#pragma unroll
      for (int nt = 0; nt < 2; ++nt) {
        float ss = 0.f;
#pragma unroll
        for (int dt = 0; dt < 4; ++dt)
#pragma unroll
          for (int jj = 0; jj < 4; ++jj) ss += hs[dt][nt][jj] * hs[dt][nt][jj];
        ss += __shfl_xor(ss, 16);
        ss += __shfl_xor(ss, 32);
        const float rs = rsqrtf(ss * (1.f / 64.f) + EPS);
        const int orow = rowbase + j * 64 + half * 32 + nt * 16 + fr;
#pragma unroll
        for (int dt = 0; dt < 4; ++dt) {
          const int v0 = dt * 16 + fq * 4;
          const float4 gn = *(const float4*)(p.g_ml + l * 256 + h * 64 + v0);
          const uint2 mo = *(const uint2*)(p.zb + (size_t)orow * ZW + 2304 + h * 64 + v0);
          const float o0 = bf2f((u16)(mo.x & 0xffff)), o1 = bf2f((u16)(mo.x >> 16)), o2 = bf2f((u16)(mo.y & 0xffff)), o3 = bf2f((u16)(mo.y >> 16));
          const float r0 = hs[dt][nt][0] * rs * gn.x / (1.f + __expf(-o0));
          const float r1 = hs[dt][nt][1] * rs * gn.y / (1.f + __expf(-o1));
          const float r2 = hs[dt][nt][2] * rs * gn.z / (1.f + __expf(-o2));
          const float r3 = hs[dt][nt][3] * rs * gn.w / (1.f + __expf(-o3));
          uint2 w; w.x = pack2(r0, r1); w.y = pack2(r2, r3);
          *(uint2*)(p.mix + (size_t)orow * 1024 + 768 + h * 64 + v0) = w;
        }
      }
    }
    wave_sync();
  }
  __syncthreads();
}

DI void phase_mix(const P& p, int l, char* smem) {
  for (int it = blockIdx.x; it < 672; it += gridDim.x) {
    int tv = threadIdx.x;
    asm volatile("" : "+v"(tv));
    const int wid = tv >> 6, lane = tv & 63;
    if (it < 32) {
      mlstm_item(p, l, it, smem, tv);
    } else if (it < 288) {
      const int x = it - 32, b = x >> 5, kvh = (x >> 4) & 1, qt = x & 15, head = kvh * 4 + wid;
      const int rowbase = TP + b * 1024;
      const int ci = (b * 4 + l) * 2 + kvh;
      attn_wave<false>(p.zb + (size_t)(rowbase + qt * 64) * ZW + 768 + head * 64, ZW,
                       p.zb + (size_t)rowbase * ZW + 1280 + kvh * 64, ZW, p.vt_gqa + 524288 + (size_t)((b * 2 + kvh) * 64) * 1024, 1024, 1024,
                       p.kc_gqa + (size_t)ci * 16384, 64, p.vct_gqa + (size_t)ci * 16384, 256, 256,
                       p.mix + (size_t)(rowbase + qt * 64) * 1024 + 256 + head * 64, 1024, nullptr, 0, lane);
    } else if (it < 416) {
      const int x = it - 288, b = x >> 4, h = (x >> 2) & 3, r = (x & 3) * 4 + wid;
      const int rowbase = TP + b * 1024;
      const int r0 = min(max(r - 4, 0), 8);
      const int ci = (b * 4 + l) * 4 + h;
      attn_wave<true>(p.zb + (size_t)(rowbase + r * 64) * ZW + h * 64, ZW,
                      p.zb + (size_t)(rowbase + r0 * 64) * ZW + 256 + h * 64, ZW, p.vt_na + 1048576 + (size_t)((b * 4 + h) * 64) * 1024 + r0 * 64, 1024, 512,
                      p.kc_na + (size_t)ci * 16384, 64, p.vct_na + (size_t)ci * 16384, 256, 256,
                      p.mix + (size_t)(rowbase + r * 64) * 1024 + h * 64, 1024, p.na_bias + (size_t)(l * 4 + h) * 15 * 31, r0 - r + 7, lane);
    } else if (it < 480) {
      mlstm_item(p, l, 32 + (it - 416), smem, tv);
    } else if (it < 608) {
      const int x = it - 480, b = x >> 3, kvh = (x >> 2) & 1, qt = x & 3, head = kvh * 4 + wid;
      const int rowbase = b * 256;
      attn_wave<false>(p.zb + (size_t)(rowbase + qt * 64) * ZW + 768 + head * 64, ZW,
                       p.zb + (size_t)rowbase * ZW + 1280 + kvh * 64, ZW, p.vt_gqa + (size_t)((b * 2 + kvh) * 64) * 256, 256, 256,
                       nullptr, 0, nullptr, 0, 0,
                       p.mix + (size_t)(rowbase + qt * 64) * 1024 + 256 + head * 64, 1024, nullptr, 0, lane);
    } else {
      const int x = it - 608, b = x >> 2, h = x & 3, qt = wid;
      const int rowbase = b * 256;
      attn_wave<false>(p.zb + (size_t)(rowbase + qt * 64) * ZW + h * 64, ZW,
                       p.zb + (size_t)rowbase * ZW + 256 + h * 64, ZW, p.vt_na + (size_t)((b * 4 + h) * 64) * 256, 256, 256,
                       nullptr, 0, nullptr, 0, 0,
                       p.mix + (size_t)(rowbase + qt * 64) * 1024 + h * 64, 1024, nullptr, 0, lane);
    }
  }
}

DI void phase_gemm(const P& p, int which, int l, char* smem) {
  if (which == 0) {
    for (int t = blockIdx.x; t < 96 * 21; t += gridDim.x) {
      int m = t % 96, n = t / 96;
      gemm_tile<0>(p, l, p.hn, 1024, p.wt_in + (size_t)l * NIN * 1024, 1024, 1024, m * 128, n * 128, n, smem);
    }
  } else if (which == 1) {
    for (int t = blockIdx.x; t < 96 * 8; t += gridDim.x) {
      int m = t % 96, n = t / 96;
      gemm_tile<1>(p, l, p.mix, 1024, p.wt_out + (size_t)l * 1024 * 1024, 1024, 1024, m * 128, n * 128, n, smem);
    }
  } else if (which == 2) {
    for (int t = blockIdx.x; t < 96 * 44; t += gridDim.x) {
      int m = t % 96, n = t / 96;
      gemm_tile<2>(p, l, p.hn, 1024, p.wt_gu + (size_t)l * 5632 * 1024, 1024, 1024, m * 128, n * 128, n, smem);
    }
  } else {
    for (int t = blockIdx.x; t < 96 * 8; t += gridDim.x) {
      int m = t % 96, n = t / 96;
      gemm_tile<1>(p, l, p.act, FF, p.wt_down + (size_t)l * 1024 * FF, FF, FF, m * 128, n * 128, n, smem);
    }
  }
}

DI void run_phase(const P& p, int ph, int l, char* smem) {
  switch (ph) {
    case 0: phase_init(p, smem); break;
    case 1: phase_row(p, 0, 0); break;
    case 2: phase_gemm(p, 0, l, smem); break;
    case 3: phase_mix(p, l, smem); break;
    case 4: phase_gemm(p, 1, l, smem); break;
    case 5: phase_row(p, 1, l); break;
    case 6: phase_gemm(p, 2, l, smem); break;
    case 7: phase_gemm(p, 3, l, smem); break;
    default: phase_row(p, 2, l); break;
  }
}

#if !ONE_LAUNCH
__global__ void __launch_bounds__(256, 2) k_phase(P p, int ph, int l) {
  __shared__ __attribute__((aligned(16))) char smem[SMEM_BYTES];
  run_phase(p, ph, l, smem);
}

#else
__global__ void __launch_bounds__(256, 2) k_mega(P p) {
  __shared__ __attribute__((aligned(16))) char smem[SMEM_BYTES];
  cg::grid_group grid = cg::this_grid();
  run_phase(p, 0, 0, smem);
  grid.sync();
  run_phase(p, 1, 0, smem);
  for (int l = 0; l < 4; ++l) {
    for (int ph = 2; ph <= 8; ++ph) {
      grid.sync();
      run_phase(p, ph, l, smem);
    }
  }
}

#endif

extern "C" void kernel_launch(void* const* d_in, const int* in_sizes, int n_in, void* d_out, int out_size, void* d_ws,
                              size_t ws_size, hipStream_t stream) {
  P p{};
  p.x_prompt = (const float*)d_in[0]; p.x_sample = (const float*)d_in[1]; p.cache_na = (const float*)d_in[2];
  p.cache_gqa = (const float*)d_in[3]; p.stC = (const float*)d_in[4]; p.stn = (const float*)d_in[5]; p.stm = (const float*)d_in[6];
  p.c = (const float*)d_in[7]; p.c_ctx = (const float*)d_in[8]; p.w_in = (const float*)d_in[9]; p.b_gates = (const float*)d_in[10];
  p.w_out = (const float*)d_in[11]; p.g_norm = (const float*)d_in[12]; p.g_qk = (const float*)d_in[13]; p.g_ml = (const float*)d_in[14];
  p.na_bias = (const float*)d_in[15]; p.w_ada = (const float*)d_in[16]; p.b_ada = (const float*)d_in[17]; p.w_gu = (const float*)d_in[18];
  p.w_down = (const float*)d_in[19];
  p.out = (float*)d_out;
  char* w = (char*)d_ws;
  size_t off = 0;
  auto take = [&](size_t bytes) { char* r = w + off; off += (bytes + 255) & ~(size_t)255; return r; };
  p.wt_in = (u16*)take((size_t)4 * NIN * 1024 * 2);
  p.wt_out = (u16*)take((size_t)4 * 1024 * 1024 * 2);
  p.wt_gu = (u16*)take((size_t)4 * 5632 * 1024 * 2);
  p.wt_down = (u16*)take((size_t)4 * 1024 * FF * 2);
  p.mods = (float*)take((size_t)4 * 9 * 6144 * 4);
  p.rope = (float*)take(2048 * 4);
  p.kc_na = (u16*)take((size_t)128 * 16384 * 2);
  p.vct_na = (u16*)take((size_t)128 * 16384 * 2);
  p.kc_gqa = (u16*)take((size_t)64 * 16384 * 2);
  p.vct_gqa = (u16*)take((size_t)64 * 16384 * 2);
  p.hn = (u16*)take((size_t)TT * 1024 * 2);
  {
    size_t zsz = (size_t)TT * ZW * 2, asz = (size_t)TT * FF * 2;
    char* r = take(zsz > asz ? zsz : asz);
    p.zb = (u16*)r; p.act = (u16*)r;
  }
  p.vt_na = (u16*)take((size_t)(16 * 4 * 64 * 256 + 8 * 4 * 64 * 1024) * 2);
  p.vt_gqa = (u16*)take((size_t)(16 * 2 * 64 * 256 + 8 * 2 * 64 * 1024) * 2);
  p.kt_ml = (u16*)take((size_t)(16 * 4 * 64 * 256 + 8 * 4 * 64 * 1024) * 2);
  p.vt_ml = (u16*)take((size_t)(16 * 4 * 64 * 256 + 8 * 4 * 64 * 1024) * 2);
  p.mix = (u16*)take((size_t)TT * 1024 * 2);
  p.gates = (float*)take((size_t)TT * 16 * 4);
  p.obuf = (float*)take((size_t)TT * 1024 * 4);
  p.ml_chat = (float*)take((size_t)1536 * 4096 * 4);
  p.ml_nhat = (float*)take((size_t)1536 * 64 * 4);
  p.ml_ab = (float*)take((size_t)1536 * 2 * 4);
  p.ml_nst = (float*)take((size_t)1536 * 64 * 4);
  p.ml_mst = (float*)take((size_t)1536 * 4);
  p.ml_cst = (u16*)take((size_t)1536 * 4096 * 2);
  if (off > ws_size) { fprintf(stderr, "workspace too small: need %zu have %zu\n", off, ws_size); return; }

  static int grid_blocks = 0;
  if (!grid_blocks) {
    int dev = 0, cus = 0, per_cu = 0;
    hipGetDevice(&dev);
    hipDeviceGetAttribute(&cus, hipDeviceAttributeMultiprocessorCount, dev);
#if ONE_LAUNCH
    hipOccupancyMaxActiveBlocksPerMultiprocessor(&per_cu, k_mega, 256, 0);
#else
    hipOccupancyMaxActiveBlocksPerMultiprocessor(&per_cu, k_phase, 256, 0);
#endif
    if (per_cu < 1) per_cu = 1;
    if (per_cu > 2) per_cu = 2;
    grid_blocks = cus * per_cu;
  }
#if ONE_LAUNCH
  void* args[] = {&p};
  hipError_t e = hipLaunchCooperativeKernel((void*)k_mega, dim3(grid_blocks), dim3(256), args, 0, stream);
  if (e != hipSuccess) fprintf(stderr, "cooperative launch failed: %s (grid %d)\n", hipGetErrorString(e), grid_blocks);
#else
  k_phase<<<grid_blocks, 256, 0, stream>>>(p, 0, 0);
  k_phase<<<grid_blocks, 256, 0, stream>>>(p, 1, 0);
  for (int l = 0; l < 4; ++l)
    for (int ph = 2; ph <= 8; ++ph) k_phase<<<grid_blocks, 256, 0, stream>>>(p, ph, l);
#endif
}
```

```cpp
#include <hip/hip_runtime.h>
#include <hip/hip_cooperative_groups.h>
#include <stdint.h>
#include <stdio.h>
namespace cg = cooperative_groups;

#ifndef ONE_LAUNCH
#define ONE_LAUNCH 1
#endif

#define DI __device__ __forceinline__
typedef unsigned short u16;
typedef __attribute__((ext_vector_type(8))) short bf16x8;
typedef __attribute__((ext_vector_type(4))) float f32x4;

constexpr int TP = 4096, TS = 8192, TT = 12288, ZW = 2560, NIN = 2688, FF = 2816;
constexpr float EPS = 1e-6f;
constexpr size_t O_YP = 0, O_NA = 12582912, O_GQA = 20971520, O_C = 25165824, O_N = 27262976, O_M = 27295744;
constexpr int SMEM_BYTES = 73728;

struct P {
  const float *x_prompt, *x_sample, *cache_na, *cache_gqa, *stC, *stn, *stm, *c, *c_ctx, *w_in, *b_gates, *w_out,
      *g_norm, *g_qk, *g_ml, *na_bias, *w_ada, *b_ada, *w_gu, *w_down;
  float* out;
  u16 *wt_in, *wt_out, *wt_gu, *wt_down;
  float *mods, *rope;
  u16 *kc_na, *vct_na, *kc_gqa, *vct_gqa;
  u16 *hn, *zb, *act, *vt_na, *vt_gqa, *kt_ml, *vt_ml, *mix;
  float *gates, *obuf;
  float *ml_chat, *ml_nhat, *ml_ab, *ml_nst, *ml_mst;
  u16* ml_cst;
};

DI u16 f2bf(float x) { unsigned u = __float_as_uint(x); u += 0x7fffu + ((u >> 16) & 1u); return (u16)(u >> 16); }
DI float bf2f(u16 h) { return __uint_as_float(((unsigned)h) << 16); }
DI unsigned pack2(float a, float b) { return (unsigned)f2bf(a) | ((unsigned)f2bf(b) << 16); }
DI float wave_sum(float v) { for (int o = 32; o >= 1; o >>= 1) v += __shfl_xor(v, o); return v; }
DI float wave_max(float v) { for (int o = 32; o >= 1; o >>= 1) v = fmaxf(v, __shfl_xor(v, o)); return v; }
DI void wave_sync() { __builtin_amdgcn_fence(__ATOMIC_RELEASE, "wavefront"); __builtin_amdgcn_wave_barrier(); __builtin_amdgcn_fence(__ATOMIC_ACQUIRE, "wavefront"); }
#define MFMA16(a, b, c) __builtin_amdgcn_mfma_f32_16x16x32_bf16((a), (b), (c), 0, 0, 0)
DI bf16x8 ld8(const u16* p) { return *(const bf16x8*)p; }
DI bf16x8 ld4x2(const u16* p0, const u16* p1) {
  uint2 a = *(const uint2*)p0, b = *(const uint2*)p1;
  uint4 r; r.x = a.x; r.y = a.y; r.z = b.x; r.w = b.y;
  return __builtin_bit_cast(bf16x8, r);
}
DI bf16x8 pack8(const f32x4& a, const f32x4& b) {
  uint4 r; r.x = pack2(a[0], a[1]); r.y = pack2(a[2], a[3]); r.z = pack2(b[0], b[1]); r.w = pack2(b[2], b[3]);
  return __builtin_bit_cast(bf16x8, r);
}
DI f32x4 zero4() { f32x4 z = {0.f, 0.f, 0.f, 0.f}; return z; }

DI size_t vt_index(int row, int H, int h, int d) {
  if (row < TP) { int b = row >> 8, t = row & 255; return ((size_t)((b * H + h) * 64 + d)) * 256 + t; }
  int r = row - TP; int b = r >> 10, t = r & 1023;
  return (size_t)16 * H * 64 * 256 + ((size_t)((b * H + h) * 64 + d)) * 1024 + t;
}

DI void transpose_tile(const float* __restrict__ src, int ldsrc, int k0, int n0, int mode, int nvalid,
                       u16* __restrict__ dst, int ldd, float* tile, int tid) {
  const int nn = tid & 63, kq = tid >> 6;
  int rr = n0 + nn, col;
  if (mode == 1) {
    int jt = rr >> 7, c = rr & 127, wn = c >> 6, sub = (c & 63) >> 4, idx = c & 15;
    col = jt * 64 + wn * 32 + (sub >> 1) * 16 + idx + (sub & 1) * FF;
  } else col = rr < nvalid ? rr : -1;
#pragma unroll
  for (int i = 0; i < 16; ++i) {
    int kk = i * 4 + kq;
    tile[kk * 65 + nn] = col >= 0 ? src[(size_t)(k0 + kk) * ldsrc + col] : 0.f;
  }
  __syncthreads();
  const int k2 = (tid & 31) * 2, nq = tid >> 5;
#pragma unroll
  for (int i = 0; i < 8; ++i) {
    int n = i * 8 + nq;
    *(unsigned*)(dst + (size_t)(n0 + n) * ldd + k0 + k2) = pack2(tile[k2 * 65 + n], tile[(k2 + 1) * 65 + n]);
  }
  __syncthreads();
}

DI void phase_init(const P& p, char* smem, int tid) {
  float* tile = (float*)smem;
  const int NTR = 12160, NCV = 768, NADA = 384;
  const int total = NTR + NCV + NADA + 1;
  for (int it = blockIdx.x; it < total; it += gridDim.x) {
    if (it < NTR) {
      int l = it / 3040, r = it % 3040;
      if (r < 672) {
        int kt = r / 42, nt = r % 42;
        transpose_tile(p.w_in + (size_t)l * 1024 * 2576, 2576, kt * 64, nt * 64, 0, 2576, p.wt_in + (size_t)l * NIN * 1024, 1024, tile, tid);
      } else if (r < 928) {
        int x = r - 672, kt = x / 16, nt = x % 16;
        transpose_tile(p.w_out + (size_t)l * 1024 * 1024, 1024, kt * 64, nt * 64, 0, 1024, p.wt_out + (size_t)l * 1024 * 1024, 1024, tile, tid);
      } else if (r < 2336) {
        int x = r - 928, kt = x / 88, nt = x % 88;
        transpose_tile(p.w_gu + (size_t)l * 1024 * 5632, 5632, kt * 64, nt * 64, 1, 5632, p.wt_gu + (size_t)l * 5632 * 1024, 1024, tile, tid);
      } else {
        int x = r - 2336, kt = x / 16, nt = x % 16;
        transpose_tile(p.w_down + (size_t)l * FF * 1024, 1024, kt * 64, nt * 64, 0, 1024, p.wt_down + (size_t)l * 1024 * FF, FF, tile, tid);
      }
    } else if (it < NTR + NCV) {
      int it2 = it - NTR;
      if (it2 < 512) {
        int idx = it2 >> 2, tt = it2 & 3, bl = idx >> 2, h = idx & 3;
        transpose_tile(p.cache_na + (size_t)((bl * 2 + 1) * 4 + h) * 16384, 64, tt * 64, 0, 0, 64, p.vct_na + (size_t)idx * 16384, 256, tile, tid);
      } else {
        int it3 = it2 - 512;
        int idx = it3 >> 2, tt = it3 & 3, bl = idx >> 1, h = idx & 1;
        transpose_tile(p.cache_gqa + (size_t)((bl * 2 + 1) * 2 + h) * 16384, 64, tt * 64, 0, 0, 64, p.vct_gqa + (size_t)idx * 16384, 256, tile, tid);
      }
    } else if (it < NTR + NCV + NADA) {
      int ia = it - NTR - NCV;
      int l = ia / 96, colbase = (ia % 96) * 64;
      float* sl = (float*)smem;
      for (int i = tid; i < 9 * 1024; i += 256) {
        int n = i >> 10, d = i & 1023;
        float cv = n == 0 ? p.c_ctx[d] : p.c[(n - 1) * 1024 + d];
        sl[i] = cv / (1.f + __expf(-cv));
      }
      __syncthreads();
      const int col = tid & 63, kg = tid >> 6;
      float acc[9];
#pragma unroll
      for (int n = 0; n < 9; ++n) acc[n] = 0.f;
      const float* w = p.w_ada + ((size_t)l * 1024 + kg * 256) * 6144 + colbase + col;
#pragma unroll 4
      for (int k = 0; k < 256; ++k) {
        float wv = w[(size_t)k * 6144];
#pragma unroll
        for (int n = 0; n < 9; ++n) acc[n] += sl[n * 1024 + kg * 256 + k] * wv;
      }
      float* red = sl + 9216;
#pragma unroll
      for (int n = 0; n < 9; ++n) red[(kg * 9 + n) * 64 + col] = acc[n];
      __syncthreads();
      for (int i = tid; i < 576; i += 256) {
        int n = i >> 6, cc = i & 63;
        float s = red[(0 * 9 + n) * 64 + cc] + red[(1 * 9 + n) * 64 + cc] + red[(2 * 9 + n) * 64 + cc] + red[(3 * 9 + n) * 64 + cc];
        p.mods[(size_t)(l * 9 + n) * 6144 + colbase + cc] = s + p.b_ada[l * 6144 + colbase + cc];
      }
      __syncthreads();
    } else {
      for (int i = tid; i < 1024; i += 256) {
        int pos = i >> 4, fi = i & 15;
        float inv = __builtin_amdgcn_exp2f(-(float)fi * 0.8304820237f);
        float ang = (float)pos * inv;
        p.rope[i] = __cosf(ang);
        p.rope[1024 + i] = __sinf(ang);
      }
    }
  }
  const int gtid = blockIdx.x * 256 + tid, gsz = gridDim.x * 256;
  for (int i = gtid; i < 128 * 4096; i += gsz) {
    int idx = i >> 12, e = (i & 4095) * 4, bl = idx >> 2, h = idx & 3;
    float4 v = *(const float4*)(p.cache_na + (size_t)((bl * 2 + 0) * 4 + h) * 16384 + e);
    uint2 o; o.x = pack2(v.x, v.y); o.y = pack2(v.z, v.w);
    *(uint2*)(p.kc_na + (size_t)idx * 16384 + e) = o;
  }
  for (int i = gtid; i < 64 * 4096; i += gsz) {
    int idx = i >> 12, e = (i & 4095) * 4, bl = idx >> 1, h = idx & 1;
    float4 v = *(const float4*)(p.cache_gqa + (size_t)((bl * 2 + 0) * 2 + h) * 16384 + e);
    uint2 o; o.x = pack2(v.x, v.y); o.y = pack2(v.z, v.w);
    *(uint2*)(p.kc_gqa + (size_t)idx * 16384 + e) = o;
  }
}

DI void phase_row(const P& p, int mode, int l, int tid) {
  const int lane = tid & 63, wid = tid >> 6;
  for (int row = blockIdx.x * 4 + wid; row < TT; row += gridDim.x * 4) {
    const int nidx = row < TP ? 0 : 1 + ((row - TP) >> 10);
    float4 x[4];
    float* xrow = p.out + (size_t)row * 1024;
    if (mode == 0) {
      const float* src = row < TP ? p.x_prompt + (size_t)row * 1024 : p.x_sample + (size_t)(row - TP) * 1024;
#pragma unroll
      for (int i = 0; i < 4; ++i) { x[i] = *(const float4*)(src + i * 256 + lane * 4); *(float4*)(xrow + i * 256 + lane * 4) = x[i]; }
    } else {
      const float* orow = p.obuf + (size_t)row * 1024;
      float4 o[4];
      float ss = 0.f;
#pragma unroll
      for (int i = 0; i < 4; ++i) { o[i] = *(const float4*)(orow + i * 256 + lane * 4); ss += o[i].x * o[i].x + o[i].y * o[i].y + o[i].z * o[i].z + o[i].w * o[i].w; }
      ss = wave_sum(ss);
      const float rs = rsqrtf(ss * (1.f / 1024.f) + EPS);
      const float* ga = p.mods + ((size_t)(l * 9 + nidx) * 6 + (mode == 1 ? 2 : 5)) * 1024;
      const float* g = p.g_norm + (size_t)(l * 4 + (mode == 1 ? 1 : 3)) * 1024;
#pragma unroll
      for (int i = 0; i < 4; ++i) {
        const int cidx = i * 256 + lane * 4;
        float4 xv = *(const float4*)(xrow + cidx), gav = *(const float4*)(ga + cidx), gv = *(const float4*)(g + cidx);
        xv.x += gav.x * (o[i].x * rs * gv.x); xv.y += gav.y * (o[i].y * rs * gv.y);
        xv.z += gav.z * (o[i].z * rs * gv.z); xv.w += gav.w * (o[i].w * rs * gv.w);
        x[i] = xv;
        *(float4*)(xrow + cidx) = xv;
      }
    }
    if (mode == 2 && l == 3) continue;
    const int ln = mode == 1 ? l : (mode == 0 ? 0 : l + 1);
    const int gi = mode == 1 ? 2 : 0, shi = mode == 1 ? 3 : 0;
    float ss2 = 0.f;
#pragma unroll
    for (int i = 0; i < 4; ++i) ss2 += x[i].x * x[i].x + x[i].y * x[i].y + x[i].z * x[i].z + x[i].w * x[i].w;
    ss2 = wave_sum(ss2);
    const float rs2 = rsqrtf(ss2 * (1.f / 1024.f) + EPS);
    const float* g = p.g_norm + (size_t)(ln * 4 + gi) * 1024;
    const float* sh = p.mods + ((size_t)(ln * 9 + nidx) * 6 + shi) * 1024;
    const float* sc = sh + 1024;
#pragma unroll
    for (int i = 0; i < 4; ++i) {
      const int cidx = i * 256 + lane * 4;
      float4 gv = *(const float4*)(g + cidx), shv = *(const float4*)(sh + cidx), scv = *(const float4*)(sc + cidx);
      float h0 = x[i].x * rs2 * gv.x * (1.f + scv.x) + shv.x;
      float h1 = x[i].y * rs2 * gv.y * (1.f + scv.y) + shv.y;
      float h2 = x[i].z * rs2 * gv.z * (1.f + scv.z) + shv.z;
      float h3 = x[i].w * rs2 * gv.w * (1.f + scv.w) + shv.w;
      uint2 o2; o2.x = pack2(h0, h1); o2.y = pack2(h2, h3);
      *(uint2*)(p.hn + (size_t)row * 1024 + cidx) = o2;
    }
  }
}

DI void epi_in(const P& p, int l, f32x4 (&acc)[4][4], int m0, int n0, int wm, int wn, int fr, int fq) {
  const int c0 = n0 + wn * 64;
  const int rbase = m0 + wm * 64;
  const bool prm = rbase < TP;
  if (c0 >= 2560) {
    if (c0 == 2560) {
      const float bg = p.b_gates[l * 16 + fr];
#pragma unroll
      for (int mt = 0; mt < 4; ++mt)
#pragma unroll
        for (int j = 0; j < 4; ++j) {
          int row = rbase + mt * 16 + fq * 4 + j;
          p.gates[(size_t)row * 16 + fr] = acc[mt][0][j] + bg;
        }
    }
    return;
  }
  int region, hh;
  if (c0 < 256) { region = 0; hh = c0 >> 6; }
  else if (c0 < 512) { region = 1; hh = (c0 - 256) >> 6; }
  else if (c0 < 768) { region = 2; hh = (c0 - 512) >> 6; }
  else if (c0 < 1280) { region = 3; hh = (c0 - 768) >> 6; }
  else if (c0 < 1408) { region = 4; hh = (c0 - 1280) >> 6; }
  else if (c0 < 1536) { region = 5; hh = (c0 - 1408) >> 6; }
  else if (c0 < 1792) { region = 6; hh = (c0 - 1536) >> 6; }
  else if (c0 < 2048) { region = 7; hh = (c0 - 1792) >> 6; }
  else if (c0 < 2304) { region = 8; hh = (c0 - 2048) >> 6; }
  else { region = 9; hh = (c0 - 2304) >> 6; }

  if (region == 2 || region == 5 || region == 7 || region == 8) {
    u16* vt = region == 2 ? p.vt_na : (region == 5 ? p.vt_gqa : (region == 7 ? p.kt_ml : p.vt_ml));
    const int H = region == 5 ? 2 : 4;
    const float mul = region == 7 ? 0.125f : 1.f;
#pragma unroll
    for (int mt = 0; mt < 4; ++mt) {
      const int row0 = rbase + mt * 16 + fq * 4;
#pragma unroll
      for (int nt = 0; nt < 4; ++nt) {
        uint2 o; o.x = pack2(acc[mt][nt][0] * mul, acc[mt][nt][1] * mul); o.y = pack2(acc[mt][nt][2] * mul, acc[mt][nt][3] * mul);
        *(uint2*)(vt + vt_index(row0, H, hh, nt * 16 + fr)) = o;
      }
    }
  }
  if (prm && (region == 1 || region == 2 || region == 5)) {
#pragma unroll
    for (int mt = 0; mt < 4; ++mt)
#pragma unroll
      for (int j = 0; j < 4; ++j) {
        const int row = rbase + mt * 16 + fq * 4 + j;
        const int b = row >> 8, t = row & 255;
        size_t base;
        if (region == 5) base = O_GQA + ((size_t)((((b * 4 + l) * 2 + 1) * 2 + hh) * 256 + t)) * 64;
        else base = O_NA + ((size_t)((((b * 4 + l) * 2 + (region == 2 ? 1 : 0)) * 4 + hh) * 256 + t)) * 64;
#pragma unroll
        for (int nt = 0; nt < 4; ++nt) p.out[base + nt * 16 + fr] = acc[mt][nt][j];
      }
  }
  if (region == 2 || region == 5 || region == 8) return;
#pragma unroll
  for (int mt = 0; mt < 4; ++mt)
#pragma unroll
    for (int j = 0; j < 4; ++j) {
      const int row = rbase + mt * 16 + fq * 4 + j;
      float v[4];
#pragma unroll
      for (int nt = 0; nt < 4; ++nt) v[nt] = acc[mt][nt][j];
      if (region == 3 || region == 4) {
        float ss = v[0] * v[0] + v[1] * v[1] + v[2] * v[2] + v[3] * v[3];
        ss += __shfl_xor(ss, 1); ss += __shfl_xor(ss, 2); ss += __shfl_xor(ss, 4); ss += __shfl_xor(ss, 8);
        const float rs = rsqrtf(ss * (1.f / 64.f) + EPS);
        const float* gq = p.g_qk + (size_t)(l * 2 + (region == 4 ? 1 : 0)) * 64;
#pragma unroll
        for (int nt = 0; nt < 4; ++nt) v[nt] *= rs * gq[nt * 16 + fr];
        if (prm) {
          if (region == 4) {
            const int b = row >> 8, t = row & 255;
            const size_t base = O_GQA + ((size_t)((((b * 4 + l) * 2 + 0) * 2 + hh) * 256 + t)) * 64;
#pragma unroll
            for (int nt = 0; nt < 4; ++nt) p.out[base + nt * 16 + fr] = v[nt];
          }
        } else {
          const int t = (row - TP) & 1023, pr = t >> 6, pc = t & 63;
          const float c1 = p.rope[pr * 16 + fr], s1 = p.rope[1024 + pr * 16 + fr];
          const float c2 = p.rope[pc * 16 + fr], s2 = p.rope[1024 + pc * 16 + fr];
          float x1 = v[0], x2 = v[1];
          v[0] = x1 * c1 - x2 * s1; v[1] = x2 * c1 + x1 * s1;
          x1 = v[2]; x2 = v[3];
          v[2] = x1 * c2 - x2 * s2; v[3] = x2 * c2 + x1 * s2;
        }
      }
      const float mul = region == 7 ? 0.125f : 1.f;
#pragma unroll
      for (int nt = 0; nt < 4; ++nt) p.zb[(size_t)row * ZW + c0 + nt * 16 + fr] = f2bf(v[nt] * mul);
    }
}

template <int EPI>
DI void gemm_tile(const P& p, int l, const u16* __restrict__ A, int lda, const u16* __restrict__ Bt, int ldb, int K,
                  int m0, int n0, int ntile, char* smem, int tid0) {
  u16* As = (u16*)smem;
  u16* Bs = As + 2 * 128 * 72;
  int tid = tid0;
  asm volatile("" : "+v"(tid));
  const int lane = tid & 63, wid = tid >> 6, wm = wid >> 1, wn = wid & 1, fr = lane & 15, fq = lane >> 4;
  f32x4 acc[4][4];
#pragma unroll
  for (int i = 0; i < 4; ++i)
#pragma unroll
    for (int j = 0; j < 4; ++j) acc[i][j] = zero4();
  const int lr = tid >> 3, lc = (tid & 7) * 8;
  const u16* Ag = A + (size_t)(m0 + lr) * lda + lc;
  const u16* Bg = Bt + (size_t)(n0 + lr) * ldb + lc;
  uint4 ra[4], rb[4];
#pragma unroll
  for (int i = 0; i < 4; ++i) { ra[i] = *(const uint4*)(Ag + (size_t)i * 32 * lda); rb[i] = *(const uint4*)(Bg + (size_t)i * 32 * ldb); }
#pragma unroll
  for (int i = 0; i < 4; ++i) { *(uint4*)(As + (lr + i * 32) * 72 + lc) = ra[i]; *(uint4*)(Bs + (lr + i * 32) * 72 + lc) = rb[i]; }
  __syncthreads();
  const int nk = K >> 6;
  for (int kt = 0; kt < nk; ++kt) {
    const int buf = kt & 1;
    if (kt + 1 < nk) {
      const int k0 = (kt + 1) * 64;
#pragma unroll
      for (int i = 0; i < 4; ++i) { ra[i] = *(const uint4*)(Ag + (size_t)i * 32 * lda + k0); rb[i] = *(const uint4*)(Bg + (size_t)i * 32 * ldb + k0); }
    }
    const u16* Ab = As + buf * 9216 + (wm * 64 + fr) * 72 + fq * 8;
    const u16* Bb = Bs + buf * 9216 + (wn * 64 + fr) * 72 + fq * 8;
#pragma unroll
    for (int ks = 0; ks < 2; ++ks) {
      bf16x8 a[4], b[4];
#pragma unroll
      for (int i = 0; i < 4; ++i) { a[i] = ld8(Ab + i * 16 * 72 + ks * 32); b[i] = ld8(Bb + i * 16 * 72 + ks * 32); }
#pragma unroll
      for (int i = 0; i < 4; ++i)
#pragma unroll
        for (int j = 0; j < 4; ++j) acc[i][j] = MFMA16(a[i], b[j], acc[i][j]);
    }
    if (kt + 1 < nk) {
      u16* Aw = As + (buf ^ 1) * 9216;
      u16* Bw = Bs + (buf ^ 1) * 9216;
#pragma unroll
      for (int i = 0; i < 4; ++i) { *(uint4*)(Aw + (lr + i * 32) * 72 + lc) = ra[i]; *(uint4*)(Bw + (lr + i * 32) * 72 + lc) = rb[i]; }
    }
    __syncthreads();
  }
  if (EPI == 0) {
    epi_in(p, l, acc, m0, n0, wm, wn, fr, fq);
  } else if (EPI == 1) {
#pragma unroll
    for (int mt = 0; mt < 4; ++mt)
#pragma unroll
      for (int j = 0; j < 4; ++j) {
        const int row = m0 + wm * 64 + mt * 16 + fq * 4 + j;
#pragma unroll
        for (int nt = 0; nt < 4; ++nt) p.obuf[(size_t)row * 1024 + n0 + wn * 64 + nt * 16 + fr] = acc[mt][nt][j];
      }
  } else {
#pragma unroll
    for (int mt = 0; mt < 4; ++mt)
#pragma unroll
      for (int j = 0; j < 4; ++j) {
        const int row = m0 + wm * 64 + mt * 16 + fq * 4 + j;
#pragma unroll
        for (int pr = 0; pr < 2; ++pr) {
          const float g = acc[mt][2 * pr][j], u = acc[mt][2 * pr + 1][j];
          const float a = g / (1.f + __expf(-g)) * u;
          p.act[(size_t)row * FF + ntile * 64 + wn * 32 + pr * 16 + fr] = f2bf(a);
        }
      }
  }
}

template <bool WIN>
DI void attn_seg(const u16* __restrict__ K, int ldk, const u16* __restrict__ V, int ldv, int nkeys, const bf16x8 (&qf)[4][2],
                 f32x4 (&o)[4][4], float (&m)[4], float (&lsum)[4], const float* __restrict__ bias, int rdelta, int fr, int fq) {
  const float L2E = 1.44269504f;
  for (int key0 = 0; key0 < nkeys; key0 += 32) {
    bf16x8 kf[2][2];
#pragma unroll
    for (int mt = 0; mt < 2; ++mt)
#pragma unroll
      for (int ks = 0; ks < 2; ++ks) kf[mt][ks] = ld8(K + (size_t)(key0 + mt * 16 + fr) * ldk + ks * 32 + fq * 8);
    bf16x8 va[4];
#pragma unroll
    for (int dt = 0; dt < 4; ++dt) {
      const u16* vp = V + (size_t)(dt * 16 + fr) * ldv + key0 + fq * 4;
      va[dt] = ld4x2(vp, vp + 16);
    }
    f32x4 s[2][4];
#pragma unroll
    for (int mt = 0; mt < 2; ++mt)
#pragma unroll
      for (int nt = 0; nt < 4; ++nt) {
        s[mt][nt] = zero4();
#pragma unroll
        for (int ks = 0; ks < 2; ++ks) s[mt][nt] = MFMA16(kf[mt][ks], qf[nt][ks], s[mt][nt]);
      }
    if (WIN) {
      const int krel = key0 >> 6, ckb = key0 & 63;
      const float* brow = bias + (rdelta + krel) * 31;
#pragma unroll
      for (int nt = 0; nt < 4; ++nt) {
        const int cq = nt * 16 + fr;
        const int cw = min(max(cq - 8, 0), 48);
#pragma unroll
        for (int mt = 0; mt < 2; ++mt)
#pragma unroll
          for (int j = 0; j < 4; ++j) {
            const int ck = ckb + mt * 16 + fq * 4 + j;
            const bool valid = (ck >= cw) && (ck < cw + 16);
            const int dc = min(max(ck - cq, -15), 15) + 15;
            const float bv = brow[dc];
            s[mt][nt][j] = valid ? (s[mt][nt][j] * 0.125f + bv) * L2E : -INFINITY;
          }
      }
    } else {
#pragma unroll
      for (int mt = 0; mt < 2; ++mt)
#pragma unroll
        for (int nt = 0; nt < 4; ++nt) s[mt][nt] *= (0.125f * L2E);
    }
    bf16x8 pb[4];
#pragma unroll
    for (int nt = 0; nt < 4; ++nt) {
      float tm = fmaxf(fmaxf(fmaxf(s[0][nt][0], s[0][nt][1]), fmaxf(s[0][nt][2], s[0][nt][3])),
                       fmaxf(fmaxf(s[1][nt][0], s[1][nt][1]), fmaxf(s[1][nt][2], s[1][nt][3])));
      tm = fmaxf(tm, __shfl_xor(tm, 16));
      tm = fmaxf(tm, __shfl_xor(tm, 32));
      const float mn = fmaxf(m[nt], tm);
      const float alpha = __builtin_amdgcn_exp2f(m[nt] - mn);
      m[nt] = mn;
      float ps = 0.f;
#pragma unroll
      for (int mt = 0; mt < 2; ++mt)
#pragma unroll
        for (int j = 0; j < 4; ++j) { float pv = __builtin_amdgcn_exp2f(s[mt][nt][j] - mn); s[mt][nt][j] = pv; ps += pv; }
      lsum[nt] = lsum[nt] * alpha + ps;
#pragma unroll
      for (int dt = 0; dt < 4; ++dt) o[dt][nt] *= alpha;
      pb[nt] = pack8(s[0][nt], s[1][nt]);
    }
#pragma unroll
    for (int dt = 0; dt < 4; ++dt)
#pragma unroll
      for (int nt = 0; nt < 4; ++nt) o[dt][nt] = MFMA16(va[dt], pb[nt], o[dt][nt]);
  }
}

template <bool WIN>
DI void attn_wave(const u16* Q, int ldq, const u16* K0, int ldk0, const u16* V0, int ldv0, int n0, const u16* K1, int ldk1,
                  const u16* V1, int ldv1, int n1, u16* O, int ldo, const float* bias, int rdelta, int lane) {
  const int fr = lane & 15, fq = lane >> 4;
  bf16x8 qf[4][2];
#pragma unroll
  for (int nt = 0; nt < 4; ++nt)
#pragma unroll
    for (int ks = 0; ks < 2; ++ks) qf[nt][ks] = ld8(Q + (size_t)(nt * 16 + fr) * ldq + ks * 32 + fq * 8);
  f32x4 o[4][4];
  float m[4], lsum[4];
#pragma unroll
  for (int i = 0; i < 4; ++i) {
    m[i] = -1e30f; lsum[i] = 0.f;
#pragma unroll
    for (int j = 0; j < 4; ++j) o[i][j] = zero4();
  }
  attn_seg<WIN>(K0, ldk0, V0, ldv0, n0, qf, o, m, lsum, bias, rdelta, fr, fq);
  if (n1 > 0) attn_seg<false>(K1, ldk1, V1, ldv1, n1, qf, o, m, lsum, bias, rdelta, fr, fq);
#pragma unroll
  for (int nt = 0; nt < 4; ++nt) {
    float lt = lsum[nt];
    lt += __shfl_xor(lt, 16);
    lt += __shfl_xor(lt, 32);
    const float inv = 1.f / lt;
#pragma unroll
    for (int dt = 0; dt < 4; ++dt) {
      uint2 w; w.x = pack2(o[dt][nt][0] * inv, o[dt][nt][1] * inv); w.y = pack2(o[dt][nt][2] * inv, o[dt][nt][3] * inv);
      *(uint2*)(O + (size_t)(nt * 16 + fr) * ldo + dt * 16 + fq * 4) = w;
    }
  }
}

DI float logsig(float x) { return fminf(x, 0.f) - __logf(1.f + __expf(-fabsf(x))); }

DI void mlstm_item(const P& p, int l, int u, char* smem, int tid) {
  const int wid = tid >> 6;
  const bool samp = u < 32;
  int b, h, NC, rowbase, ldT, cs0;
  size_t tb;
  if (samp) { b = u >> 2; h = u & 3; NC = 16; rowbase = TP + b * 1024; ldT = 1024; tb = 1048576 + (size_t)((b * 4 + h) * 64) * 1024; cs0 = u * 32; }
  else { int v = u - 32; b = v >> 2; h = v & 3; NC = 4; rowbase = b * 256; ldT = 256; tb = (size_t)((b * 4 + h) * 64) * 256; cs0 = 1024 + v * 8; }
  float* fl = (float*)smem + wid * 768;
  float* W = fl;
  float* U = fl + 64;
  float* MX = fl + 192;
  float* DEC = fl + 320;
  float* EN = fl + 448;
  float* NQ = fl + 576;

#ifndef MLS
#define MLS 7
#endif
  if (MLS & 1)
  for (int cd = wid; cd < NC * 2; cd += 4) {
    int lane = tid & 63;
    asm volatile("" : "+v"(lane));
    const int fr = lane & 15, fq = lane >> 4;
    const int j = cd >> 1, dir = cd & 1;
    const int cs = cs0 + dir * NC + j;
    const int row = rowbase + j * 64 + lane;
    const float gi = p.gates[(size_t)row * 16 + dir * 8 + h], gf = p.gates[(size_t)row * 16 + dir * 8 + 4 + h];
    float bb = logsig(gf);
    if (dir == 0) {
#pragma unroll
      for (int off = 1; off < 64; off <<= 1) { float t = __shfl_up(bb, off); if (lane >= off) bb += t; }
    } else {
#pragma unroll
      for (int off = 1; off < 64; off <<= 1) { float t = __shfl_down(bb, off); if (lane + off < 64) bb += t; }
    }
    const float bend = __shfl(bb, dir ? 0 : 63);
    const float lw = bend - bb + gi;
    const float a = wave_max(lw);
    W[lane] = __expf(lw - a);
    wave_sync();
    f32x4 acc[4][4];
#pragma unroll
    for (int i = 0; i < 4; ++i)
#pragma unroll
      for (int jj = 0; jj < 4; ++jj) acc[i][jj] = zero4();
    const u16* vt = p.vt_ml + tb + j * 64;
    const u16* kt = p.kt_ml + tb + j * 64;
#pragma unroll 1
    for (int ks = 0; ks < 2; ++ks) {
      const float4 w0 = *(const float4*)(W + ks * 32 + fq * 8), w1 = *(const float4*)(W + ks * 32 + fq * 8 + 4);
      bf16x8 af[4], bfr[4];
#pragma unroll
      for (int mt = 0; mt < 4; ++mt) {
        bf16x8 raw = ld8(vt + (size_t)(mt * 16 + fr) * ldT + ks * 32 + fq * 8);
        f32x4 lo, hi;
        lo[0] = bf2f((u16)raw[0]) * w0.x; lo[1] = bf2f((u16)raw[1]) * w0.y; lo[2] = bf2f((u16)raw[2]) * w0.z; lo[3] = bf2f((u16)raw[3]) * w0.w;
        hi[0] = bf2f((u16)raw[4]) * w1.x; hi[1] = bf2f((u16)raw[5]) * w1.y; hi[2] = bf2f((u16)raw[6]) * w1.z; hi[3] = bf2f((u16)raw[7]) * w1.w;
        af[mt] = pack8(lo, hi);
      }
#pragma unroll
      for (int nt = 0; nt < 4; ++nt) bfr[nt] = ld8(kt + (size_t)(nt * 16 + fr) * ldT + ks * 32 + fq * 8);
#pragma unroll
      for (int mt = 0; mt < 4; ++mt)
#pragma unroll
        for (int nt = 0; nt < 4; ++nt) acc[mt][nt] = MFMA16(af[mt], bfr[nt], acc[mt][nt]);
    }
    float* ch = p.ml_chat + (size_t)cs * 4096;
#pragma unroll
    for (int mt = 0; mt < 4; ++mt)
#pragma unroll
      for (int nt = 0; nt < 4; ++nt)
#pragma unroll
        for (int jj = 0; jj < 4; ++jj) ch[(mt * 16 + fq * 4 + jj) * 64 + nt * 16 + fr] = acc[mt][nt][jj];
    float nh = 0.f;
    const u16* kr = kt + (size_t)lane * ldT;
#pragma unroll 1
    for (int c8 = 0; c8 < 8; ++c8) {
      bf16x8 kk = ld8(kr + c8 * 8);
      const float4 wa = *(const float4*)(W + c8 * 8), wb = *(const float4*)(W + c8 * 8 + 4);
      nh += bf2f((u16)kk[0]) * wa.x + bf2f((u16)kk[1]) * wa.y + bf2f((u16)kk[2]) * wa.z + bf2f((u16)kk[3]) * wa.w;
      nh += bf2f((u16)kk[4]) * wb.x + bf2f((u16)kk[5]) * wb.y + bf2f((u16)kk[6]) * wb.z + bf2f((u16)kk[7]) * wb.w;
    }
    p.ml_nhat[(size_t)cs * 64 + lane] = nh;
    if (lane == 0) { p.ml_ab[cs * 2] = a; p.ml_ab[cs * 2 + 1] = bend; }
    wave_sync();
  }
  __syncthreads();

  if (MLS & 2) {
    const int e0 = tid * 16;
    for (int dir = 0; dir < 2; ++dir) {
      float C[16];
      float n = 0.f, m = 0.f;
      const int sidx = ((b * 4 + l) * 2 + dir) * 4 + h;
      if (samp) {
#pragma unroll
        for (int i = 0; i < 4; ++i) {
          float4 v = *(const float4*)(p.stC + (size_t)sidx * 4096 + e0 + i * 4);
          C[i * 4] = v.x; C[i * 4 + 1] = v.y; C[i * 4 + 2] = v.z; C[i * 4 + 3] = v.w;
        }
        if (tid < 64) n = p.stn[sidx * 64 + tid];
        m = p.stm[sidx];
      } else {
#pragma unroll
        for (int i = 0; i < 16; ++i) C[i] = 0.f;
      }
      for (int c = 0; c < NC; ++c) {
        const int j = dir ? NC - 1 - c : c;
        const int cs = cs0 + dir * NC + j;
        uint4 w0, w1;
        w0.x = pack2(C[0], C[1]); w0.y = pack2(C[2], C[3]); w0.z = pack2(C[4], C[5]); w0.w = pack2(C[6], C[7]);
        w1.x = pack2(C[8], C[9]); w1.y = pack2(C[10], C[11]); w1.z = pack2(C[12], C[13]); w1.w = pack2(C[14], C[15]);
        *(uint4*)(p.ml_cst + (size_t)cs * 4096 + e0) = w0;
        *(uint4*)(p.ml_cst + (size_t)cs * 4096 + e0 + 8) = w1;
        if (tid < 64) p.ml_nst[(size_t)cs * 64 + tid] = n;
        if (tid == 0) p.ml_mst[cs] = m;
        const float a = p.ml_ab[cs * 2], be = p.ml_ab[cs * 2 + 1];
        const float mn = fmaxf(be + m, a);
        const float carry = __expf(be + m - mn), beta = __expf(a - mn);
        const float* ch = p.ml_chat + (size_t)cs * 4096 + e0;
#pragma unroll
        for (int i = 0; i < 4; ++i) {
          float4 v = *(const float4*)(ch + i * 4);
          C[i * 4] = carry * C[i * 4] + beta * v.x; C[i * 4 + 1] = carry * C[i * 4 + 1] + beta * v.y;
          C[i * 4 + 2] = carry * C[i * 4 + 2] + beta * v.z; C[i * 4 + 3] = carry * C[i * 4 + 3] + beta * v.w;
        }
        if (tid < 64) n = carry * n + beta * p.ml_nhat[(size_t)cs * 64 + tid];
        m = mn;
      }
      if (!samp) {
        float* oc = p.out + O_C + (size_t)sidx * 4096 + e0;
#pragma unroll
        for (int i = 0; i < 4; ++i) { float4 v; v.x = C[i * 4]; v.y = C[i * 4 + 1]; v.z = C[i * 4 + 2]; v.w = C[i * 4 + 3]; *(float4*)(oc + i * 4) = v; }
        if (tid < 64) p.out[O_N + (size_t)sidx * 64 + tid] = n;
        if (tid == 0) p.out[O_M + sidx] = m;
      }
    }
  }
  __syncthreads();

  if (MLS & 4)
  for (int j = wid; j < NC; j += 4) {
    int lane = tid & 63;
    asm volatile("" : "+v"(lane));
    const int fr = lane & 15, fq = lane >> 4;
    const int row = rowbase + j * 64 + lane;
    for (int dir = 0; dir < 2; ++dir) {
      const int cs = cs0 + dir * NC + j;
      const float m0 = p.ml_mst[cs];
      const float gi = p.gates[(size_t)row * 16 + dir * 8 + h], gf = p.gates[(size_t)row * 16 + dir * 8 + 4 + h];
      float bb = logsig(gf);
      if (dir == 0) {
#pragma unroll
        for (int off = 1; off < 64; off <<= 1) { float t = __shfl_up(bb, off); if (lane >= off) bb += t; }
      } else {
#pragma unroll
        for (int off = 1; off < 64; off <<= 1) { float t = __shfl_down(bb, off); if (lane + off < 64) bb += t; }
      }
      const float uu = gi - bb;
      float cm = uu;
      if (dir == 0) {
#pragma unroll
        for (int off = 1; off < 64; off <<= 1) { float t = __shfl_up(cm, off); if (lane >= off) cm = fmaxf(cm, t); }
      } else {
#pragma unroll
        for (int off = 1; off < 64; off <<= 1) { float t = __shfl_down(cm, off); if (lane + off < 64) cm = fmaxf(cm, t); }
      }
      const float M = fmaxf(cm, m0);
      U[dir * 64 + lane] = uu;
      MX[dir * 64 + lane] = M;
      DEC[dir * 64 + lane] = __expf(m0 - M);
      EN[dir * 64 + lane] = __expf(-(bb + M));
      const u16* qr = p.zb + (size_t)row * ZW + 1536 + h * 64;
      const float* ns = p.ml_nst + (size_t)cs * 64;
      float nq = 0.f;
#pragma unroll
      for (int c8 = 0; c8 < 8; ++c8) {
        bf16x8 qq = ld8(qr + c8 * 8);
#pragma unroll
        for (int jj = 0; jj < 8; ++jj) nq += bf2f((u16)qq[jj]) * ns[c8 * 8 + jj];
      }
      NQ[dir * 64 + lane] = nq;
    }
    wave_sync();
#pragma unroll 1
    for (int half = 0; half < 2; ++half) {
      bf16x8 qf[2][2];
#pragma unroll
      for (int nt = 0; nt < 2; ++nt)
#pragma unroll
        for (int ks = 0; ks < 2; ++ks)
          qf[nt][ks] = ld8(p.zb + (size_t)(rowbase + j * 64 + half * 32 + nt * 16 + fr) * ZW + 1536 + h * 64 + ks * 32 + fq * 8);
      f32x4 hs[4][2];
#pragma unroll
      for (int i = 0; i < 4; ++i) { hs[i][0] = zero4(); hs[i][1] = zero4(); }
#pragma unroll 1
      for (int dir = 0; dir < 2; ++dir) {
        const int cs = cs0 + dir * NC + j;
        f32x4 acc[4][2];
#pragma unroll
        for (int i = 0; i < 4; ++i) { acc[i][0] = zero4(); acc[i][1] = zero4(); }
        const u16* cst = p.ml_cst + (size_t)cs * 4096;
#pragma unroll
        for (int ks = 0; ks < 2; ++ks)
#pragma unroll
          for (int dt = 0; dt < 4; ++dt) {
            bf16x8 cf = ld8(cst + (dt * 16 + fr) * 64 + ks * 32 + fq * 8);
#pragma unroll
            for (int nt = 0; nt < 2; ++nt) acc[dt][nt] = MFMA16(cf, qf[nt][ks], acc[dt][nt]);
          }
        float dec[2], Mt[2], dsum[2];
#pragma unroll
        for (int nt = 0; nt < 2; ++nt) {
          const int t = half * 32 + nt * 16 + fr;
          dec[nt] = DEC[dir * 64 + t]; Mt[nt] = MX[dir * 64 + t]; dsum[nt] = 0.f;
#pragma unroll
          for (int dt = 0; dt < 4; ++dt) acc[dt][nt] *= dec[nt];
        }
#pragma unroll 1
        for (int sk = 0; sk < 2; ++sk) {
          bf16x8 kf[2][2];
#pragma unroll
          for (int mt = 0; mt < 2; ++mt)
#pragma unroll
            for (int ks = 0; ks < 2; ++ks)
              kf[mt][ks] = ld8(p.zb + (size_t)(rowbase + j * 64 + sk * 32 + mt * 16 + fr) * ZW + 1792 + h * 64 + ks * 32 + fq * 8);
          f32x4 s[2][2];
#pragma unroll
          for (int mt = 0; mt < 2; ++mt)
#pragma unroll
            for (int nt = 0; nt < 2; ++nt) {
              s[mt][nt] = zero4();
#pragma unroll
              for (int ks = 0; ks < 2; ++ks) s[mt][nt] = MFMA16(kf[mt][ks], qf[nt][ks], s[mt][nt]);
            }
#pragma unroll
          for (int mt = 0; mt < 2; ++mt) {
            const float4 u4 = *(const float4*)(U + dir * 64 + sk * 32 + mt * 16 + fq * 4);
            const float uv[4] = {u4.x, u4.y, u4.z, u4.w};
#pragma unroll
            for (int jj = 0; jj < 4; ++jj) {
              const int stok = sk * 32 + mt * 16 + fq * 4 + jj;
#pragma unroll
              for (int nt = 0; nt < 2; ++nt) {
                const int t = half * 32 + nt * 16 + fr;
                const bool valid = dir ? (stok >= t) : (stok <= t);
                const float w = valid ? __expf(uv[jj] - Mt[nt]) : 0.f;
                const float pv = s[mt][nt][jj] * w;
                s[mt][nt][jj] = pv;
                dsum[nt] += pv;
              }
            }
          }
          bf16x8 pb[2];
#pragma unroll
          for (int nt = 0; nt < 2; ++nt) pb[nt] = pack8(s[0][nt], s[1][nt]);
#pragma unroll
          for (int dt = 0; dt < 4; ++dt) {
            const u16* vp = p.vt_ml + tb + (size_t)(dt * 16 + fr) * ldT + j * 64 + sk * 32 + fq * 4;
            bf16x8 va = ld4x2(vp, vp + 16);
#pragma unroll
            for (int nt = 0; nt < 2; ++nt) acc[dt][nt] = MFMA16(va, pb[nt], acc[dt][nt]);
          }
        }
#pragma unroll
        for (int nt = 0; nt < 2; ++nt) {
          const int t = half * 32 + nt * 16 + fr;
          float ds = dsum[nt];
          ds += __shfl_xor(ds, 16);
          ds += __shfl_xor(ds, 32);
          const float den = ds + dec[nt] * NQ[dir * 64 + t];
          const float dv = 1.f / fmaxf(fabsf(den), EN[dir * 64 + t]);
#pragma unroll
          for (int dt = 0; dt < 4; ++dt) hs[dt][nt] += acc[dt][nt] * dv;
        }
      }
#pragma unroll
      for (int nt = 0; nt < 2; ++nt) {
        float ss = 0.f;
#pragma unroll
        for (int dt = 0; dt < 4; ++dt)
#pragma unroll
          for (int jj = 0; jj < 4; ++jj) ss += hs[dt][nt][jj] * hs[dt][nt][jj];
        ss += __shfl_xor(ss, 16);
        ss += __shfl_xor(ss, 32);
        const float rs = rsqrtf(ss * (1.f / 64.f) + EPS);
        const int orow = rowbase + j * 64 + half * 32 + nt * 16 + fr;
#pragma unroll
        for (int dt = 0; dt < 4; ++dt) {
          const int v0 = dt * 16 + fq * 4;
          const float4 gn = *(const float4*)(p.g_ml + l * 256 + h * 64 + v0);
          const uint2 mo = *(const uint2*)(p.zb + (size_t)orow * ZW + 2304 + h * 64 + v0);
          const float o0 = bf2f((u16)(mo.x & 0xffff)), o1 = bf2f((u16)(mo.x >> 16)), o2 = bf2f((u16)(mo.y & 0xffff)), o3 = bf2f((u16)(mo.y >> 16));
          const float r0 = hs[dt][nt][0] * rs * gn.x / (1.f + __expf(-o0));
          const float r1 = hs[dt][nt][1] * rs * gn.y / (1.f + __expf(-o1));
          const float r2 = hs[dt][nt][2] * rs * gn.z / (1.f + __expf(-o2));
          const float r3 = hs[dt][nt][3] * rs * gn.w / (1.f + __expf(-o3));
          uint2 w; w.x = pack2(r0, r1); w.y = pack2(r2, r3);
          *(uint2*)(p.mix + (size_t)orow * 1024 + 768 + h * 64 + v0) = w;
        }
      }
    }
    wave_sync();
  }
  __syncthreads();
}

DI void phase_mix(const P& p, int l, char* smem, int tid0) {
  for (int it = blockIdx.x; it < 672; it += gridDim.x) {
    int tv = tid0;
    asm volatile("" : "+v"(tv));
    const int wid = tv >> 6, lane = tv & 63;
    if (it < 32) {
      mlstm_item(p, l, it, smem, tv);
    } else if (it < 288) {
      const int x = it - 32, b = x >> 5, kvh = (x >> 4) & 1, qt = x & 15, head = kvh * 4 + wid;
      const int rowbase = TP + b * 1024;
      const int ci = (b * 4 + l) * 2 + kvh;
      attn_wave<false>(p.zb + (size_t)(rowbase + qt * 64) * ZW + 768 + head * 64, ZW,
                       p.zb + (size_t)rowbase * ZW + 1280 + kvh * 64, ZW, p.vt_gqa + 524288 + (size_t)((b * 2 + kvh) * 64) * 1024, 1024, 1024,
                       p.kc_gqa + (size_t)ci * 16384, 64, p.vct_gqa + (size_t)ci * 16384, 256, 256,
                       p.mix + (size_t)(rowbase + qt * 64) * 1024 + 256 + head * 64, 1024, nullptr, 0, lane);
    } else if (it < 416) {
      const int x = it - 288, b = x >> 4, h = (x >> 2) & 3, r = (x & 3) * 4 + wid;
      const int rowbase = TP + b * 1024;
      const int r0 = min(max(r - 4, 0), 8);
      const int ci = (b * 4 + l) * 4 + h;
      attn_wave<true>(p.zb + (size_t)(rowbase + r * 64) * ZW + h * 64, ZW,
                      p.zb + (size_t)(rowbase + r0 * 64) * ZW + 256 + h * 64, ZW, p.vt_na + 1048576 + (size_t)((b * 4 + h) * 64) * 1024 + r0 * 64, 1024, 512,
                      p.kc_na + (size_t)ci * 16384, 64, p.vct_na + (size_t)ci * 16384, 256, 256,
                      p.mix + (size_t)(rowbase + r * 64) * 1024 + h * 64, 1024, p.na_bias + (size_t)(l * 4 + h) * 15 * 31, r0 - r + 7, lane);
    } else if (it < 480) {
      mlstm_item(p, l, 32 + (it - 416), smem, tv);
    } else if (it < 608) {
      const int x = it - 480, b = x >> 3, kvh = (x >> 2) & 1, qt = x & 3, head = kvh * 4 + wid;
      const int rowbase = b * 256;
      attn_wave<false>(p.zb + (size_t)(rowbase + qt * 64) * ZW + 768 + head * 64, ZW,
                       p.zb + (size_t)rowbase * ZW + 1280 + kvh * 64, ZW, p.vt_gqa + (size_t)((b * 2 + kvh) * 64) * 256, 256, 256,
                       nullptr, 0, nullptr, 0, 0,
                       p.mix + (size_t)(rowbase + qt * 64) * 1024 + 256 + head * 64, 1024, nullptr, 0, lane);
    } else {
      const int x = it - 608, b = x >> 2, h = x & 3, qt = wid;
      const int rowbase = b * 256;
      attn_wave<false>(p.zb + (size_t)(rowbase + qt * 64) * ZW + h * 64, ZW,
                       p.zb + (size_t)rowbase * ZW + 256 + h * 64, ZW, p.vt_na + (size_t)((b * 4 + h) * 64) * 256, 256, 256,
                       nullptr, 0, nullptr, 0, 0,
                       p.mix + (size_t)(rowbase + qt * 64) * 1024 + h * 64, 1024, nullptr, 0, lane);
    }
  }
}

DI void phase_gemm(const P& p, int which, int l, char* smem, int tid) {
  if (which == 0) {
    for (int t = blockIdx.x; t < 96 * 21; t += gridDim.x) {
      int m = t % 96, n = t / 96;
      gemm_tile<0>(p, l, p.hn, 1024, p.wt_in + (size_t)l * NIN * 1024, 1024, 1024, m * 128, n * 128, n, smem, tid);
    }
  } else if (which == 1) {
    for (int t = blockIdx.x; t < 96 * 8; t += gridDim.x) {
      int m = t % 96, n = t / 96;
      gemm_tile<1>(p, l, p.mix, 1024, p.wt_out + (size_t)l * 1024 * 1024, 1024, 1024, m * 128, n * 128, n, smem, tid);
    }
  } else if (which == 2) {
    for (int t = blockIdx.x; t < 96 * 44; t += gridDim.x) {
      int m = t % 96, n = t / 96;
      gemm_tile<2>(p, l, p.hn, 1024, p.wt_gu + (size_t)l * 5632 * 1024, 1024, 1024, m * 128, n * 128, n, smem, tid);
    }
  } else {
    for (int t = blockIdx.x; t < 96 * 8; t += gridDim.x) {
      int m = t % 96, n = t / 96;
      gemm_tile<1>(p, l, p.act, FF, p.wt_down + (size_t)l * 1024 * FF, FF, FF, m * 128, n * 128, n, smem, tid);
    }
  }
}

DI void run_phase(const P& p, int ph, int l, char* smem) {
  int tid = threadIdx.x;
  asm volatile("" : "+v"(tid));
  switch (ph) {
    case 0: phase_init(p, smem, tid); break;
    case 1: phase_row(p, 0, 0, tid); break;
    case 2: phase_gemm(p, 0, l, smem, tid); break;
    case 3: phase_mix(p, l, smem, tid); break;
    case 4: phase_gemm(p, 1, l, smem, tid); break;
    case 5: phase_row(p, 1, l, tid); break;
    case 6: phase_gemm(p, 2, l, smem, tid); break;
    case 7: phase_gemm(p, 3, l, smem, tid); break;
    default: phase_row(p, 2, l, tid); break;
  }
}

#if !ONE_LAUNCH
__global__ void __launch_bounds__(256, 2) k_phase(P p, int ph, int l) {
  __shared__ __attribute__((aligned(16))) char smem[SMEM_BYTES];
  run_phase(p, ph, l, smem);
}

#else
__global__ void __launch_bounds__(256, 2) k_mega(P p) {
  __shared__ __attribute__((aligned(16))) char smem[SMEM_BYTES];
  cg::grid_group grid = cg::this_grid();
  run_phase(p, 0, 0, smem);
  grid.sync();
  run_phase(p, 1, 0, smem);
  for (int l = 0; l < 4; ++l) {
    for (int ph = 2; ph <= 8; ++ph) {
      grid.sync();
      run_phase(p, ph, l, smem);
    }
  }
}

#endif

extern "C" void kernel_launch(void* const* d_in, const int* in_sizes, int n_in, void* d_out, int out_size, void* d_ws,
                              size_t ws_size, hipStream_t stream) {
  P p{};
  p.x_prompt = (const float*)d_in[0]; p.x_sample = (const float*)d_in[1]; p.cache_na = (const float*)d_in[2];
  p.cache_gqa = (const float*)d_in[3]; p.stC = (const float*)d_in[4]; p.stn = (const float*)d_in[5]; p.stm = (const float*)d_in[6];
  p.c = (const float*)d_in[7]; p.c_ctx = (const float*)d_in[8]; p.w_in = (const float*)d_in[9]; p.b_gates = (const float*)d_in[10];
  p.w_out = (const float*)d_in[11]; p.g_norm = (const float*)d_in[12]; p.g_qk = (const float*)d_in[13]; p.g_ml = (const float*)d_in[14];
  p.na_bias = (const float*)d_in[15]; p.w_ada = (const float*)d_in[16]; p.b_ada = (const float*)d_in[17]; p.w_gu = (const float*)d_in[18];
  p.w_down = (const float*)d_in[19];
  p.out = (float*)d_out;
  char* w = (char*)d_ws;
  size_t off = 0;
  auto take = [&](size_t bytes) { char* r = w + off; off += (bytes + 255) & ~(size_t)255; return r; };
  p.wt_in = (u16*)take((size_t)4 * NIN * 1024 * 2);
  p.wt_out = (u16*)take((size_t)4 * 1024 * 1024 * 2);
  p.wt_gu = (u16*)take((size_t)4 * 5632 * 1024 * 2);
  p.wt_down = (u16*)take((size_t)4 * 1024 * FF * 2);
  p.mods = (float*)take((size_t)4 * 9 * 6144 * 4);
  p.rope = (float*)take(2048 * 4);
  p.kc_na = (u16*)take((size_t)128 * 16384 * 2);
  p.vct_na = (u16*)take((size_t)128 * 16384 * 2);
  p.kc_gqa = (u16*)take((size_t)64 * 16384 * 2);
  p.vct_gqa = (u16*)take((size_t)64 * 16384 * 2);
  p.hn = (u16*)take((size_t)TT * 1024 * 2);
  {
    size_t zsz = (size_t)TT * ZW * 2, asz = (size_t)TT * FF * 2;
    char* r = take(zsz > asz ? zsz : asz);
    p.zb = (u16*)r; p.act = (u16*)r;
  }
  p.vt_na = (u16*)take((size_t)(16 * 4 * 64 * 256 + 8 * 4 * 64 * 1024) * 2);
  p.vt_gqa = (u16*)take((size_t)(16 * 2 * 64 * 256 + 8 * 2 * 64 * 1024) * 2);
  p.kt_ml = (u16*)take((size_t)(16 * 4 * 64 * 256 + 8 * 4 * 64 * 1024) * 2);
  p.vt_ml = (u16*)take((size_t)(16 * 4 * 64 * 256 + 8 * 4 * 64 * 1024) * 2);
  p.mix = (u16*)take((size_t)TT * 1024 * 2);
  p.gates = (float*)take((size_t)TT * 16 * 4);
  p.obuf = (float*)take((size_t)TT * 1024 * 4);
  p.ml_chat = (float*)take((size_t)1536 * 4096 * 4);
  p.ml_nhat = (float*)take((size_t)1536 * 64 * 4);
  p.ml_ab = (float*)take((size_t)1536 * 2 * 4);
  p.ml_nst = (float*)take((size_t)1536 * 64 * 4);
  p.ml_mst = (float*)take((size_t)1536 * 4);
  p.ml_cst = (u16*)take((size_t)1536 * 4096 * 2);
  if (off > ws_size) { fprintf(stderr, "workspace too small: need %zu have %zu\n", off, ws_size); return; }

  static int grid_blocks = 0;
  if (!grid_blocks) {
    int dev = 0, cus = 0, per_cu = 0;
    hipGetDevice(&dev);
    hipDeviceGetAttribute(&cus, hipDeviceAttributeMultiprocessorCount, dev);
#if ONE_LAUNCH
    hipOccupancyMaxActiveBlocksPerMultiprocessor(&per_cu, k_mega, 256, 0);
#else
    hipOccupancyMaxActiveBlocksPerMultiprocessor(&per_cu, k_phase, 256, 0);
#endif
    if (per_cu < 1) per_cu = 1;
    if (per_cu > 2) per_cu = 2;
    grid_blocks = cus * per_cu;
  }
#if ONE_LAUNCH
  void* args[] = {&p};
  hipError_t e = hipLaunchCooperativeKernel((void*)k_mega, dim3(grid_blocks), dim3(256), args, 0, stream);
  if (e != hipSuccess) fprintf(stderr, "cooperative launch failed: %s (grid %d)\n", hipGetErrorString(e), grid_blocks);
#else
  k_phase<<<grid_blocks, 256, 0, stream>>>(p, 0, 0);
  k_phase<<<grid_blocks, 256, 0, stream>>>(p, 1, 0);
  for (int l = 0; l < 4; ++l)
    for (int ph = 2; ph <= 8; ++ph) k_phase<<<grid_blocks, 256, 0, stream>>>(p, ph, l);
#endif
}
```

```cpp
#include <hip/hip_runtime.h>
#include <stdint.h>
#include <stdio.h>

#ifndef ONE_LAUNCH
#define ONE_LAUNCH 1
#endif
constexpr int NTHR = 512, NWAVE = 8;
constexpr int STAGE_LDS = 131072, DYN_LDS = STAGE_LDS + 256;

#define DI __device__ __forceinline__
typedef unsigned short u16;
typedef __attribute__((ext_vector_type(8))) short bf16x8;
typedef __attribute__((ext_vector_type(4))) float f32x4;

constexpr int TP = 4096, TS = 8192, TT = 12288, ZW = 2560, NIN = 2688, FF = 2816;
constexpr float EPS = 1e-6f;
constexpr size_t O_YP = 0, O_NA = 12582912, O_GQA = 20971520, O_C = 25165824, O_N = 27262976, O_M = 27295744;
constexpr int SMEM_BYTES = 73728;

struct P {
  const float *x_prompt, *x_sample, *cache_na, *cache_gqa, *stC, *stn, *stm, *c, *c_ctx, *w_in, *b_gates, *w_out,
      *g_norm, *g_qk, *g_ml, *na_bias, *w_ada, *b_ada, *w_gu, *w_down;
  float* out;
  char* ws;
  int nblk, pad_;
  __host__ __device__ __forceinline__ u16* wt_in() const { return (u16*)(ws + 0ull); }
  __host__ __device__ __forceinline__ u16* wt_out() const { return (u16*)(ws + 20971520ull); }
  __host__ __device__ __forceinline__ u16* wt_gu() const { return (u16*)(ws + 29360128ull); }
  __host__ __device__ __forceinline__ u16* wt_down() const { return (u16*)(ws + 75497472ull); }
  __host__ __device__ __forceinline__ float* mods() const { return (float*)(ws + 98566144ull); }
  __host__ __device__ __forceinline__ float* rope() const { return (float*)(ws + 99450880ull); }
  __host__ __device__ __forceinline__ u16* kc_na() const { return (u16*)(ws + 99459072ull); }
  __host__ __device__ __forceinline__ u16* vct_na() const { return (u16*)(ws + 103653376ull); }
  __host__ __device__ __forceinline__ u16* kc_gqa() const { return (u16*)(ws + 107847680ull); }
  __host__ __device__ __forceinline__ u16* vct_gqa() const { return (u16*)(ws + 109944832ull); }
  __host__ __device__ __forceinline__ u16* hn() const { return (u16*)(ws + 112041984ull); }
  __host__ __device__ __forceinline__ u16* zb() const { return (u16*)(ws + 137207808ull); }
  __host__ __device__ __forceinline__ u16* act() const { return (u16*)(ws + 137207808ull); }
  __host__ __device__ __forceinline__ u16* vt_na() const { return (u16*)(ws + 206413824ull); }
  __host__ __device__ __forceinline__ u16* vt_gqa() const { return (u16*)(ws + 212705280ull); }
  __host__ __device__ __forceinline__ u16* kt_ml() const { return (u16*)(ws + 215851008ull); }
  __host__ __device__ __forceinline__ u16* vt_ml() const { return (u16*)(ws + 222142464ull); }
  __host__ __device__ __forceinline__ u16* mix() const { return (u16*)(ws + 228433920ull); }
  __host__ __device__ __forceinline__ float* gates() const { return (float*)(ws + 253599744ull); }
  __host__ __device__ __forceinline__ float* obuf() const { return (float*)(ws + 254386176ull); }
  __host__ __device__ __forceinline__ float* ml_chat() const { return (float*)(ws + 304717824ull); }
  __host__ __device__ __forceinline__ float* ml_nhat() const { return (float*)(ws + 329883648ull); }
  __host__ __device__ __forceinline__ float* ml_ab() const { return (float*)(ws + 330276864ull); }
  __host__ __device__ __forceinline__ float* ml_nst() const { return (float*)(ws + 330289152ull); }
  __host__ __device__ __forceinline__ float* ml_mst() const { return (float*)(ws + 330682368ull); }
  __host__ __device__ __forceinline__ u16* ml_cst() const { return (u16*)(ws + 330688512ull); }
  __host__ __device__ __forceinline__ unsigned* bar() const { return (unsigned*)(ws + 343271424ull); }
};
constexpr size_t WS_TOTAL = 343286272ull;

DI u16 f2bf(float x) { unsigned u = __float_as_uint(x); u += 0x7fffu + ((u >> 16) & 1u); return (u16)(u >> 16); }
DI float bf2f(u16 h) { return __uint_as_float(((unsigned)h) << 16); }
DI unsigned pack2(float a, float b) { return (unsigned)f2bf(a) | ((unsigned)f2bf(b) << 16); }
DI float wave_sum(float v) { for (int o = 32; o >= 1; o >>= 1) v += __shfl_xor(v, o); return v; }
DI float wave_max(float v) { for (int o = 32; o >= 1; o >>= 1) v = fmaxf(v, __shfl_xor(v, o)); return v; }
DI void wave_sync() { __builtin_amdgcn_fence(__ATOMIC_RELEASE, "wavefront"); __builtin_amdgcn_wave_barrier(); __builtin_amdgcn_fence(__ATOMIC_ACQUIRE, "wavefront"); }
#define MFMA16(a, b, c) __builtin_amdgcn_mfma_f32_16x16x32_bf16((a), (b), (c), 0, 0, 0)
DI bf16x8 ld8(const u16* p) { return *(const bf16x8*)p; }
DI bf16x8 ld4x2(const u16* p0, const u16* p1) {
  uint2 a = *(const uint2*)p0, b = *(const uint2*)p1;
  uint4 r; r.x = a.x; r.y = a.y; r.z = b.x; r.w = b.y;
  return __builtin_bit_cast(bf16x8, r);
}
DI bf16x8 pack8(const f32x4& a, const f32x4& b) {
  uint4 r; r.x = pack2(a[0], a[1]); r.y = pack2(a[2], a[3]); r.z = pack2(b[0], b[1]); r.w = pack2(b[2], b[3]);
  return __builtin_bit_cast(bf16x8, r);
}
DI f32x4 zero4() { f32x4 z = {0.f, 0.f, 0.f, 0.f}; return z; }

DI size_t vt_index(int row, int H, int h, int d) {
  if (row < TP) { int b = row >> 8, t = row & 255; return ((size_t)((b * H + h) * 64 + d)) * 256 + t; }
  int r = row - TP; int b = r >> 10, t = r & 1023;
  return (size_t)16 * H * 64 * 256 + ((size_t)((b * H + h) * 64 + d)) * 1024 + t;
}


#define XB_TMO      128
#define XB_XCNT(j)  (256  + 64 * (j))
#define XB_XSUB(j)  (1280 + 64 * (j))
#define XB_XGEN(j)  (2304 + 64 * (j))
#define XB_TOP      3328
#define XB_TOPGEN   3392
#define XCD_BAR_WORDS 3456
#define XB_SPIN_CAP (1u << 20)
#define LAS __attribute__((address_space(3)))
DI unsigned xb_ld(unsigned* p) { return __hip_atomic_load(p, __ATOMIC_RELAXED, __HIP_MEMORY_SCOPE_AGENT); }
DI unsigned xb_add(unsigned* p, unsigned v) { return __hip_atomic_fetch_add(p, v, __ATOMIC_RELAXED, __HIP_MEMORY_SCOPE_AGENT); }
DI unsigned xb_xcc_id() { return (unsigned)__builtin_amdgcn_s_getreg((3 << 11) | 20) & 0xFu; }
#define XB_SPIN(cond, bar) do { unsigned _sp = 0; while (cond) { __builtin_amdgcn_s_sleep(1); \
    if ((++_sp & 255u) == 0u) { if (xb_ld(&(bar)[XB_TMO])) break; if (_sp > XB_SPIN_CAP) { atomicAdd(&(bar)[XB_TMO], 1u); break; } } } } while (0)
struct XcdBarrier { unsigned* bar; unsigned x; unsigned G; volatile LAS unsigned* st; };
DI XcdBarrier xcd_barrier_post(unsigned* bar, volatile LAS unsigned* st, unsigned G) {
  XcdBarrier b; b.bar = bar; b.x = xb_xcc_id(); b.st = st; b.G = G;
  if (threadIdx.x == 0) (void)xb_add(&bar[XB_XCNT(b.x)], 1u);
  return b;
}
DI void xcd_barrier_complete(unsigned* bar, unsigned x, unsigned& nloc, unsigned& nx, unsigned G) {
  unsigned sum, cnt, mine, sp = 0u;
  for (;;) {
    sum = 0u; cnt = 0u; mine = 0u;
#pragma unroll
    for (unsigned j = 0; j < 16; ++j) { const unsigned c = xb_ld(&bar[XB_XCNT(j)]); sum += c; cnt += (c > 0u) ? 1u : 0u; mine = (j == x) ? c : mine; }
    if (sum == G) break;
    __builtin_amdgcn_s_sleep(1);
    if ((++sp & 255u) == 0u) { if (xb_ld(&bar[XB_TMO])) break; if (sp > XB_SPIN_CAP) { atomicAdd(&bar[XB_TMO], 1u); break; } }
  }
  nloc = mine > 0u ? mine : 1u; nx = cnt > 0u ? cnt : 1u;
}
DI void xcd_barrier(const XcdBarrier& b) {
  asm volatile("s_waitcnt vmcnt(0)" ::: "memory");
  __syncthreads();
  if (threadIdx.x == 0) {
    unsigned* bar = b.bar;
    __builtin_amdgcn_s_waitcnt(0);
    unsigned nloc = b.st[0], nx = b.st[1];
    if (nloc == 0u) { xcd_barrier_complete(bar, b.x, nloc, nx, b.G); b.st[0] = nloc; b.st[1] = nx; }
    const unsigned old = xb_add(&bar[XB_XSUB(b.x)], 1u);
    const unsigned gen = old / nloc;
    if (old + 1u == (gen + 1u) * nloc) {
      __builtin_amdgcn_fence(__ATOMIC_RELEASE, "agent");
      asm volatile("s_waitcnt vmcnt(0)" ::: "memory");
      const unsigned og = xb_add(&bar[XB_TOP], 1u);
      const unsigned tg = og / nx;
      if (og + 1u == (tg + 1u) * nx) xb_add(&bar[XB_TOPGEN], 1u);
      else XB_SPIN(xb_ld(&bar[XB_TOPGEN]) == tg, bar);
      __builtin_amdgcn_fence(__ATOMIC_ACQUIRE, "agent");
      xb_add(&bar[XB_XGEN(b.x)], 1u);
      asm volatile("s_waitcnt vmcnt(0)" ::: "memory");
    } else {
      XB_SPIN(xb_ld(&bar[XB_XGEN(b.x)]) == gen, bar);
      __builtin_amdgcn_fence(__ATOMIC_ACQUIRE, "agent");
      asm volatile("s_waitcnt vmcnt(0)" ::: "memory");
    }
  }
  __syncthreads();
}

DI void transpose_tile(const float* __restrict__ src, int ldsrc, int k0, int n0, int mode, int nvalid,
                       u16* __restrict__ dst, int ldd, float* tile, int tid) {
  const int nn = tid & 63, kq = tid >> 6;
  int rr = n0 + nn, col;
  if (mode == 1) {
    int tl = rr >> 8, c = rr & 255, bj = c >> 7, wc = (c >> 5) & 3, w = c & 31;
    col = tl * 128 + wc * 32 + w + bj * FF;
  } else if (mode == 2) {
    int tl = rr >> 8, c = rr & 255, bj = c >> 7, wc = (c >> 5) & 3, w = c & 31;
    col = tl * 256 + wc * 64 + bj * 32 + w;
  } else col = rr < nvalid ? rr : -1;
#pragma unroll
  for (int i = 0; i < 8; ++i) {
    int kk = i * 8 + kq;
    tile[kk * 65 + nn] = col >= 0 ? src[(size_t)(k0 + kk) * ldsrc + col] : 0.f;
  }
  __syncthreads();
  const int k2 = (tid & 31) * 2, nq = tid >> 5;
#pragma unroll
  for (int i = 0; i < 4; ++i) {
    int n = i * 16 + nq;
    *(unsigned*)(dst + (size_t)(n0 + n) * ldd + k0 + k2) = pack2(tile[k2 * 65 + n], tile[(k2 + 1) * 65 + n]);
  }
  __syncthreads();
}

DI void phase_init(const P& p, char* smem, int tid) {
  float* tile = (float*)smem;
  const int NTR = 12032, NCV = 768, NADA = 384;
  const int total = NTR + NCV + NADA + 1;
  for (int it = blockIdx.x; it < total; it += p.nblk) {
    if (it < NTR) {
      int l = it / 3008, r = it % 3008;
      if (r < 640) {
        int kt = r / 40, nt = r % 40;
        transpose_tile(p.w_in + (size_t)l * 1024 * 2576, 2576, kt * 64, nt * 64, 2, 2560, p.wt_in() + (size_t)l * ZW * 1024, 1024, tile, tid);
      } else if (r < 896) {
        int x = r - 640, kt = x / 16, nt = x % 16;
        transpose_tile(p.w_out + (size_t)l * 1024 * 1024, 1024, kt * 64, nt * 64, 0, 1024, p.wt_out() + (size_t)l * 1024 * 1024, 1024, tile, tid);
      } else if (r < 2304) {
        int x = r - 896, kt = x / 88, nt = x % 88;
        transpose_tile(p.w_gu + (size_t)l * 1024 * 5632, 5632, kt * 64, nt * 64, 1, 5632, p.wt_gu() + (size_t)l * 5632 * 1024, 1024, tile, tid);
      } else {
        int x = r - 2304, kt = x / 16, nt = x % 16;
        transpose_tile(p.w_down + (size_t)l * FF * 1024, 1024, kt * 64, nt * 64, 0, 1024, p.wt_down() + (size_t)l * 1024 * FF, FF, tile, tid);
      }
    } else if (it < NTR + NCV) {
      int it2 = it - NTR;
      if (it2 < 512) {
        int idx = it2 >> 2, tt = it2 & 3, bl = idx >> 2, h = idx & 3;
        transpose_tile(p.cache_na + (size_t)((bl * 2 + 1) * 4 + h) * 16384, 64, tt * 64, 0, 0, 64, p.vct_na() + (size_t)idx * 16384, 256, tile, tid);
      } else {
        int it3 = it2 - 512;
        int idx = it3 >> 2, tt = it3 & 3, bl = idx >> 1, h = idx & 1;
        transpose_tile(p.cache_gqa + (size_t)((bl * 2 + 1) * 2 + h) * 16384, 64, tt * 64, 0, 0, 64, p.vct_gqa() + (size_t)idx * 16384, 256, tile, tid);
      }
    } else if (it < NTR + NCV + NADA) {
      int ia = it - NTR - NCV;
      int l = ia / 96, colbase = (ia % 96) * 64;
      float* sl = (float*)smem;
      for (int i = tid; i < 9 * 1024; i += NTHR) {
        int n = i >> 10, d = i & 1023;
        float cv = n == 0 ? p.c_ctx[d] : p.c[(n - 1) * 1024 + d];
        sl[i] = cv / (1.f + __expf(-cv));
      }
      __syncthreads();
      const int col = tid & 63, kg = tid >> 6;
      float acc[9];
#pragma unroll
      for (int n = 0; n < 9; ++n) acc[n] = 0.f;
      const float* w = p.w_ada + ((size_t)l * 1024 + kg * 128) * 6144 + colbase + col;
#pragma unroll 4
      for (int k = 0; k < 128; ++k) {
        float wv = w[(size_t)k * 6144];
#pragma unroll
        for (int n = 0; n < 9; ++n) acc[n] += sl[n * 1024 + kg * 128 + k] * wv;
      }
      float* red = sl + 9216;
#pragma unroll
      for (int n = 0; n < 9; ++n) red[(kg * 9 + n) * 64 + col] = acc[n];
      __syncthreads();
      for (int i = tid; i < 576; i += NTHR) {
        int n = i >> 6, cc = i & 63;
        float s = 0.f;
#pragma unroll
        for (int g = 0; g < 8; ++g) s += red[(g * 9 + n) * 64 + cc];
        p.mods()[(size_t)(l * 9 + n) * 6144 + colbase + cc] = s + p.b_ada[l * 6144 + colbase + cc];
      }
      __syncthreads();
    } else {
      for (int i = tid; i < 1024; i += NTHR) {
        int pos = i >> 4, fi = i & 15;
        float inv = __builtin_amdgcn_exp2f(-(float)fi * 0.8304820237f);
        float ang = (float)pos * inv;
        p.rope()[i] = __cosf(ang);
        p.rope()[1024 + i] = __sinf(ang);
      }
    }
  }
  const int gtid = blockIdx.x * NTHR + tid, gsz = p.nblk * NTHR;
  for (int i = gtid; i < 128 * 4096; i += gsz) {
    int idx = i >> 12, e = (i & 4095) * 4, bl = idx >> 2, h = idx & 3;
    float4 v = *(const float4*)(p.cache_na + (size_t)((bl * 2 + 0) * 4 + h) * 16384 + e);
    uint2 o; o.x = pack2(v.x, v.y); o.y = pack2(v.z, v.w);
    *(uint2*)(p.kc_na() + (size_t)idx * 16384 + e) = o;
  }
  for (int i = gtid; i < 64 * 4096; i += gsz) {
    int idx = i >> 12, e = (i & 4095) * 4, bl = idx >> 1, h = idx & 1;
    float4 v = *(const float4*)(p.cache_gqa + (size_t)((bl * 2 + 0) * 2 + h) * 16384 + e);
    uint2 o; o.x = pack2(v.x, v.y); o.y = pack2(v.z, v.w);
    *(uint2*)(p.kc_gqa() + (size_t)idx * 16384 + e) = o;
  }
}

DI void phase_row(const P& p, int mode, int l, char* smem, int tid) {
  const int lane = tid & 63, wid = tid >> 6;
  const bool last = (mode == 2 && l == 3);
  const int ln = mode == 1 ? l : (mode == 0 ? 0 : l + 1);
  const bool do_gates = (mode != 1) && !last;
  float* Wg = (float*)smem;
  if (do_gates) {
    for (int idx = tid; idx < 16384; idx += NTHR) {
      int k = idx >> 4, g = idx & 15;
      Wg[g * 1024 + k] = p.w_in[((size_t)ln * 1024 + k) * 2576 + 2560 + g];
    }
    __syncthreads();
  }
  for (int row = blockIdx.x * NWAVE + wid; row < TT; row += p.nblk * NWAVE) {
    const int nidx = row < TP ? 0 : 1 + ((row - TP) >> 10);
    float4 x[4];
    float* xrow = p.out + (size_t)row * 1024;
    if (mode == 0) {
      const float* src = row < TP ? p.x_prompt + (size_t)row * 1024 : p.x_sample + (size_t)(row - TP) * 1024;
#pragma unroll
      for (int i = 0; i < 4; ++i) { x[i] = *(const float4*)(src + i * 256 + lane * 4); *(float4*)(xrow + i * 256 + lane * 4) = x[i]; }
    } else {
      const float* orow = p.obuf() + (size_t)row * 1024;
      float4 o[4];
      float ss = 0.f;
#pragma unroll
      for (int i = 0; i < 4; ++i) { o[i] = *(const float4*)(orow + i * 256 + lane * 4); ss += o[i].x * o[i].x + o[i].y * o[i].y + o[i].z * o[i].z + o[i].w * o[i].w; }
      ss = wave_sum(ss);
      const float rs = rsqrtf(ss * (1.f / 1024.f) + EPS);
      const float* ga = p.mods() + ((size_t)(l * 9 + nidx) * 6 + (mode == 1 ? 2 : 5)) * 1024;
      const float* g = p.g_norm + (size_t)(l * 4 + (mode == 1 ? 1 : 3)) * 1024;
#pragma unroll
      for (int i = 0; i < 4; ++i) {
        const int cidx = i * 256 + lane * 4;
        float4 xv = *(const float4*)(xrow + cidx), gav = *(const float4*)(ga + cidx), gv = *(const float4*)(g + cidx);
        xv.x += gav.x * (o[i].x * rs * gv.x); xv.y += gav.y * (o[i].y * rs * gv.y);
        xv.z += gav.z * (o[i].z * rs * gv.z); xv.w += gav.w * (o[i].w * rs * gv.w);
        x[i] = xv;
        *(float4*)(xrow + cidx) = xv;
      }
    }
    if (last) continue;
    const int gi = mode == 1 ? 2 : 0, shi = mode == 1 ? 3 : 0;
    float ss2 = 0.f;
#pragma unroll
    for (int i = 0; i < 4; ++i) ss2 += x[i].x * x[i].x + x[i].y * x[i].y + x[i].z * x[i].z + x[i].w * x[i].w;
    ss2 = wave_sum(ss2);
    const float rs2 = rsqrtf(ss2 * (1.f / 1024.f) + EPS);
    const float* g = p.g_norm + (size_t)(ln * 4 + gi) * 1024;
    const float* sh = p.mods() + ((size_t)(ln * 9 + nidx) * 6 + shi) * 1024;
    const float* sc = sh + 1024;
#pragma unroll
    for (int i = 0; i < 4; ++i) {
      const int cidx = i * 256 + lane * 4;
      float4 gv = *(const float4*)(g + cidx), shv = *(const float4*)(sh + cidx), scv = *(const float4*)(sc + cidx);
      x[i].x = x[i].x * rs2 * gv.x * (1.f + scv.x) + shv.x;
      x[i].y = x[i].y * rs2 * gv.y * (1.f + scv.y) + shv.y;
      x[i].z = x[i].z * rs2 * gv.z * (1.f + scv.z) + shv.z;
      x[i].w = x[i].w * rs2 * gv.w * (1.f + scv.w) + shv.w;
      uint2 o2; o2.x = pack2(x[i].x, x[i].y); o2.y = pack2(x[i].z, x[i].w);
      *(uint2*)(p.hn() + (size_t)row * 1024 + cidx) = o2;
    }
    if (do_gates) {
      float outv = 0.f;
#pragma unroll 1
      for (int g16 = 0; g16 < 16; ++g16) {
        float part = 0.f;
#pragma unroll
        for (int i = 0; i < 4; ++i) {
          const float4 wv = *(const float4*)(Wg + g16 * 1024 + i * 256 + lane * 4);
          part += x[i].x * wv.x + x[i].y * wv.y + x[i].z * wv.z + x[i].w * wv.w;
        }
        part = wave_sum(part);
        if (lane == g16) outv = part;
      }
      if (lane < 16) p.gates()[(size_t)row * 16 + lane] = outv + p.b_gates[ln * 16 + lane];
    }
  }
  if (do_gates) __syncthreads();
}

#define PG8_LAS __attribute__((address_space(3)))
typedef unsigned u32x4 __attribute__((ext_vector_type(4)));
namespace pg8 {
constexpr int BM = 256, BK = 64, HALF = 128, HTB = HALF * BK * 2, NXCD = 8, WGM = 8;
DI int lds_byte(int r, int c) { const int st = (r >> 4) * 2 + (c >> 5), rr = r & 15, cc = c & 31, ob = rr * 64 + cc * 2; return st * 1024 + (ob ^ (((ob >> 9) & 1) << 5)); }
DI void stage_rc(int b, int& R, int& C) { const int st = b / 1024, sb = b % 1024, swz = sb ^ (((sb >> 9) & 1) << 5); R = (st >> 1) * 16 + swz / 64; C = (st & 1) * 32 + (swz % 64) / 2; }
DI int perm32(int rho) { const int n = rho >> 4, i = rho & 15; return 8 * (i >> 2) + 4 * n + (i & 3); }
struct Unit { int pm, pn; };
struct Gemm { const u16* A; const u16* Bt; int M, N, K; };
struct StaticOrder {
  int nM, nN, nwg, G, c;
  DI void init(int M, int N, int G_, int c_) { nM = M / BM; nN = N / BM; nwg = nM * nN; G = G_; c = c_; }
  DI bool next(int i, Unit& u) const {
    const long L = (long)i * G + c; if (L >= nwg) return false;
    int wgid = (int)L; { const int q = nwg / NXCD, r = nwg % NXCD, xcd = wgid % NXCD, off = wgid / NXCD; wgid = (xcd < r ? xcd * (q + 1) : r * (q + 1) + (xcd - r) * q) + off; }
    const int nig = WGM * nN, gid = wgid / nig, fm = gid * WGM, gsz = (nM - fm) < WGM ? (nM - fm) : WGM;
    u.pm = fm + ((wgid % nig) % gsz); u.pn = (wgid % nig) / gsz; return true;
  }
};
DI unsigned cvt_pk_bf16(float lo, float hi) { unsigned r; asm volatile("v_cvt_pk_bf16_f32 %0, %1, %2" : "=v"(r) : "v"(lo), "v"(hi)); return r; }

template <class Epi>
DI void gemm_phase(PG8_LAS unsigned char* lds, const Gemm g, const StaticOrder& S, const Epi& E) {
  int tid = threadIdx.x;
  asm volatile("" : "+v"(tid));
  const int wid = __builtin_amdgcn_readfirstlane(tid >> 6), lane = tid & 63, wr = wid >> 2, wc = wid & 3, fr = lane & 15, fq = lane >> 4;
  const int K = g.K, nt = K / BK;
  unsigned voffA[2], voffB[2];
#pragma unroll
  for (int i = 0; i < 2; ++i) { int R, C; stage_rc(tid * 16 + i * 8192, R, C); const int Rb = Epi::PERM ? ((R & ~31) + perm32(R & 31)) : R;
    voffA[i] = (unsigned)(R * K + C) * 2u; voffB[i] = (unsigned)(Rb * K + C) * 2u; }
  const size_t kstep = (size_t)(BK * 2);
  const size_t hstep = (size_t)HALF * K * 2;
  const size_t tstep = 2 * hstep;
  const unsigned ldsw = (unsigned)wid * 1024u;
  const int aoff = lds_byte(wr * 64 + fr, fq * 8), boff = lds_byte(wc * 32 + fr, fq * 8);
#define PG8_SA(b, h) (((b) * 2 + (h)) * HTB)
#define PG8_SB(b, h) ((4 + (b) * 2 + (h)) * HTB)
#define PG8_STAGE(bufoff, gbase, voff) do { _Pragma("unroll") for (int _i = 0; _i < 2; ++_i) \
    __builtin_amdgcn_global_load_lds((const unsigned*)((const char*)(gbase) + (voff)[_i]), (PG8_LAS unsigned*)(lds + (bufoff) + ldsw + _i * 8192), 16, 0, 0); } while (0)
#define PG8_LDA(dst, b, h) do { _Pragma("unroll") for (int m = 0; m < 4; ++m) _Pragma("unroll") for (int k = 0; k < 2; ++k) dst[m][k] = *(const PG8_LAS bf16x8*)(lds + PG8_SA(b, h) + aoff + m * 2048 + k * 1024); } while (0)
#define PG8_LDB(dst, b, h) do { _Pragma("unroll") for (int n = 0; n < 2; ++n) _Pragma("unroll") for (int k = 0; k < 2; ++k) dst[n][k] = *(const PG8_LAS bf16x8*)(lds + PG8_SB(b, h) + boff + n * 2048 + k * 1024); } while (0)
#define PG8_MMA(ai, bj, At, Bt) do { __builtin_amdgcn_s_setprio(1); _Pragma("unroll") for (int m = 0; m < 4; ++m) _Pragma("unroll") for (int n = 0; n < 2; ++n) _Pragma("unroll") for (int k = 0; k < 2; ++k) \
    acc[ai][bj][m][n] = __builtin_amdgcn_mfma_f32_16x16x32_bf16(Bt[n][k], At[m][k], acc[ai][bj][m][n], 0, 0, 0); __builtin_amdgcn_s_setprio(0); } while (0)
#define PG8_WAIT_V(n) asm volatile("s_waitcnt vmcnt(" #n ")" ::: "memory")
#define PG8_WAIT_L(n) asm volatile("s_waitcnt lgkmcnt(" #n ")" ::: "memory")
#define PG8_BAR __builtin_amdgcn_s_barrier()
#define PG8_SCHED __builtin_amdgcn_sched_barrier(0)
  Unit cur, nxt; int ui = 0;
  if (!S.next(0, cur)) return;
  f32x4 acc[2][2][4][2];
#pragma unroll
  for (int a = 0; a < 2; ++a)
#pragma unroll
    for (int b = 0; b < 2; ++b)
#pragma unroll
      for (int m = 0; m < 4; ++m)
#pragma unroll
        for (int n = 0; n < 2; ++n) acc[a][b][m][n] = (f32x4){0.f, 0.f, 0.f, 0.f};
  bf16x8 At[4][2], B0[2][2], B1[2][2];
  const char* cA = (const char*)g.A + (size_t)cur.pm * tstep; const char* cB = (const char*)g.Bt + (size_t)cur.pn * tstep;
  PG8_STAGE(PG8_SB(0, 0), cB, voffB); PG8_STAGE(PG8_SA(0, 0), cA, voffA); PG8_STAGE(PG8_SB(0, 1), cB + hstep, voffB); PG8_STAGE(PG8_SA(0, 1), cA + hstep, voffA);
  if (wr == 1) PG8_BAR;
  PG8_WAIT_V(4); PG8_BAR;
  PG8_STAGE(PG8_SB(1, 0), cB + kstep, voffB); PG8_STAGE(PG8_SA(1, 0), cA + kstep, voffA); PG8_STAGE(PG8_SB(1, 1), cB + hstep + kstep, voffB);
  PG8_WAIT_V(6); PG8_BAR;
  for (;;) {
    const bool has_next = S.next(ui + 1, nxt);
    const char* nA = has_next ? (const char*)g.A + (size_t)nxt.pm * tstep : cA; const char* nB = has_next ? (const char*)g.Bt + (size_t)nxt.pn * tstep : cB;
    for (int t = 0; t < nt; t += 2) {
      const bool last = (t == nt - 2);
      const char* a1 = cA + (size_t)(t + 1) * kstep;
      const char* a2 = last ? nA : cA + (size_t)(t + 2) * kstep; const char* b2 = last ? nB : cB + (size_t)(t + 2) * kstep;
      const char* a3 = a2 + kstep; const char* b3 = b2 + kstep;
      PG8_LDB(B0, 0, 0); PG8_SCHED; PG8_LDA(At, 0, 0); PG8_STAGE(PG8_SA(1, 1), a1 + hstep, voffA);
      PG8_WAIT_L(8); PG8_BAR; PG8_WAIT_L(0); PG8_MMA(0, 0, At, B0); PG8_BAR; PG8_SCHED;
      PG8_LDB(B1, 0, 1); PG8_STAGE(PG8_SB(0, 0), b2, voffB);
      PG8_BAR; PG8_WAIT_L(0); PG8_MMA(0, 1, At, B1); PG8_BAR;
      PG8_LDA(At, 0, 1); PG8_STAGE(PG8_SA(0, 0), a2, voffA);
      PG8_BAR; PG8_WAIT_L(0); PG8_MMA(1, 0, At, B0); PG8_BAR; PG8_SCHED;
      PG8_STAGE(PG8_SB(0, 1), b2 + hstep, voffB);
      PG8_WAIT_V(6); PG8_BAR; PG8_MMA(1, 1, At, B1); PG8_BAR;
      PG8_LDB(B0, 1, 0); PG8_SCHED; PG8_LDA(At, 1, 0); PG8_STAGE(PG8_SA(0, 1), a2 + hstep, voffA);
      PG8_WAIT_L(8); PG8_BAR; PG8_WAIT_L(0); PG8_MMA(0, 0, At, B0); PG8_BAR; PG8_SCHED;
      PG8_LDB(B1, 1, 1); PG8_STAGE(PG8_SB(1, 0), b3, voffB);
      PG8_BAR; PG8_WAIT_L(0); PG8_MMA(0, 1, At, B1); PG8_BAR;
      PG8_LDA(At, 1, 1); PG8_STAGE(PG8_SA(1, 0), a3, voffA);
      PG8_BAR; PG8_WAIT_L(0); PG8_MMA(1, 0, At, B0); PG8_BAR; PG8_SCHED;
      PG8_STAGE(PG8_SB(1, 1), b3 + hstep, voffB);
      PG8_WAIT_V(6); PG8_BAR; PG8_MMA(1, 1, At, B1); PG8_BAR;
    }
    E(acc, cur, wr, wc, fr, fq);
    if (!has_next) break;
#pragma unroll
    for (int a = 0; a < 2; ++a)
#pragma unroll
      for (int b = 0; b < 2; ++b)
#pragma unroll
        for (int m = 0; m < 4; ++m)
#pragma unroll
          for (int n = 0; n < 2; ++n) acc[a][b][m][n] = (f32x4){0.f, 0.f, 0.f, 0.f};
    cur = nxt; cA = nA; cB = nB; ++ui;
  }
  PG8_WAIT_V(0);
  if (wr == 0) PG8_BAR;
  PG8_BAR;
#undef PG8_SA
#undef PG8_SB
#undef PG8_STAGE
#undef PG8_LDA
#undef PG8_LDB
#undef PG8_MMA
#undef PG8_WAIT_V
#undef PG8_WAIT_L
#undef PG8_BAR
#undef PG8_SCHED
}
}

struct EpiF32 {
  static constexpr bool PERM = false;
  float* C;
  DI void operator()(const f32x4 (&acc)[2][2][4][2], const pg8::Unit& u, int wr, int wc, int fr, int fq) const {
    const int row0 = u.pm * 256 + wr * 64 + fr, col0 = u.pn * 256 + wc * 32 + 4 * fq;
#pragma unroll
    for (int ai = 0; ai < 2; ++ai)
#pragma unroll
      for (int m = 0; m < 4; ++m) {
        float* rowp = C + (size_t)(row0 + ai * 128 + m * 16) * 1024 + col0;
#pragma unroll
        for (int bj = 0; bj < 2; ++bj)
#pragma unroll
          for (int n = 0; n < 2; ++n) *(f32x4*)(rowp + bj * 128 + n * 16) = acc[ai][bj][m][n];
      }
  }
};

struct EpiGU {
  static constexpr bool PERM = true;
  u16* act;
  DI void operator()(const f32x4 (&acc)[2][2][4][2], const pg8::Unit& u, int wr, int wc, int fr, int fq) const {
    const int row0 = u.pm * 256 + wr * 64 + fr, col0 = u.pn * 128 + wc * 32 + 8 * fq;
#pragma unroll
    for (int ai = 0; ai < 2; ++ai)
#pragma unroll
      for (int m = 0; m < 4; ++m) {
        float r[8];
#pragma unroll
        for (int n = 0; n < 2; ++n)
#pragma unroll
          for (int j = 0; j < 4; ++j) {
            const float g = acc[ai][0][m][n][j], up = acc[ai][1][m][n][j];
            r[n * 4 + j] = g * __builtin_amdgcn_rcpf(1.f + __expf(-g)) * up;
          }
        u32x4 w; w.x = pg8::cvt_pk_bf16(r[0], r[1]); w.y = pg8::cvt_pk_bf16(r[2], r[3]); w.z = pg8::cvt_pk_bf16(r[4], r[5]); w.w = pg8::cvt_pk_bf16(r[6], r[7]);
        *(u32x4*)(act + (size_t)(row0 + ai * 128 + m * 16) * FF + col0) = w;
      }
  }
};

struct EpiIn {
  static constexpr bool PERM = false;
  const P* pp; int l;
  DI void operator()(const f32x4 (&acc)[2][2][4][2], const pg8::Unit& u, int wr, int wc, int fr, int fq) const {
    const P& p = *pp;
    const int c0 = u.pn * 256 + wc * 64;
    const int rb = u.pm * 256 + wr * 64 + fr;
    const bool prm = u.pm * 256 < TP;
    int region, hh;
    if (c0 < 256) { region = 0; hh = c0 >> 6; }
    else if (c0 < 512) { region = 1; hh = (c0 - 256) >> 6; }
    else if (c0 < 768) { region = 2; hh = (c0 - 512) >> 6; }
    else if (c0 < 1280) { region = 3; hh = (c0 - 768) >> 6; }
    else if (c0 < 1408) { region = 4; hh = (c0 - 1280) >> 6; }
    else if (c0 < 1536) { region = 5; hh = (c0 - 1408) >> 6; }
    else if (c0 < 1792) { region = 6; hh = (c0 - 1536) >> 6; }
    else if (c0 < 2048) { region = 7; hh = (c0 - 1792) >> 6; }
    else if (c0 < 2304) { region = 8; hh = (c0 - 2048) >> 6; }
    else { region = 9; hh = (c0 - 2304) >> 6; }
    const unsigned dl = fq * 4;
    if (region == 2 || region == 5 || region == 8 || region == 7) {
      u16* vt = region == 2 ? p.vt_na() : (region == 5 ? p.vt_gqa() : (region == 7 ? p.kt_ml() : p.vt_ml()));
      const int H = region == 5 ? 2 : 4;
      const float mul = region == 7 ? 0.125f : 1.f;
      const unsigned Tlen = prm ? 256u : 1024u;
#pragma unroll
      for (int ai = 0; ai < 2; ++ai)
#pragma unroll
        for (int m = 0; m < 4; ++m) {
          const int row = rb + ai * 128 + m * 16;
          unsigned vbase;
          if (prm) vbase = (unsigned)(((row >> 8) * H + hh) * 64) * 256u + (unsigned)(row & 255);
          else { const int r = row - TP; vbase = (unsigned)(16 * H * 64 * 256) + (unsigned)((((r >> 10) * H + hh) * 64)) * 1024u + (unsigned)(r & 1023); }
          u16* vp = vt + vbase + dl * Tlen;
#pragma unroll
          for (int bj = 0; bj < 2; ++bj)
#pragma unroll
            for (int n = 0; n < 2; ++n)
#pragma unroll
              for (int j = 0; j < 4; ++j) vp[(unsigned)(bj * 32 + n * 16 + j) * Tlen] = f2bf(acc[ai][bj][m][n][j] * mul);
        }
    }
    if (prm && (region == 1 || region == 2 || region == 5)) {
#pragma unroll
      for (int ai = 0; ai < 2; ++ai)
#pragma unroll
        for (int m = 0; m < 4; ++m) {
          const int row = rb + ai * 128 + m * 16, b = row >> 8, t = row & 255;
          unsigned base;
          if (region == 5) base = (unsigned)O_GQA + (unsigned)((((b * 4 + l) * 2 + 1) * 2 + hh) * 256 + t) * 64u;
          else base = (unsigned)O_NA + (unsigned)((((b * 4 + l) * 2 + (region == 2 ? 1 : 0)) * 4 + hh) * 256 + t) * 64u;
          float* op = p.out + base + dl;
#pragma unroll
          for (int bj = 0; bj < 2; ++bj)
#pragma unroll
            for (int n = 0; n < 2; ++n) *(f32x4*)(op + bj * 32 + n * 16) = acc[ai][bj][m][n];
        }
    }
    if (region == 2 || region == 5 || region == 8) return;
    if (region == 3 || region == 4) {
      const float* gq = p.g_qk + (l * 2 + (region == 4 ? 1 : 0)) * 64 + dl;
      f32x4 gv[2][2];
#pragma unroll
      for (int bj = 0; bj < 2; ++bj)
#pragma unroll
        for (int n = 0; n < 2; ++n) gv[bj][n] = *(const f32x4*)(gq + bj * 32 + n * 16);
#pragma unroll
      for (int ai = 0; ai < 2; ++ai)
#pragma unroll
        for (int m = 0; m < 4; ++m) {
          const int row = rb + ai * 128 + m * 16;
          f32x4 v[2][2];
          float ss = 0.f;
#pragma unroll
          for (int bj = 0; bj < 2; ++bj)
#pragma unroll
            for (int n = 0; n < 2; ++n) {
              v[bj][n] = acc[ai][bj][m][n];
#pragma unroll
              for (int j = 0; j < 4; ++j) ss += v[bj][n][j] * v[bj][n][j];
            }
          ss += __shfl_xor(ss, 16);
          ss += __shfl_xor(ss, 32);
          const float rs = rsqrtf(ss * (1.f / 64.f) + EPS);
#pragma unroll
          for (int bj = 0; bj < 2; ++bj)
#pragma unroll
            for (int n = 0; n < 2; ++n) v[bj][n] = v[bj][n] * rs * gv[bj][n];
          if (prm) {
            if (region == 4) {
              const int b = row >> 8, t = row & 255;
              float* op = p.out + (unsigned)O_GQA + (unsigned)((((b * 4 + l) * 2 + 0) * 2 + hh) * 256 + t) * 64u + dl;
#pragma unroll
              for (int bj = 0; bj < 2; ++bj)
#pragma unroll
                for (int n = 0; n < 2; ++n) *(f32x4*)(op + bj * 32 + n * 16) = v[bj][n];
            }
          } else {
            const int t = (row - TP) & 1023, pr = t >> 6, pc = t & 63;
#pragma unroll
            for (int bj = 0; bj < 2; ++bj) {
              const int pos = bj ? pc : pr;
              const f32x4 cs = *(const f32x4*)(p.rope() + pos * 16 + dl), sn = *(const f32x4*)(p.rope() + 1024 + pos * 16 + dl);
              const f32x4 x1 = v[bj][0], x2 = v[bj][1];
              v[bj][0] = x1 * cs - x2 * sn;
              v[bj][1] = x2 * cs + x1 * sn;
            }
          }
          u16* zp = p.zb() + (unsigned)row * (unsigned)ZW + (unsigned)c0 + dl;
#pragma unroll
          for (int bj = 0; bj < 2; ++bj)
#pragma unroll
            for (int n = 0; n < 2; ++n) {
              uint2 w; w.x = pg8::cvt_pk_bf16(v[bj][n][0], v[bj][n][1]); w.y = pg8::cvt_pk_bf16(v[bj][n][2], v[bj][n][3]);
              *(uint2*)(zp + bj * 32 + n * 16) = w;
            }
        }
      return;
    }
    {
      const float mul = region == 7 ? 0.125f : 1.f;
#pragma unroll
      for (int ai = 0; ai < 2; ++ai)
#pragma unroll
        for (int m = 0; m < 4; ++m) {
          const int row = rb + ai * 128 + m * 16;
          u16* zp = p.zb() + (unsigned)row * (unsigned)ZW + (unsigned)c0 + dl;
#pragma unroll
          for (int bj = 0; bj < 2; ++bj)
#pragma unroll
            for (int n = 0; n < 2; ++n) {
              const f32x4 v = acc[ai][bj][m][n] * mul;
              uint2 w; w.x = pg8::cvt_pk_bf16(v[0], v[1]); w.y = pg8::cvt_pk_bf16(v[2], v[3]);
              *(uint2*)(zp + bj * 32 + n * 16) = w;
            }
        }
    }
  }
};

DI void phase_gemm(const P& p, int which, int l, char* smem) {
  PG8_LAS unsigned char* lds = (PG8_LAS unsigned char*)smem;
  pg8::StaticOrder S;
  pg8::Gemm g;
  if (which == 0) {
    g.A = p.hn(); g.Bt = p.wt_in() + (size_t)l * ZW * 1024; g.M = TT; g.N = ZW; g.K = 1024;
    S.init(g.M, g.N, p.nblk, blockIdx.x);
    EpiIn E; E.pp = &p; E.l = l;
    pg8::gemm_phase(lds, g, S, E);
  } else if (which == 1) {
    g.A = p.mix(); g.Bt = p.wt_out() + (size_t)l * 1024 * 1024; g.M = TT; g.N = 1024; g.K = 1024;
    S.init(g.M, g.N, p.nblk, blockIdx.x);
    EpiF32 E; E.C = p.obuf();
    pg8::gemm_phase(lds, g, S, E);
  } else if (which == 2) {
    g.A = p.hn(); g.Bt = p.wt_gu() + (size_t)l * 5632 * 1024; g.M = TT; g.N = 5632; g.K = 1024;
    S.init(g.M, g.N, p.nblk, blockIdx.x);
    EpiGU E; E.act = p.act();
    pg8::gemm_phase(lds, g, S, E);
  } else {
    g.A = p.act(); g.Bt = p.wt_down() + (size_t)l * 1024 * FF; g.M = TT; g.N = 1024; g.K = FF;
    S.init(g.M, g.N, p.nblk, blockIdx.x);
    EpiF32 E; E.C = p.obuf();
    pg8::gemm_phase(lds, g, S, E);
  }
}

template <bool WIN>
DI void attn_seg(const u16* __restrict__ K, int ldk, const u16* __restrict__ V, int ldv, int nkeys, const bf16x8 (&qf)[4][2],
                 f32x4 (&o)[4][4], float (&m)[4], float (&lsum)[4], const float* __restrict__ bias, int rdelta, int fr, int fq) {
  const float L2E = 1.44269504f;
  for (int key0 = 0; key0 < nkeys; key0 += 32) {
    bf16x8 kf[2][2];
#pragma unroll
    for (int mt = 0; mt < 2; ++mt)
#pragma unroll
      for (int ks = 0; ks < 2; ++ks) kf[mt][ks] = ld8(K + (size_t)(key0 + mt * 16 + fr) * ldk + ks * 32 + fq * 8);
    bf16x8 va[4];
#pragma unroll
    for (int dt = 0; dt < 4; ++dt) {
      const u16* vp = V + (size_t)(dt * 16 + fr) * ldv + key0 + fq * 4;
      va[dt] = ld4x2(vp, vp + 16);
    }
    f32x4 s[2][4];
#pragma unroll
    for (int mt = 0; mt < 2; ++mt)
#pragma unroll
      for (int nt = 0; nt < 4; ++nt) {
        s[mt][nt] = zero4();
#pragma unroll
        for (int ks = 0; ks < 2; ++ks) s[mt][nt] = MFMA16(kf[mt][ks], qf[nt][ks], s[mt][nt]);
      }
    if (WIN) {
      const int krel = key0 >> 6, ckb = key0 & 63;
      const float* brow = bias + (rdelta + krel) * 31;
#pragma unroll
      for (int nt = 0; nt < 4; ++nt) {
        const int cq = nt * 16 + fr;
        const int cw = min(max(cq - 8, 0), 48);
#pragma unroll
        for (int mt = 0; mt < 2; ++mt)
#pragma unroll
          for (int j = 0; j < 4; ++j) {
            const int ck = ckb + mt * 16 + fq * 4 + j;
            const bool valid = (ck >= cw) && (ck < cw + 16);
            const int dc = min(max(ck - cq, -15), 15) + 15;
            const float bv = brow[dc];
            s[mt][nt][j] = valid ? (s[mt][nt][j] * 0.125f + bv) * L2E : -INFINITY;
          }
      }
    } else {
#pragma unroll
      for (int mt = 0; mt < 2; ++mt)
#pragma unroll
        for (int nt = 0; nt < 4; ++nt) s[mt][nt] *= (0.125f * L2E);
    }
    bf16x8 pb[4];
#pragma unroll
    for (int nt = 0; nt < 4; ++nt) {
      float tm = fmaxf(fmaxf(fmaxf(s[0][nt][0], s[0][nt][1]), fmaxf(s[0][nt][2], s[0][nt][3])),
                       fmaxf(fmaxf(s[1][nt][0], s[1][nt][1]), fmaxf(s[1][nt][2], s[1][nt][3])));
      tm = fmaxf(tm, __shfl_xor(tm, 16));
      tm = fmaxf(tm, __shfl_xor(tm, 32));
      const float mn = fmaxf(m[nt], tm);
      const float alpha = __builtin_amdgcn_exp2f(m[nt] - mn);
      m[nt] = mn;
      float ps = 0.f;
#pragma unroll
      for (int mt = 0; mt < 2; ++mt)
#pragma unroll
        for (int j = 0; j < 4; ++j) { float pv = __builtin_amdgcn_exp2f(s[mt][nt][j] - mn); s[mt][nt][j] = pv; ps += pv; }
      lsum[nt] = lsum[nt] * alpha + ps;
#pragma unroll
      for (int dt = 0; dt < 4; ++dt) o[dt][nt] *= alpha;
      pb[nt] = pack8(s[0][nt], s[1][nt]);
    }
#pragma unroll
    for (int dt = 0; dt < 4; ++dt)
#pragma unroll
      for (int nt = 0; nt < 4; ++nt) o[dt][nt] = MFMA16(va[dt], pb[nt], o[dt][nt]);
  }
}

template <bool WIN>
DI void attn_wave(const u16* Q, int ldq, const u16* K0, int ldk0, const u16* V0, int ldv0, int n0, const u16* K1, int ldk1,
                  const u16* V1, int ldv1, int n1, u16* O, int ldo, const float* bias, int rdelta, int lane) {
  const int fr = lane & 15, fq = lane >> 4;
  bf16x8 qf[4][2];
#pragma unroll
  for (int nt = 0; nt < 4; ++nt)
#pragma unroll
    for (int ks = 0; ks < 2; ++ks) qf[nt][ks] = ld8(Q + (size_t)(nt * 16 + fr) * ldq + ks * 32 + fq * 8);
  f32x4 o[4][4];
  float m[4], lsum[4];
#pragma unroll
  for (int i = 0; i < 4; ++i) {
    m[i] = -1e30f; lsum[i] = 0.f;
#pragma unroll
    for (int j = 0; j < 4; ++j) o[i][j] = zero4();
  }
  attn_seg<WIN>(K0, ldk0, V0, ldv0, n0, qf, o, m, lsum, bias, rdelta, fr, fq);
  if (n1 > 0) attn_seg<false>(K1, ldk1, V1, ldv1, n1, qf, o, m, lsum, bias, rdelta, fr, fq);
#pragma unroll
  for (int nt = 0; nt < 4; ++nt) {
    float lt = lsum[nt];
    lt += __shfl_xor(lt, 16);
    lt += __shfl_xor(lt, 32);
    const float inv = 1.f / lt;
#pragma unroll
    for (int dt = 0; dt < 4; ++dt) {
      uint2 w; w.x = pack2(o[dt][nt][0] * inv, o[dt][nt][1] * inv); w.y = pack2(o[dt][nt][2] * inv, o[dt][nt][3] * inv);
      *(uint2*)(O + (size_t)(nt * 16 + fr) * ldo + dt * 16 + fq * 4) = w;
    }
  }
}

DI float logsig(float x) { return fminf(x, 0.f) - __logf(1.f + __expf(-fabsf(x))); }

DI void mlstm_item(const P& p, int l, int u, char* smem, int tid) {
  const int wid = tid >> 6;
  const bool samp = u < 32;
  int b, h, NC, rowbase, ldT, cs0;
  size_t tb;
  if (samp) { b = u >> 2; h = u & 3; NC = 16; rowbase = TP + b * 1024; ldT = 1024; tb = 1048576 + (size_t)((b * 4 + h) * 64) * 1024; cs0 = u * 32; }
  else { int v = u - 32; b = v >> 2; h = v & 3; NC = 4; rowbase = b * 256; ldT = 256; tb = (size_t)((b * 4 + h) * 64) * 256; cs0 = 1024 + v * 8; }
  float* fl = (float*)smem + wid * 768;
  float* W = fl;
  float* U = fl + 64;
  float* MX = fl + 192;
  float* DEC = fl + 320;
  float* EN = fl + 448;
  float* NQ = fl + 576;

#ifndef MLS
#define MLS 7
#endif
  if (MLS & 1)
  for (int cd = wid; cd < NC * 2; cd += 8) {
    int lane = tid & 63;
    asm volatile("" : "+v"(lane));
    const int fr = lane & 15, fq = lane >> 4;
    const int j = cd >> 1, dir = cd & 1;
    const int cs = cs0 + dir * NC + j;
    const int row = rowbase + j * 64 + lane;
    const float gi = p.gates()[(size_t)row * 16 + dir * 8 + h], gf = p.gates()[(size_t)row * 16 + dir * 8 + 4 + h];
    float bb = logsig(gf);
    if (dir == 0) {
#pragma unroll
      for (int off = 1; off < 64; off <<= 1) { float t = __shfl_up(bb, off); if (lane >= off) bb += t; }
    } else {
#pragma unroll
      for (int off = 1; off < 64; off <<= 1) { float t = __shfl_down(bb, off); if (lane + off < 64) bb += t; }
    }
    const float bend = __shfl(bb, dir ? 0 : 63);
    const float lw = bend - bb + gi;
    const float a = wave_max(lw);
    W[lane] = __expf(lw - a);
    wave_sync();
    f32x4 acc[4][4];
#pragma unroll
    for (int i = 0; i < 4; ++i)
#pragma unroll
      for (int jj = 0; jj < 4; ++jj) acc[i][jj] = zero4();
    const u16* vt = p.vt_ml() + tb + j * 64;
    const u16* kt = p.kt_ml() + tb + j * 64;
#pragma unroll 1
    for (int ks = 0; ks < 2; ++ks) {
      const float4 w0 = *(const float4*)(W + ks * 32 + fq * 8), w1 = *(const float4*)(W + ks * 32 + fq * 8 + 4);
      bf16x8 af[4], bfr[4];
#pragma unroll
      for (int mt = 0; mt < 4; ++mt) {
        bf16x8 raw = ld8(vt + (size_t)(mt * 16 + fr) * ldT + ks * 32 + fq * 8);
        f32x4 lo, hi;
        lo[0] = bf2f((u16)raw[0]) * w0.x; lo[1] = bf2f((u16)raw[1]) * w0.y; lo[2] = bf2f((u16)raw[2]) * w0.z; lo[3] = bf2f((u16)raw[3]) * w0.w;
        hi[0] = bf2f((u16)raw[4]) * w1.x; hi[1] = bf2f((u16)raw[5]) * w1.y; hi[2] = bf2f((u16)raw[6]) * w1.z; hi[3] = bf2f((u16)raw[7]) * w1.w;
        af[mt] = pack8(lo, hi);
      }
#pragma unroll
      for (int nt = 0; nt < 4; ++nt) bfr[nt] = ld8(kt + (size_t)(nt * 16 + fr) * ldT + ks * 32 + fq * 8);
#pragma unroll
      for (int mt = 0; mt < 4; ++mt)
#pragma unroll
        for (int nt = 0; nt < 4; ++nt) acc[mt][nt] = MFMA16(af[mt], bfr[nt], acc[mt][nt]);
    }
    float* ch = p.ml_chat() + (size_t)cs * 4096;
#pragma unroll
    for (int mt = 0; mt < 4; ++mt)
#pragma unroll
      for (int nt = 0; nt < 4; ++nt)
#pragma unroll
        for (int jj = 0; jj < 4; ++jj) ch[(mt * 16 + fq * 4 + jj) * 64 + nt * 16 + fr] = acc[mt][nt][jj];
    float nh = 0.f;
    const u16* kr = kt + (size_t)lane * ldT;
#pragma unroll 1
    for (int c8 = 0; c8 < 8; ++c8) {
      bf16x8 kk = ld8(kr + c8 * 8);
      const float4 wa = *(const float4*)(W + c8 * 8), wb = *(const float4*)(W + c8 * 8 + 4);
      nh += bf2f((u16)kk[0]) * wa.x + bf2f((u16)kk[1]) * wa.y + bf2f((u16)kk[2]) * wa.z + bf2f((u16)kk[3]) * wa.w;
      nh += bf2f((u16)kk[4]) * wb.x + bf2f((u16)kk[5]) * wb.y + bf2f((u16)kk[6]) * wb.z + bf2f((u16)kk[7]) * wb.w;
    }
    p.ml_nhat()[(size_t)cs * 64 + lane] = nh;
    if (lane == 0) { p.ml_ab()[cs * 2] = a; p.ml_ab()[cs * 2 + 1] = bend; }
    wave_sync();
  }
  __syncthreads();

  if (MLS & 2) {
    const int e0 = tid * 8;
    for (int dir = 0; dir < 2; ++dir) {
      float C[8];
      float n = 0.f, m = 0.f;
      const int sidx = ((b * 4 + l) * 2 + dir) * 4 + h;
      if (samp) {
#pragma unroll
        for (int i = 0; i < 2; ++i) {
          float4 v = *(const float4*)(p.stC + (size_t)sidx * 4096 + e0 + i * 4);
          C[i * 4] = v.x; C[i * 4 + 1] = v.y; C[i * 4 + 2] = v.z; C[i * 4 + 3] = v.w;
        }
        if (tid < 64) n = p.stn[sidx * 64 + tid];
        m = p.stm[sidx];
      } else {
#pragma unroll
        for (int i = 0; i < 8; ++i) { float z = 0.f; asm volatile("" : "+v"(z)); C[i] = z; }
      }
      for (int c = 0; c < NC; ++c) {
        const int j = dir ? NC - 1 - c : c;
        const int cs = cs0 + dir * NC + j;
        uint4 w0;
        w0.x = pack2(C[0], C[1]); w0.y = pack2(C[2], C[3]); w0.z = pack2(C[4], C[5]); w0.w = pack2(C[6], C[7]);
        *(uint4*)(p.ml_cst() + (size_t)cs * 4096 + e0) = w0;
        if (tid < 64) p.ml_nst()[(size_t)cs * 64 + tid] = n;
        if (tid == 0) p.ml_mst()[cs] = m;
        const float a = p.ml_ab()[cs * 2], be = p.ml_ab()[cs * 2 + 1];
        const float mn = fmaxf(be + m, a);
        const float carry = __expf(be + m - mn), beta = __expf(a - mn);
        const float* ch = p.ml_chat() + (size_t)cs * 4096 + e0;
#pragma unroll
        for (int i = 0; i < 2; ++i) {
          float4 v = *(const float4*)(ch + i * 4);
          C[i * 4] = carry * C[i * 4] + beta * v.x; C[i * 4 + 1] = carry * C[i * 4 + 1] + beta * v.y;
          C[i * 4 + 2] = carry * C[i * 4 + 2] + beta * v.z; C[i * 4 + 3] = carry * C[i * 4 + 3] + beta * v.w;
        }
        if (tid < 64) n = carry * n + beta * p.ml_nhat()[(size_t)cs * 64 + tid];
        m = mn;
      }
      if (!samp) {
        float* oc = p.out + O_C + (size_t)sidx * 4096 + e0;
#pragma unroll
        for (int i = 0; i < 2; ++i) { float4 v; v.x = C[i * 4]; v.y = C[i * 4 + 1]; v.z = C[i * 4 + 2]; v.w = C[i * 4 + 3]; *(float4*)(oc + i * 4) = v; }
        if (tid < 64) p.out[O_N + (size_t)sidx * 64 + tid] = n;
        if (tid == 0) p.out[O_M + sidx] = m;
      }
    }
  }
  __syncthreads();

  if (MLS & 4)
  for (int j = wid; j < NC; j += 8) {
    int lane = tid & 63;
    asm volatile("" : "+v"(lane));
    const int fr = lane & 15, fq = lane >> 4;
    const int row = rowbase + j * 64 + lane;
    for (int dir = 0; dir < 2; ++dir) {
      const int cs = cs0 + dir * NC + j;
      const float m0 = p.ml_mst()[cs];
      const float gi = p.gates()[(size_t)row * 16 + dir * 8 + h], gf = p.gates()[(size_t)row * 16 + dir * 8 + 4 + h];
      float bb = logsig(gf);
      if (dir == 0) {
#pragma unroll
        for (int off = 1; off < 64; off <<= 1) { float t = __shfl_up(bb, off); if (lane >= off) bb += t; }
      } else {
#pragma unroll
        for (int off = 1; off < 64; off <<= 1) { float t = __shfl_down(bb, off); if (lane + off < 64) bb += t; }
      }
      const float uu = gi - bb;
      float cm = uu;
      if (dir == 0) {
#pragma unroll
        for (int off = 1; off < 64; off <<= 1) { float t = __shfl_up(cm, off); if (lane >= off) cm = fmaxf(cm, t); }
      } else {
#pragma unroll
        for (int off = 1; off < 64; off <<= 1) { float t = __shfl_down(cm, off); if (lane + off < 64) cm = fmaxf(cm, t); }
      }
      const float M = fmaxf(cm, m0);
      U[dir * 64 + lane] = uu;
      MX[dir * 64 + lane] = M;
      DEC[dir * 64 + lane] = __expf(m0 - M);
      EN[dir * 64 + lane] = __expf(-(bb + M));
      const u16* qr = p.zb() + (size_t)row * ZW + 1536 + h * 64;
      const float* ns = p.ml_nst() + (size_t)cs * 64;
      float nq = 0.f;
#pragma unroll
      for (int c8 = 0; c8 < 8; ++c8) {
        bf16x8 qq = ld8(qr + c8 * 8);
#pragma unroll
        for (int jj = 0; jj < 8; ++jj) nq += bf2f((u16)qq[jj]) * ns[c8 * 8 + jj];
      }
      NQ[dir * 64 + lane] = nq;
    }
    wave_sync();
#pragma unroll 1
    for (int half = 0; half < 2; ++half) {
      int lane_h = lane;
      asm volatile("" : "+v"(lane_h));
      const int fr = lane_h & 15, fq = lane_h >> 4;
      bf16x8 qf[2][2];
#pragma unroll
      for (int nt = 0; nt < 2; ++nt)
#pragma unroll
        for (int ks = 0; ks < 2; ++ks)
          qf[nt][ks] = ld8(p.zb() + (size_t)(rowbase + j * 64 + half * 32 + nt * 16 + fr) * ZW + 1536 + h * 64 + ks * 32 + fq * 8);
      f32x4 hs[4][2];
#pragma unroll
      for (int i = 0; i < 4; ++i) { hs[i][0] = zero4(); hs[i][1] = zero4(); }
#pragma unroll 1
      for (int dir = 0; dir < 2; ++dir) {
        const int cs = cs0 + dir * NC + j;
        f32x4 acc[4][2];
#pragma unroll
        for (int i = 0; i < 4; ++i) { acc[i][0] = zero4(); acc[i][1] = zero4(); }
        const u16* cst = p.ml_cst() + (size_t)cs * 4096;
#pragma unroll
        for (int ks = 0; ks < 2; ++ks)
#pragma unroll
          for (int dt = 0; dt < 4; ++dt) {
            bf16x8 cf = ld8(cst + (dt * 16 + fr) * 64 + ks * 32 + fq * 8);
#pragma unroll
            for (int nt = 0; nt < 2; ++nt) acc[dt][nt] = MFMA16(cf, qf[nt][ks], acc[dt][nt]);
          }
        float dec[2], Mt[2], dsum[2];
#pragma unroll
        for (int nt = 0; nt < 2; ++nt) {
          const int t = half * 32 + nt * 16 + fr;
          dec[nt] = DEC[dir * 64 + t]; Mt[nt] = MX[dir * 64 + t]; dsum[nt] = 0.f;
#pragma unroll
          for (int dt = 0; dt < 4; ++dt) acc[dt][nt] *= dec[nt];
        }
#pragma unroll 1
        for (int sk = 0; sk < 2; ++sk) {
          bf16x8 kf[2][2];
#pragma unroll
          for (int mt = 0; mt < 2; ++mt)
#pragma unroll
            for (int ks = 0; ks < 2; ++ks)
              kf[mt][ks] = ld8(p.zb() + (size_t)(rowbase + j * 64 + sk * 32 + mt * 16 + fr) * ZW + 1792 + h * 64 + ks * 32 + fq * 8);
          f32x4 s[2][2];
#pragma unroll
          for (int mt = 0; mt < 2; ++mt)
#pragma unroll
            for (int nt = 0; nt < 2; ++nt) {
              s[mt][nt] = zero4();
#pragma unroll
              for (int ks = 0; ks < 2; ++ks) s[mt][nt] = MFMA16(kf[mt][ks], qf[nt][ks], s[mt][nt]);
            }
#pragma unroll
          for (int mt = 0; mt < 2; ++mt) {
            const float4 u4 = *(const float4*)(U + dir * 64 + sk * 32 + mt * 16 + fq * 4);
            const float uv[4] = {u4.x, u4.y, u4.z, u4.w};
#pragma unroll
            for (int jj = 0; jj < 4; ++jj) {
              const int stok = sk * 32 + mt * 16 + fq * 4 + jj;
#pragma unroll
              for (int nt = 0; nt < 2; ++nt) {
                const int t = half * 32 + nt * 16 + fr;
                const bool valid = dir ? (stok >= t) : (stok <= t);
                const float w = valid ? __expf(uv[jj] - Mt[nt]) : 0.f;
                const float pv = s[mt][nt][jj] * w;
                s[mt][nt][jj] = pv;
                dsum[nt] += pv;
              }
            }
          }
          bf16x8 pb[2];
#pragma unroll
          for (int nt = 0; nt < 2; ++nt) pb[nt] = pack8(s[0][nt], s[1][nt]);
#pragma unroll
          for (int dt = 0; dt < 4; ++dt) {
            const u16* vp = p.vt_ml() + tb + (size_t)(dt * 16 + fr) * ldT + j * 64 + sk * 32 + fq * 4;
            bf16x8 va = ld4x2(vp, vp + 16);
#pragma unroll
            for (int nt = 0; nt < 2; ++nt) acc[dt][nt] = MFMA16(va, pb[nt], acc[dt][nt]);
          }
        }
#pragma unroll
        for (int nt = 0; nt < 2; ++nt) {
          const int t = half * 32 + nt * 16 + fr;
          float ds = dsum[nt];
          ds += __shfl_xor(ds, 16);
          ds += __shfl_xor(ds, 32);
          const float den = ds + dec[nt] * NQ[dir * 64 + t];
          const float dv = 1.f / fmaxf(fabsf(den), EN[dir * 64 + t]);
#pragma unroll
          for (int dt = 0; dt < 4; ++dt) hs[dt][nt] += acc[dt][nt] * dv;
        }
      }
#pragma unroll
      for (int nt = 0; nt < 2; ++nt) {
        float ss = 0.f;
#pragma unroll
        for (int dt = 0; dt < 4; ++dt)
#pragma unroll
          for (int jj = 0; jj < 4; ++jj) ss += hs[dt][nt][jj] * hs[dt][nt][jj];
        ss += __shfl_xor(ss, 16);
        ss += __shfl_xor(ss, 32);
        const float rs = rsqrtf(ss * (1.f / 64.f) + EPS);
        const int orow = rowbase + j * 64 + half * 32 + nt * 16 + fr;
#pragma unroll
        for (int dt = 0; dt < 4; ++dt) {
          const int v0 = dt * 16 + fq * 4;
          const float4 gn = *(const float4*)(p.g_ml + l * 256 + h * 64 + v0);
          const uint2 mo = *(const uint2*)(p.zb() + (size_t)orow * ZW + 2304 + h * 64 + v0);
          const float o0 = bf2f((u16)(mo.x & 0xffff)), o1 = bf2f((u16)(mo.x >> 16)), o2 = bf2f((u16)(mo.y & 0xffff)), o3 = bf2f((u16)(mo.y >> 16));
          const float r0 = hs[dt][nt][0] * rs * gn.x / (1.f + __expf(-o0));
          const float r1 = hs[dt][nt][1] * rs * gn.y / (1.f + __expf(-o1));
          const float r2 = hs[dt][nt][2] * rs * gn.z / (1.f + __expf(-o2));
          const float r3 = hs[dt][nt][3] * rs * gn.w / (1.f + __expf(-o3));
          uint2 w; w.x = pack2(r0, r1); w.y = pack2(r2, r3);
          *(uint2*)(p.mix() + (size_t)orow * 1024 + 768 + h * 64 + v0) = w;
        }
      }
    }
    wave_sync();
  }
  __syncthreads();
}

#define QCTR_BASE XCD_BAR_WORDS
#define BAR_TOTAL_WORDS (XCD_BAR_WORDS + 4 * 64)
DI void phase_mix(const P& p, int l, char* smem, int tid0) {
  volatile LAS int* sit = (volatile LAS int*)((LAS char*)smem + STAGE_LDS + 64);
  for (;;) {
    __syncthreads();
    if (tid0 == 0) *sit = (int)atomicAdd(&p.bar()[QCTR_BASE + l * 64], 1u);
    __syncthreads();
    const int it = *sit;
    if (it >= 384) break;
    int tv = tid0;
    asm volatile("" : "+v"(tv));
    const int wid = tv >> 6, lane = tv & 63;
    if (it < 32) {
      mlstm_item(p, l, it, smem, tv);
    } else if (it < 160) {
      const int x = it - 32, b = x >> 4, kvh = (x >> 3) & 1, qt = (x & 7) * 2 + (wid >> 2), head = kvh * 4 + (wid & 3);
      const int rowbase = TP + b * 1024;
      const int ci = (b * 4 + l) * 2 + kvh;
      attn_wave<false>(p.zb() + (size_t)(rowbase + qt * 64) * ZW + 768 + head * 64, ZW,
                       p.zb() + (size_t)rowbase * ZW + 1280 + kvh * 64, ZW, p.vt_gqa() + 524288 + (size_t)((b * 2 + kvh) * 64) * 1024, 1024, 1024,
                       p.kc_gqa() + (size_t)ci * 16384, 64, p.vct_gqa() + (size_t)ci * 16384, 256, 256,
                       p.mix() + (size_t)(rowbase + qt * 64) * 1024 + 256 + head * 64, 1024, nullptr, 0, lane);
    } else if (it < 224) {
      const int x = it - 160, b = x >> 3, h = (x >> 1) & 3, r = (x & 1) * 8 + wid;
      const int rowbase = TP + b * 1024;
      const int r0 = min(max(r - 4, 0), 8);
      const int ci = (b * 4 + l) * 4 + h;
      attn_wave<true>(p.zb() + (size_t)(rowbase + r * 64) * ZW + h * 64, ZW,
                      p.zb() + (size_t)(rowbase + r0 * 64) * ZW + 256 + h * 64, ZW, p.vt_na() + 1048576 + (size_t)((b * 4 + h) * 64) * 1024 + r0 * 64, 1024, 512,
                      p.kc_na() + (size_t)ci * 16384, 64, p.vct_na() + (size_t)ci * 16384, 256, 256,
                      p.mix() + (size_t)(rowbase + r * 64) * 1024 + h * 64, 1024, p.na_bias + (size_t)(l * 4 + h) * 15 * 31, r0 - r + 7, lane);
    } else if (it < 288) {
      mlstm_item(p, l, 32 + (it - 224), smem, tv);
    } else if (it < 352) {
      const int x = it - 288, b = x >> 2, kvh = (x >> 1) & 1, qt = (x & 1) * 2 + (wid >> 2), head = kvh * 4 + (wid & 3);
      const int rowbase = b * 256;
      attn_wave<false>(p.zb() + (size_t)(rowbase + qt * 64) * ZW + 768 + head * 64, ZW,
                       p.zb() + (size_t)rowbase * ZW + 1280 + kvh * 64, ZW, p.vt_gqa() + (size_t)((b * 2 + kvh) * 64) * 256, 256, 256,
                       nullptr, 0, nullptr, 0, 0,
                       p.mix() + (size_t)(rowbase + qt * 64) * 1024 + 256 + head * 64, 1024, nullptr, 0, lane);
    } else {
      const int x = it - 352, b = x >> 1, h = (x & 1) * 2 + (wid >> 2), qt = wid & 3;
      const int rowbase = b * 256;
      attn_wave<false>(p.zb() + (size_t)(rowbase + qt * 64) * ZW + h * 64, ZW,
                       p.zb() + (size_t)rowbase * ZW + 256 + h * 64, ZW, p.vt_na() + (size_t)((b * 4 + h) * 64) * 256, 256, 256,
                       nullptr, 0, nullptr, 0, 0,
                       p.mix() + (size_t)(rowbase + qt * 64) * 1024 + h * 64, 1024, nullptr, 0, lane);
    }
  }
}

DI void run_phase(const P& p, int ph, int l, char* smem) {
  int tid = threadIdx.x;
  asm volatile("" : "+v"(tid));
  switch (ph) {
    case 0: phase_init(p, smem, tid); break;
    case 1: phase_row(p, 0, 0, smem, tid); break;
    case 2: phase_gemm(p, 0, l, smem); break;
    case 3: phase_mix(p, l, smem, tid); break;
    case 4: phase_gemm(p, 1, l, smem); break;
    case 5: phase_row(p, 1, l, smem, tid); break;
    case 6: phase_gemm(p, 2, l, smem); break;
    case 7: phase_gemm(p, 3, l, smem); break;
    default: phase_row(p, 2, l, smem, tid); break;
  }
}

#if !ONE_LAUNCH
__global__ void __launch_bounds__(512, 2) k_phase(P p, int ph, int l) {
  extern __shared__ __attribute__((aligned(16))) char smem[];
  run_phase(p, ph, l, smem);
}
#else
__global__ void __launch_bounds__(512, 2) k_mega(P p) {
  extern __shared__ __attribute__((aligned(16))) char smem[];
  uint4* xbw = (uint4*)(smem + STAGE_LDS);
  if (threadIdx.x == 0) *xbw = make_uint4(0u, 0u, 0u, 0u);
  __syncthreads();
  XcdBarrier xb = xcd_barrier_post(p.bar(), (volatile LAS unsigned*)xbw, (unsigned)p.nblk);
  run_phase(p, 0, 0, smem);
  xcd_barrier(xb);
  run_phase(p, 1, 0, smem);
  for (int l = 0; l < 4; ++l) {
    for (int ph = 2; ph <= 8; ++ph) {
      xcd_barrier(xb);
      run_phase(p, ph, l, smem);
    }
  }
}
#endif

extern "C" void kernel_launch(void* const* d_in, const int* in_sizes, int n_in, void* d_out, int out_size, void* d_ws,
                              size_t ws_size, hipStream_t stream) {
  P p{};
  p.x_prompt = (const float*)d_in[0]; p.x_sample = (const float*)d_in[1]; p.cache_na = (const float*)d_in[2];
  p.cache_gqa = (const float*)d_in[3]; p.stC = (const float*)d_in[4]; p.stn = (const float*)d_in[5]; p.stm = (const float*)d_in[6];
  p.c = (const float*)d_in[7]; p.c_ctx = (const float*)d_in[8]; p.w_in = (const float*)d_in[9]; p.b_gates = (const float*)d_in[10];
  p.w_out = (const float*)d_in[11]; p.g_norm = (const float*)d_in[12]; p.g_qk = (const float*)d_in[13]; p.g_ml = (const float*)d_in[14];
  p.na_bias = (const float*)d_in[15]; p.w_ada = (const float*)d_in[16]; p.b_ada = (const float*)d_in[17]; p.w_gu = (const float*)d_in[18];
  p.w_down = (const float*)d_in[19];
  p.out = (float*)d_out;
  p.ws = (char*)d_ws;
  if (WS_TOTAL > ws_size) { fprintf(stderr, "workspace too small: need %zu have %zu\n", (size_t)WS_TOTAL, ws_size); return; }

  static int grid_blocks = 0;
  if (!grid_blocks) {
    int dev = 0, cus = 0, per_cu = 0;
    (void)hipGetDevice(&dev);
    (void)hipDeviceGetAttribute(&cus, hipDeviceAttributeMultiprocessorCount, dev);
#if ONE_LAUNCH
    (void)hipFuncSetAttribute((const void*)k_mega, hipFuncAttributeMaxDynamicSharedMemorySize, DYN_LDS);
    (void)hipOccupancyMaxActiveBlocksPerMultiprocessor(&per_cu, k_mega, NTHR, DYN_LDS);
#else
    (void)hipFuncSetAttribute((const void*)k_phase, hipFuncAttributeMaxDynamicSharedMemorySize, DYN_LDS);
    (void)hipOccupancyMaxActiveBlocksPerMultiprocessor(&per_cu, k_phase, NTHR, DYN_LDS);
#endif
    if (per_cu < 1) { fprintf(stderr, "occupancy query returned %d\n", per_cu); per_cu = 1; }
    if (per_cu > 1) per_cu = 1;
    grid_blocks = cus * per_cu;
  }
  p.nblk = grid_blocks;
  (void)hipMemsetAsync(p.bar(), 0, (size_t)BAR_TOTAL_WORDS * 4, stream);
#if ONE_LAUNCH
  void* args[] = {&p};
  hipError_t e = hipLaunchCooperativeKernel((void*)k_mega, dim3(grid_blocks), dim3(NTHR), args, DYN_LDS, stream);
  if (e != hipSuccess) fprintf(stderr, "cooperative launch failed: %s (grid %d)\n", hipGetErrorString(e), grid_blocks);
#else
  k_phase<<<grid_blocks, NTHR, DYN_LDS, stream>>>(p, 0, 0);
  k_phase<<<grid_blocks, NTHR, DYN_LDS, stream>>>(p, 1, 0);
  for (int l = 0; l < 4; ++l)
    for (int ph = 2; ph <= 8; ++ph) k_phase<<<grid_blocks, NTHR, DYN_LDS, stream>>>(p, ph, l);
#endif
}
```

```cpp
#include <hip/hip_runtime.h>
#include <stdint.h>
#include <stdio.h>

#ifndef ONE_LAUNCH
#define ONE_LAUNCH 1
#endif
#ifndef TPROBE
#define TPROBE 0
#endif
#ifndef TQ
#define TQ 200.f
#endif
constexpr int NTHR = 512, NWAVE = 8;
constexpr int STAGE_LDS = 131072, DYN_LDS = STAGE_LDS + 256;

#define DI __device__ __forceinline__
typedef unsigned short u16;
typedef __attribute__((ext_vector_type(8))) short bf16x8;
typedef __attribute__((ext_vector_type(4))) float f32x4;

constexpr int TP = 4096, TS = 8192, TT = 12288, ZW = 2560, NIN = 2688, FF = 2816;
constexpr float EPS = 1e-6f;
constexpr size_t O_YP = 0, O_NA = 12582912, O_GQA = 20971520, O_C = 25165824, O_N = 27262976, O_M = 27295744;
constexpr int SMEM_BYTES = 73728;

struct P {
  const float *x_prompt, *x_sample, *cache_na, *cache_gqa, *stC, *stn, *stm, *c, *c_ctx, *w_in, *b_gates, *w_out,
      *g_norm, *g_qk, *g_ml, *na_bias, *w_ada, *b_ada, *w_gu, *w_down;
  float* out;
  char* ws;
  int nblk, pad_;
  __host__ __device__ __forceinline__ u16* wt_in() const { return (u16*)(ws + 0ull); }
  __host__ __device__ __forceinline__ u16* wt_out() const { return (u16*)(ws + 20971520ull); }
  __host__ __device__ __forceinline__ u16* wt_gu() const { return (u16*)(ws + 29360128ull); }
  __host__ __device__ __forceinline__ u16* wt_down() const { return (u16*)(ws + 75497472ull); }
  __host__ __device__ __forceinline__ float* mods() const { return (float*)(ws + 98566144ull); }
  __host__ __device__ __forceinline__ float* rope() const { return (float*)(ws + 99450880ull); }
  __host__ __device__ __forceinline__ u16* kc_na() const { return (u16*)(ws + 99459072ull); }
  __host__ __device__ __forceinline__ u16* vct_na() const { return (u16*)(ws + 103653376ull); }
  __host__ __device__ __forceinline__ u16* kc_gqa() const { return (u16*)(ws + 107847680ull); }
  __host__ __device__ __forceinline__ u16* vct_gqa() const { return (u16*)(ws + 109944832ull); }
  __host__ __device__ __forceinline__ u16* hn() const { return (u16*)(ws + 112041984ull); }
  __host__ __device__ __forceinline__ u16* zb() const { return (u16*)(ws + 137207808ull); }
  __host__ __device__ __forceinline__ u16* act() const { return (u16*)(ws + 137207808ull); }
  __host__ __device__ __forceinline__ u16* vt_na() const { return (u16*)(ws + 206413824ull); }
  __host__ __device__ __forceinline__ u16* vt_gqa() const { return (u16*)(ws + 212705280ull); }
  __host__ __device__ __forceinline__ u16* kt_ml() const { return (u16*)(ws + 215851008ull); }
  __host__ __device__ __forceinline__ u16* vt_ml() const { return (u16*)(ws + 222142464ull); }
  __host__ __device__ __forceinline__ u16* mix() const { return (u16*)(ws + 228433920ull); }
  __host__ __device__ __forceinline__ float* gates() const { return (float*)(ws + 253599744ull); }
  __host__ __device__ __forceinline__ float* obuf() const { return (float*)(ws + 254386176ull); }
  __host__ __device__ __forceinline__ float* ml_chat() const { return (float*)(ws + 304717824ull); }
  __host__ __device__ __forceinline__ float* ml_nhat() const { return (float*)(ws + 329883648ull); }
  __host__ __device__ __forceinline__ float* ml_ab() const { return (float*)(ws + 330276864ull); }
  __host__ __device__ __forceinline__ float* ml_nst() const { return (float*)(ws + 330289152ull); }
  __host__ __device__ __forceinline__ float* ml_mst() const { return (float*)(ws + 330682368ull); }
  __host__ __device__ __forceinline__ u16* ml_cst() const { return (u16*)(ws + 330688512ull); }
  __host__ __device__ __forceinline__ unsigned* bar() const { return (unsigned*)(ws + 343271424ull); }
};
constexpr size_t X16_OFF = 343351808ull;
constexpr size_t WS_TOTAL_X = X16_OFF + (size_t)12288 * 1024 * 2;
constexpr size_t WS_TOTAL = 343286272ull;

DI u16 f2bf(float x) { unsigned u = __float_as_uint(x); u += 0x7fffu + ((u >> 16) & 1u); return (u16)(u >> 16); }
DI float bf2f(u16 h) { return __uint_as_float(((unsigned)h) << 16); }
DI unsigned pack2(float a, float b) { unsigned r; asm volatile("v_cvt_pk_bf16_f32 %0, %1, %2" : "=v"(r) : "v"(a), "v"(b)); return r; }
#define DPP_F(v, ctrl, rmask) __int_as_float(__builtin_amdgcn_update_dpp(0, __float_as_int(v), (ctrl), (rmask), 0xF, false))
DI float wave_sum(float v) {
  v += DPP_F(v, 0xB1, 0xF);
  v += DPP_F(v, 0x4E, 0xF);
  v += DPP_F(v, 0x141, 0xF);
  v += DPP_F(v, 0x140, 0xF);
  v += DPP_F(v, 0x142, 0xA);
  v += DPP_F(v, 0x143, 0xC);
  return __int_as_float(__builtin_amdgcn_readlane(__float_as_int(v), 63));
}
DI float wave_max(float v) { for (int o = 32; o >= 1; o >>= 1) v = fmaxf(v, __shfl_xor(v, o)); return v; }
DI void wave_sync() { __builtin_amdgcn_fence(__ATOMIC_RELEASE, "wavefront"); __builtin_amdgcn_wave_barrier(); __builtin_amdgcn_fence(__ATOMIC_ACQUIRE, "wavefront"); }
#define MFMA16(a, b, c) __builtin_amdgcn_mfma_f32_16x16x32_bf16((a), (b), (c), 0, 0, 0)
DI bf16x8 ld8(const u16* p) { return *(const bf16x8*)p; }
DI bf16x8 ld4x2(const u16* p0, const u16* p1) {
  uint2 a = *(const uint2*)p0, b = *(const uint2*)p1;
  uint4 r; r.x = a.x; r.y = a.y; r.z = b.x; r.w = b.y;
  return __builtin_bit_cast(bf16x8, r);
}
DI bf16x8 pack8(const f32x4& a, const f32x4& b) {
  uint4 r; r.x = pack2(a[0], a[1]); r.y = pack2(a[2], a[3]); r.z = pack2(b[0], b[1]); r.w = pack2(b[2], b[3]);
  return __builtin_bit_cast(bf16x8, r);
}
DI f32x4 zero4() { f32x4 z = {0.f, 0.f, 0.f, 0.f}; return z; }

DI size_t vt_index(int row, int H, int h, int d) {
  if (row < TP) { int b = row >> 8, t = row & 255; return ((size_t)((b * H + h) * 64 + d)) * 256 + t; }
  int r = row - TP; int b = r >> 10, t = r & 1023;
  return (size_t)16 * H * 64 * 256 + ((size_t)((b * H + h) * 64 + d)) * 1024 + t;
}


#define XB_TMO      128
#define XB_XCNT(j)  (256  + 64 * (j))
#define XB_XSUB(j)  (1280 + 64 * (j))
#define XB_XGEN(j)  (2304 + 64 * (j))
#define XB_TOP      3328
#define XB_TOPGEN   3392
#define XCD_BAR_WORDS 3456
#define XB_SPIN_CAP (1u << 20)
#define LAS __attribute__((address_space(3)))
DI unsigned xb_ld(unsigned* p) { return __hip_atomic_load(p, __ATOMIC_RELAXED, __HIP_MEMORY_SCOPE_AGENT); }
DI unsigned xb_add(unsigned* p, unsigned v) { return __hip_atomic_fetch_add(p, v, __ATOMIC_RELAXED, __HIP_MEMORY_SCOPE_AGENT); }
DI unsigned xb_xcc_id() { return (unsigned)__builtin_amdgcn_s_getreg((3 << 11) | 20) & 0xFu; }
#define XB_SPIN(cond, bar) do { unsigned _sp = 0; while (cond) { __builtin_amdgcn_s_sleep(1); \
    if ((++_sp & 255u) == 0u) { if (xb_ld(&(bar)[XB_TMO])) break; if (_sp > XB_SPIN_CAP) { atomicAdd(&(bar)[XB_TMO], 1u); break; } } } } while (0)
struct XcdBarrier { unsigned* bar; unsigned x; unsigned G; volatile LAS unsigned* st; };
DI XcdBarrier xcd_barrier_post(unsigned* bar, volatile LAS unsigned* st, unsigned G) {
  XcdBarrier b; b.bar = bar; b.x = xb_xcc_id(); b.st = st; b.G = G;
  if (threadIdx.x == 0) (void)xb_add(&bar[XB_XCNT(b.x)], 1u);
  return b;
}
DI void xcd_barrier_complete(unsigned* bar, unsigned x, unsigned& nloc, unsigned& nx, unsigned G) {
  unsigned sum, cnt, mine, sp = 0u;
  for (;;) {
    sum = 0u; cnt = 0u; mine = 0u;
#pragma unroll
    for (unsigned j = 0; j < 16; ++j) { const unsigned c = xb_ld(&bar[XB_XCNT(j)]); sum += c; cnt += (c > 0u) ? 1u : 0u; mine = (j == x) ? c : mine; }
    if (sum == G) break;
    __builtin_amdgcn_s_sleep(1);
    if ((++sp & 255u) == 0u) { if (xb_ld(&bar[XB_TMO])) break; if (sp > XB_SPIN_CAP) { atomicAdd(&bar[XB_TMO], 1u); break; } }
  }
  nloc = mine > 0u ? mine : 1u; nx = cnt > 0u ? cnt : 1u;
}
DI void xcd_barrier(const XcdBarrier& b) {
  asm volatile("s_waitcnt vmcnt(0)" ::: "memory");
  __syncthreads();
  if (threadIdx.x == 0) {
    unsigned* bar = b.bar;
    __builtin_amdgcn_s_waitcnt(0);
    unsigned nloc = b.st[0], nx = b.st[1];
    if (nloc == 0u) { xcd_barrier_complete(bar, b.x, nloc, nx, b.G); b.st[0] = nloc; b.st[1] = nx; }
    const unsigned old = xb_add(&bar[XB_XSUB(b.x)], 1u);
    const unsigned gen = old / nloc;
    if (old + 1u == (gen + 1u) * nloc) {
      __builtin_amdgcn_fence(__ATOMIC_RELEASE, "agent");
      asm volatile("s_waitcnt vmcnt(0)" ::: "memory");
      const unsigned og = xb_add(&bar[XB_TOP], 1u);
      const unsigned tg = og / nx;
      if (og + 1u == (tg + 1u) * nx) xb_add(&bar[XB_TOPGEN], 1u);
      else XB_SPIN(xb_ld(&bar[XB_TOPGEN]) == tg, bar);
      __builtin_amdgcn_fence(__ATOMIC_ACQUIRE, "agent");
      xb_add(&bar[XB_XGEN(b.x)], 1u);
      asm volatile("s_waitcnt vmcnt(0)" ::: "memory");
    } else {
      XB_SPIN(xb_ld(&bar[XB_XGEN(b.x)]) == gen, bar);
      __builtin_amdgcn_fence(__ATOMIC_ACQUIRE, "agent");
      asm volatile("s_waitcnt vmcnt(0)" ::: "memory");
    }
  }
  __syncthreads();
}

DI void transpose_tile(const float* __restrict__ src, int ldsrc, int k0, int n0, int mode, int nvalid,
                       u16* __restrict__ dst, int ldd, float* tile, int tid) {
  const int nn = tid & 63, kq = tid >> 6;
  int rr = n0 + nn, col;
  if (mode == 1) {
    int tl = rr >> 8, c = rr & 255, bj = c >> 7, wc = (c >> 5) & 3, w = c & 31;
    col = tl * 128 + wc * 32 + w + bj * FF;
  } else if (mode == 2) {
    int tl = rr >> 8, c = rr & 255, bj = c >> 7, wc = (c >> 5) & 3, w = c & 31;
    col = tl * 256 + wc * 64 + bj * 32 + w;
  } else col = rr < nvalid ? rr : -1;
#pragma unroll
  for (int i = 0; i < 8; ++i) {
    int kk = i * 8 + kq;
    tile[kk * 65 + nn] = col >= 0 ? src[(size_t)(k0 + kk) * ldsrc + col] : 0.f;
  }
  __syncthreads();
  const int k2 = (tid & 31) * 2, nq = tid >> 5;
#pragma unroll
  for (int i = 0; i < 4; ++i) {
    int n = i * 16 + nq;
    *(unsigned*)(dst + (size_t)(n0 + n) * ldd + k0 + k2) = pack2(tile[k2 * 65 + n], tile[(k2 + 1) * 65 + n]);
  }
  __syncthreads();
}

DI int tt_col(int rr, int mode, int nvalid) {
  if (mode == 1) { int tl = rr >> 8, c = rr & 255, bj = c >> 7, wc = (c >> 5) & 3, w = c & 31; return tl * 128 + wc * 32 + w + bj * FF; }
  if (mode == 2) { int tl = rr >> 8, c = rr & 255, bj = c >> 7, wc = (c >> 5) & 3, w = c & 31; return tl * 256 + wc * 64 + bj * 32 + w; }
  return rr < nvalid ? rr : -1;
}
DI void transpose_tile2(const float* __restrict__ src, int ldsrc, int k0, int n0, int mode, int nvalid,
                        u16* __restrict__ dst, int ldd, float* tile, int tid) {
  const int nn = tid & 63, kq = tid >> 6;
  const int colA = tt_col(n0 + nn, mode, nvalid), colB = tt_col(n0 + 64 + nn, mode, nvalid);
  float ra[8], rb[8];
#pragma unroll
  for (int i = 0; i < 8; ++i) {
    const int kk = i * 8 + kq;
    ra[i] = colA >= 0 ? src[(size_t)(k0 + kk) * ldsrc + colA] : 0.f;
    rb[i] = colB >= 0 ? src[(size_t)(k0 + kk) * ldsrc + colB] : 0.f;
  }
  float* tileB = tile + 64 * 65;
#pragma unroll
  for (int i = 0; i < 8; ++i) { const int kk = i * 8 + kq; tile[kk * 65 + nn] = ra[i]; tileB[kk * 65 + nn] = rb[i]; }
  __syncthreads();
  const int k2 = (tid & 31) * 2, nq = tid >> 5;
#pragma unroll
  for (int i = 0; i < 4; ++i) {
    const int n = i * 16 + nq;
    *(unsigned*)(dst + (size_t)(n0 + n) * ldd + k0 + k2) = pack2(tile[k2 * 65 + n], tile[(k2 + 1) * 65 + n]);
    *(unsigned*)(dst + (size_t)(n0 + 64 + n) * ldd + k0 + k2) = pack2(tileB[k2 * 65 + n], tileB[(k2 + 1) * 65 + n]);
  }
  __syncthreads();
}

DI void phase_init(const P& p, char* smem, int tid) {
  float* tile = (float*)smem;
  const int NTR = 6016, NCV = 768, NADA = 384;
  const int total = NTR + NCV + NADA + 1;
  for (int it = blockIdx.x; it < total; it += p.nblk) {
    if (it < NTR) {
      int l = it / 1504, r = it % 1504;
      if (r < 320) {
        int kt = r / 20, nt = r % 20;
        transpose_tile2(p.w_in + (size_t)l * 1024 * 2576, 2576, kt * 64, nt * 128, 2, 2560, p.wt_in() + (size_t)l * ZW * 1024, 1024, tile, tid);
      } else if (r < 448) {
        int x = r - 320, kt = x / 8, nt = x % 8;
        transpose_tile2(p.w_out + (size_t)l * 1024 * 1024, 1024, kt * 64, nt * 128, 0, 1024, p.wt_out() + (size_t)l * 1024 * 1024, 1024, tile, tid);
      } else if (r < 1152) {
        int x = r - 448, kt = x / 44, nt = x % 44;
        transpose_tile2(p.w_gu + (size_t)l * 1024 * 5632, 5632, kt * 64, nt * 128, 1, 5632, p.wt_gu() + (size_t)l * 5632 * 1024, 1024, tile, tid);
      } else {
        int x = r - 1152, kt = x / 8, nt = x % 8;
        transpose_tile2(p.w_down + (size_t)l * FF * 1024, 1024, kt * 64, nt * 128, 0, 1024, p.wt_down() + (size_t)l * 1024 * FF, FF, tile, tid);
      }
    } else if (it < NTR + NCV) {
      int it2 = it - NTR;
      if (it2 < 512) {
        int idx = it2 >> 2, tt = it2 & 3, bl = idx >> 2, h = idx & 3;
        transpose_tile(p.cache_na + (size_t)((bl * 2 + 1) * 4 + h) * 16384, 64, tt * 64, 0, 0, 64, p.vct_na() + (size_t)idx * 16384, 256, tile, tid);
      } else {
        int it3 = it2 - 512;
        int idx = it3 >> 2, tt = it3 & 3, bl = idx >> 1, h = idx & 1;
        transpose_tile(p.cache_gqa + (size_t)((bl * 2 + 1) * 2 + h) * 16384, 64, tt * 64, 0, 0, 64, p.vct_gqa() + (size_t)idx * 16384, 256, tile, tid);
      }
    } else if (it < NTR + NCV + NADA) {
      int ia = it - NTR - NCV;
      int l = ia / 96, colbase = (ia % 96) * 64;
      float* sl = (float*)smem;
      for (int i = tid; i < 9 * 1024; i += NTHR) {
        int n = i >> 10, d = i & 1023;
        float cv = n == 0 ? p.c_ctx[d] : p.c[(n - 1) * 1024 + d];
        sl[i] = cv / (1.f + __expf(-cv));
      }
      __syncthreads();
      const int col = tid & 63, kg = tid >> 6;
      float acc[9];
#pragma unroll
      for (int n = 0; n < 9; ++n) acc[n] = 0.f;
      const float* w = p.w_ada + ((size_t)l * 1024 + kg * 128) * 6144 + colbase + col;
#pragma unroll 4
      for (int k = 0; k < 128; ++k) {
        float wv = w[(size_t)k * 6144];
#pragma unroll
        for (int n = 0; n < 9; ++n) acc[n] += sl[n * 1024 + kg * 128 + k] * wv;
      }
      float* red = sl + 9216;
#pragma unroll
      for (int n = 0; n < 9; ++n) red[(kg * 9 + n) * 64 + col] = acc[n];
      __syncthreads();
      for (int i = tid; i < 576; i += NTHR) {
        int n = i >> 6, cc = i & 63;
        float s = 0.f;
#pragma unroll
        for (int g = 0; g < 8; ++g) s += red[(g * 9 + n) * 64 + cc];
        p.mods()[(size_t)(l * 9 + n) * 6144 + colbase + cc] = s + p.b_ada[l * 6144 + colbase + cc];
      }
      __syncthreads();
    } else {
      for (int i = tid; i < 1024; i += NTHR) {
        int pos = i >> 4, fi = i & 15;
        float inv = __builtin_amdgcn_exp2f(-(float)fi * 0.8304820237f);
        float ang = (float)pos * inv;
        p.rope()[i] = __cosf(ang);
        p.rope()[1024 + i] = __sinf(ang);
      }
    }
  }
  const int gtid = blockIdx.x * NTHR + tid, gsz = p.nblk * NTHR;
  for (int i = gtid; i < 128 * 4096; i += gsz) {
    int idx = i >> 12, e = (i & 4095) * 4, bl = idx >> 2, h = idx & 3;
    float4 v = *(const float4*)(p.cache_na + (size_t)((bl * 2 + 0) * 4 + h) * 16384 + e);
    uint2 o; o.x = pack2(v.x, v.y); o.y = pack2(v.z, v.w);
    *(uint2*)(p.kc_na() + (size_t)idx * 16384 + e) = o;
  }
  for (int i = gtid; i < 64 * 4096; i += gsz) {
    int idx = i >> 12, e = (i & 4095) * 4, bl = idx >> 1, h = idx & 1;
    float4 v = *(const float4*)(p.cache_gqa + (size_t)((bl * 2 + 0) * 2 + h) * 16384 + e);
    uint2 o; o.x = pack2(v.x, v.y); o.y = pack2(v.z, v.w);
    *(uint2*)(p.kc_gqa() + (size_t)idx * 16384 + e) = o;
  }
}

DI void phase_row(const P& p, int mode, int l, char* smem, int tid) {
  const int lane = tid & 63, wid = tid >> 6;
  const bool last = (mode == 2 && l == 3);
  const int ln = mode == 1 ? l : (mode == 0 ? 0 : l + 1);
  const bool do_gates = (mode != 1) && !last;
  u16* x16 = (u16*)(p.ws + X16_OFF);
  float* Wg = (float*)smem;
  if (do_gates) {
    for (int idx = tid; idx < 16384; idx += NTHR) {
      int k = idx >> 4, g = idx & 15;
      Wg[g * 1024 + k] = p.w_in[((size_t)ln * 1024 + k) * 2576 + 2560 + g];
    }
    __syncthreads();
  }
  uint2 obn[4], xbn[4];
  if (mode != 0) {
    const int r0_ = blockIdx.x * NWAVE + wid;
    if (r0_ < TT) {
#pragma unroll
      for (int i = 0; i < 4; ++i) { obn[i] = *(const uint2*)((const u16*)p.obuf() + (size_t)r0_ * 1024 + i * 256 + lane * 4); xbn[i] = *(const uint2*)(x16 + (size_t)r0_ * 1024 + i * 256 + lane * 4); }
    }
  }
  for (int row_ = blockIdx.x * NWAVE + wid; row_ < TT; row_ += p.nblk * NWAVE) {
    int row = row_;
    asm volatile("" : "+v"(row));
    const int nidx = row < TP ? 0 : 1 + ((row - TP) >> 10);
    float4 x[4];
    const int gi = mode == 1 ? 2 : 0, shi = mode == 1 ? 3 : 0;
    const float* g2 = p.g_norm + (size_t)(ln * 4 + gi) * 1024;
    const float* sh = p.mods() + ((size_t)(ln * 9 + nidx) * 6 + shi) * 1024;
    const float* sc = sh + 1024;
    float4 g2v[4], shv[4], scv[4];
    if (mode == 0) {
      const float* src = row < TP ? p.x_prompt + (size_t)row * 1024 : p.x_sample + (size_t)(row - TP) * 1024;
#pragma unroll
      for (int i = 0; i < 4; ++i) x[i] = *(const float4*)(src + i * 256 + lane * 4);
#pragma unroll
      for (int i = 0; i < 4; ++i) { const int cidx = i * 256 + lane * 4; g2v[i] = *(const float4*)(g2 + cidx); shv[i] = *(const float4*)(sh + cidx); scv[i] = *(const float4*)(sc + cidx); }
    } else {
      const float* ga = p.mods() + ((size_t)(l * 9 + nidx) * 6 + (mode == 1 ? 2 : 5)) * 1024;
      const float* g = p.g_norm + (size_t)(l * 4 + (mode == 1 ? 1 : 3)) * 1024;
      uint2 ob[4], xb[4];
      float4 gav[4], gv[4];
#pragma unroll
      for (int i = 0; i < 4; ++i) { ob[i] = obn[i]; xb[i] = xbn[i]; }
      {
        const int rnx = row_ + p.nblk * NWAVE;
        if (rnx < TT) {
#pragma unroll
          for (int i = 0; i < 4; ++i) { obn[i] = *(const uint2*)((const u16*)p.obuf() + (size_t)rnx * 1024 + i * 256 + lane * 4); xbn[i] = *(const uint2*)(x16 + (size_t)rnx * 1024 + i * 256 + lane * 4); }
        }
      }
#pragma unroll
      for (int i = 0; i < 4; ++i) { const int cidx = i * 256 + lane * 4; gav[i] = *(const float4*)(ga + cidx); gv[i] = *(const float4*)(g + cidx); }
      if (!last) {
#pragma unroll
        for (int i = 0; i < 4; ++i) { const int cidx = i * 256 + lane * 4; g2v[i] = *(const float4*)(g2 + cidx); shv[i] = *(const float4*)(sh + cidx); scv[i] = *(const float4*)(sc + cidx); }
      }
      float4 o[4];
      float ss = 0.f;
#pragma unroll
      for (int i = 0; i < 4; ++i) {
        o[i].x = __uint_as_float(ob[i].x << 16); o[i].y = __uint_as_float(ob[i].x & 0xffff0000u);
        o[i].z = __uint_as_float(ob[i].y << 16); o[i].w = __uint_as_float(ob[i].y & 0xffff0000u);
        x[i].x = __uint_as_float(xb[i].x << 16); x[i].y = __uint_as_float(xb[i].x & 0xffff0000u);
        x[i].z = __uint_as_float(xb[i].y << 16); x[i].w = __uint_as_float(xb[i].y & 0xffff0000u);
        ss += o[i].x * o[i].x + o[i].y * o[i].y + o[i].z * o[i].z + o[i].w * o[i].w;
      }
      ss = wave_sum(ss);
      const float rs = rsqrtf(ss * (1.f / 1024.f) + EPS);
#pragma unroll
      for (int i = 0; i < 4; ++i) {
        x[i].x += gav[i].x * (o[i].x * rs * gv[i].x); x[i].y += gav[i].y * (o[i].y * rs * gv[i].y);
        x[i].z += gav[i].z * (o[i].z * rs * gv[i].z); x[i].w += gav[i].w * (o[i].w * rs * gv[i].w);
      }
    }
    if (last) {
#pragma unroll
      for (int i = 0; i < 4; ++i) *(float4*)(p.out + (size_t)row * 1024 + i * 256 + lane * 4) = x[i];
      continue;
    }
#pragma unroll
    for (int i = 0; i < 4; ++i) {
      uint2 w; w.x = pack2(x[i].x, x[i].y); w.y = pack2(x[i].z, x[i].w);
      *(uint2*)(x16 + (size_t)row * 1024 + i * 256 + lane * 4) = w;
      x[i].x = __uint_as_float(w.x << 16); x[i].y = __uint_as_float(w.x & 0xffff0000u);
      x[i].z = __uint_as_float(w.y << 16); x[i].w = __uint_as_float(w.y & 0xffff0000u);
    }
    float ss2 = 0.f;
#pragma unroll
    for (int i = 0; i < 4; ++i) ss2 += x[i].x * x[i].x + x[i].y * x[i].y + x[i].z * x[i].z + x[i].w * x[i].w;
    ss2 = wave_sum(ss2);
    const float rs2 = rsqrtf(ss2 * (1.f / 1024.f) + EPS);
#pragma unroll
    for (int i = 0; i < 4; ++i) {
      const int cidx = i * 256 + lane * 4;
      x[i].x = x[i].x * rs2 * g2v[i].x * (1.f + scv[i].x) + shv[i].x;
      x[i].y = x[i].y * rs2 * g2v[i].y * (1.f + scv[i].y) + shv[i].y;
      x[i].z = x[i].z * rs2 * g2v[i].z * (1.f + scv[i].z) + shv[i].z;
      x[i].w = x[i].w * rs2 * g2v[i].w * (1.f + scv[i].w) + shv[i].w;
      uint2 o2; o2.x = pack2(x[i].x, x[i].y); o2.y = pack2(x[i].z, x[i].w);
      *(uint2*)(p.hn() + (size_t)row * 1024 + cidx) = o2;
    }
    if (do_gates) {
      float part[16];
#pragma unroll 2
      for (int g16 = 0; g16 < 16; ++g16) {
        float a = 0.f;
#pragma unroll
        for (int i = 0; i < 4; ++i) {
          const float4 wv = *(const float4*)(Wg + g16 * 1024 + i * 256 + lane * 4);
          a += x[i].x * wv.x + x[i].y * wv.y + x[i].z * wv.z + x[i].w * wv.w;
        }
        part[g16] = a;
      }
      const bool b5 = (lane & 32) != 0, b4 = (lane & 16) != 0, b3 = (lane & 8) != 0, b2 = (lane & 4) != 0;
      float w8[8], w4[4], w2[2];
#pragma unroll
      for (int k = 0; k < 8; ++k) { const float send = b5 ? part[k] : part[k + 8], keep = b5 ? part[k + 8] : part[k]; w8[k] = keep + __shfl_xor(send, 32); }
#pragma unroll
      for (int k = 0; k < 4; ++k) { const float send = b4 ? w8[k] : w8[k + 4], keep = b4 ? w8[k + 4] : w8[k]; w4[k] = keep + __shfl_xor(send, 16); }
#pragma unroll
      for (int k = 0; k < 2; ++k) { const float send = b3 ? w4[k] : w4[k + 2], keep = b3 ? w4[k + 2] : w4[k]; w2[k] = keep + __shfl_xor(send, 8); }
      float w1;
      { const float send = b2 ? w2[0] : w2[1], keep = b2 ? w2[1] : w2[0]; w1 = keep + __shfl_xor(send, 4); }
      w1 += __shfl_xor(w1, 2);
      w1 += __shfl_xor(w1, 1);
      const int gidx = (b5 ? 8 : 0) + (b4 ? 4 : 0) + (b3 ? 2 : 0) + (b2 ? 1 : 0);
      if ((lane & 3) == 0) p.gates()[(size_t)row * 16 + gidx] = w1 + p.b_gates[ln * 16 + gidx];
    }
  }
  if (do_gates) __syncthreads();
}

#define PG8_LAS __attribute__((address_space(3)))
typedef unsigned u32x4 __attribute__((ext_vector_type(4)));
typedef unsigned u32x2 __attribute__((ext_vector_type(2)));
namespace pg8 {
constexpr int BM = 256, BK = 64, HALF = 128, HTB = HALF * BK * 2, NXCD = 8, WGM = 8;
DI int lds_byte(int r, int c) { const int st = (r >> 4) * 2 + (c >> 5), rr = r & 15, cc = c & 31, ob = rr * 64 + cc * 2; return st * 1024 + (ob ^ (((ob >> 9) & 1) << 5)); }
DI void stage_rc(int b, int& R, int& C) { const int st = b / 1024, sb = b % 1024, swz = sb ^ (((sb >> 9) & 1) << 5); R = (st >> 1) * 16 + swz / 64; C = (st & 1) * 32 + (swz % 64) / 2; }
DI int perm32(int rho) { const int n = rho >> 4, i = rho & 15; return 8 * (i >> 2) + 4 * n + (i & 3); }
struct Unit { int pm, pn; };
struct Gemm { const u16* A; const u16* Bt; int M, N, K; };
struct StaticOrder {
  int nM, nN, nwg, G, c;
  DI void init(int M, int N, int G_, int c_) { nM = M / BM; nN = N / BM; nwg = nM * nN; G = G_; c = c_; }
  DI bool next(int i, Unit& u) const {
    const long L = (long)i * G + c; if (L >= nwg) return false;
    int wgid = (int)L; { const int q = nwg / NXCD, r = nwg % NXCD, xcd = wgid % NXCD, off = wgid / NXCD; wgid = (xcd < r ? xcd * (q + 1) : r * (q + 1) + (xcd - r) * q) + off; }
    const int nig = WGM * nN, gid = wgid / nig, fm = gid * WGM, gsz = (nM - fm) < WGM ? (nM - fm) : WGM;
    u.pm = fm + ((wgid % nig) % gsz); u.pn = (wgid % nig) / gsz; return true;
  }
};
DI unsigned cvt_pk_bf16(float lo, float hi) { unsigned r; asm volatile("v_cvt_pk_bf16_f32 %0, %1, %2" : "=v"(r) : "v"(lo), "v"(hi)); return r; }

template <class Epi>
DI void gemm_phase(PG8_LAS unsigned char* lds, const Gemm g, const StaticOrder& S, const Epi& E) {
  int tid = threadIdx.x;
  asm volatile("" : "+v"(tid));
  const int wid = __builtin_amdgcn_readfirstlane(tid >> 6), lane = tid & 63, wr = wid >> 2, wc = wid & 3, fr = lane & 15, fq = lane >> 4;
  const int K = g.K, nt = K / BK;
  unsigned voffA[2], voffB[2];
#pragma unroll
  for (int i = 0; i < 2; ++i) { int R, C; stage_rc(tid * 16 + i * 8192, R, C); const int Rb = Epi::PERM ? ((R & ~31) + perm32(R & 31)) : R;
    voffA[i] = (unsigned)(R * K + C) * 2u; voffB[i] = (unsigned)(Rb * K + C) * 2u; }
  const size_t kstep = (size_t)(BK * 2);
  const size_t hstep = (size_t)HALF * K * 2;
  const size_t tstep = 2 * hstep;
  const unsigned ldsw = (unsigned)wid * 1024u;
  const int aoff = lds_byte(wr * 64 + fr, fq * 8), boff = lds_byte(wc * 32 + fr, fq * 8);
#define PG8_SA(b, h) (((b) * 2 + (h)) * HTB)
#define PG8_SB(b, h) ((4 + (b) * 2 + (h)) * HTB)
#define PG8_STAGE(bufoff, gbase, voff) do { _Pragma("unroll") for (int _i = 0; _i < 2; ++_i) \
    __builtin_amdgcn_global_load_lds((const unsigned*)((const char*)(gbase) + (voff)[_i]), (PG8_LAS unsigned*)(lds + (bufoff) + ldsw + _i * 8192), 16, 0, 0); } while (0)
#define PG8_LDA(dst, b, h) do { _Pragma("unroll") for (int m = 0; m < 4; ++m) _Pragma("unroll") for (int k = 0; k < 2; ++k) dst[m][k] = *(const PG8_LAS bf16x8*)(lds + PG8_SA(b, h) + aoff + m * 2048 + k * 1024); } while (0)
#define PG8_LDB(dst, b, h) do { _Pragma("unroll") for (int n = 0; n < 2; ++n) _Pragma("unroll") for (int k = 0; k < 2; ++k) dst[n][k] = *(const PG8_LAS bf16x8*)(lds + PG8_SB(b, h) + boff + n * 2048 + k * 1024); } while (0)
#define PG8_MMA(ai, bj, At, Bt) do { __builtin_amdgcn_s_setprio(1); _Pragma("unroll") for (int m = 0; m < 4; ++m) _Pragma("unroll") for (int n = 0; n < 2; ++n) _Pragma("unroll") for (int k = 0; k < 2; ++k) \
    acc[ai][bj][m][n] = __builtin_amdgcn_mfma_f32_16x16x32_bf16(Bt[n][k], At[m][k], acc[ai][bj][m][n], 0, 0, 0); __builtin_amdgcn_s_setprio(0); } while (0)
#define PG8_WAIT_V(n) asm volatile("s_waitcnt vmcnt(" #n ")" ::: "memory")
#define PG8_WAIT_L(n) asm volatile("s_waitcnt lgkmcnt(" #n ")" ::: "memory")
#define PG8_BAR __builtin_amdgcn_s_barrier()
#define PG8_SCHED __builtin_amdgcn_sched_barrier(0)
  Unit cur, nxt; int ui = 0;
  if (!S.next(0, cur)) return;
  f32x4 acc[2][2][4][2];
#pragma unroll
  for (int a = 0; a < 2; ++a)
#pragma unroll
    for (int b = 0; b < 2; ++b)
#pragma unroll
      for (int m = 0; m < 4; ++m)
#pragma unroll
        for (int n = 0; n < 2; ++n) acc[a][b][m][n] = (f32x4){0.f, 0.f, 0.f, 0.f};
  bf16x8 At[4][2], B0[2][2], B1[2][2];
  const char* cA = (const char*)g.A + (size_t)cur.pm * tstep; const char* cB = (const char*)g.Bt + (size_t)cur.pn * tstep;
  PG8_STAGE(PG8_SB(0, 0), cB, voffB); PG8_STAGE(PG8_SA(0, 0), cA, voffA); PG8_STAGE(PG8_SB(0, 1), cB + hstep, voffB); PG8_STAGE(PG8_SA(0, 1), cA + hstep, voffA);
  if (wr == 1) PG8_BAR;
  PG8_WAIT_V(4); PG8_BAR;
  PG8_STAGE(PG8_SB(1, 0), cB + kstep, voffB); PG8_STAGE(PG8_SA(1, 0), cA + kstep, voffA); PG8_STAGE(PG8_SB(1, 1), cB + hstep + kstep, voffB);
  PG8_WAIT_V(6); PG8_BAR;
  for (;;) {
    const bool has_next = S.next(ui + 1, nxt);
    const char* nA = has_next ? (const char*)g.A + (size_t)nxt.pm * tstep : cA; const char* nB = has_next ? (const char*)g.Bt + (size_t)nxt.pn * tstep : cB;
    for (int t = 0; t < nt; t += 2) {
      const bool last = (t == nt - 2);
      const char* a1 = cA + (size_t)(t + 1) * kstep;
      const char* a2 = last ? nA : cA + (size_t)(t + 2) * kstep; const char* b2 = last ? nB : cB + (size_t)(t + 2) * kstep;
      const char* a3 = a2 + kstep; const char* b3 = b2 + kstep;
      PG8_LDB(B0, 0, 0); PG8_SCHED; PG8_LDA(At, 0, 0); PG8_STAGE(PG8_SA(1, 1), a1 + hstep, voffA);
      PG8_WAIT_L(8); PG8_BAR; PG8_WAIT_L(0); PG8_MMA(0, 0, At, B0); PG8_BAR; PG8_SCHED;
      PG8_LDB(B1, 0, 1); PG8_STAGE(PG8_SB(0, 0), b2, voffB);
      PG8_BAR; PG8_WAIT_L(0); PG8_MMA(0, 1, At, B1); PG8_BAR;
      PG8_LDA(At, 0, 1); PG8_STAGE(PG8_SA(0, 0), a2, voffA);
      PG8_BAR; PG8_WAIT_L(0); PG8_MMA(1, 0, At, B0); PG8_BAR; PG8_SCHED;
      PG8_STAGE(PG8_SB(0, 1), b2 + hstep, voffB);
      PG8_WAIT_V(6); PG8_BAR; PG8_MMA(1, 1, At, B1); PG8_BAR;
      PG8_LDB(B0, 1, 0); PG8_SCHED; PG8_LDA(At, 1, 0); PG8_STAGE(PG8_SA(0, 1), a2 + hstep, voffA);
      PG8_WAIT_L(8); PG8_BAR; PG8_WAIT_L(0); PG8_MMA(0, 0, At, B0); PG8_BAR; PG8_SCHED;
      PG8_LDB(B1, 1, 1); PG8_STAGE(PG8_SB(1, 0), b3, voffB);
      PG8_BAR; PG8_WAIT_L(0); PG8_MMA(0, 1, At, B1); PG8_BAR;
      PG8_LDA(At, 1, 1); PG8_STAGE(PG8_SA(1, 0), a3, voffA);
      PG8_BAR; PG8_WAIT_L(0); PG8_MMA(1, 0, At, B0); PG8_BAR; PG8_SCHED;
      PG8_STAGE(PG8_SB(1, 1), b3 + hstep, voffB);
      PG8_WAIT_V(6); PG8_BAR; PG8_MMA(1, 1, At, B1); PG8_BAR;
    }
    E(acc, cur, wr, wc, fr, fq);
    if (!has_next) break;
#pragma unroll
    for (int a = 0; a < 2; ++a)
#pragma unroll
      for (int b = 0; b < 2; ++b)
#pragma unroll
        for (int m = 0; m < 4; ++m)
#pragma unroll
          for (int n = 0; n < 2; ++n) acc[a][b][m][n] = (f32x4){0.f, 0.f, 0.f, 0.f};
    cur = nxt; cA = nA; cB = nB; ++ui;
  }
  PG8_WAIT_V(0);
  if (wr == 0) PG8_BAR;
  PG8_BAR;
#undef PG8_SA
#undef PG8_SB
#undef PG8_STAGE
#undef PG8_LDA
#undef PG8_LDB
#undef PG8_MMA
#undef PG8_WAIT_V
#undef PG8_WAIT_L
#undef PG8_BAR
#undef PG8_SCHED
}
}

struct EpiO {
  static constexpr bool PERM = true;
  u16* C;
  DI void operator()(const f32x4 (&acc)[2][2][4][2], const pg8::Unit& u, int wr, int wc, int fr, int fq) const {
    const int row0 = u.pm * 256 + wr * 64 + fr, col0 = u.pn * 256 + wc * 32 + 8 * fq;
#pragma unroll
    for (int ai = 0; ai < 2; ++ai)
#pragma unroll
      for (int m = 0; m < 4; ++m) {
        u16* rowp = C + (unsigned)(row0 + ai * 128 + m * 16) * 1024u + (unsigned)col0;
#pragma unroll
        for (int bj = 0; bj < 2; ++bj) {
          const f32x4 v0 = acc[ai][bj][m][0], v1 = acc[ai][bj][m][1];
          u32x4 w; w.x = pg8::cvt_pk_bf16(v0[0], v0[1]); w.y = pg8::cvt_pk_bf16(v0[2], v0[3]); w.z = pg8::cvt_pk_bf16(v1[0], v1[1]); w.w = pg8::cvt_pk_bf16(v1[2], v1[3]);
          *(u32x4*)(rowp + bj * 128) = w;
        }
      }
  }
};

struct EpiGU {
  static constexpr bool PERM = true;
  u16* act;
  DI void operator()(const f32x4 (&acc)[2][2][4][2], const pg8::Unit& u, int wr, int wc, int fr, int fq) const {
    const int row0 = u.pm * 256 + wr * 64 + fr, col0 = u.pn * 128 + wc * 32 + 8 * fq;
#pragma unroll
    for (int ai = 0; ai < 2; ++ai)
#pragma unroll
      for (int m = 0; m < 4; ++m) {
        float r[8];
#pragma unroll
        for (int n = 0; n < 2; ++n)
#pragma unroll
          for (int j = 0; j < 4; ++j) {
            const float g = acc[ai][0][m][n][j], up = acc[ai][1][m][n][j];
            r[n * 4 + j] = g * __builtin_amdgcn_rcpf(1.f + __expf(-g)) * up;
          }
        u32x4 w; w.x = pg8::cvt_pk_bf16(r[0], r[1]); w.y = pg8::cvt_pk_bf16(r[2], r[3]); w.z = pg8::cvt_pk_bf16(r[4], r[5]); w.w = pg8::cvt_pk_bf16(r[6], r[7]);
        *(u32x4*)(act + (size_t)(row0 + ai * 128 + m * 16) * FF + col0) = w;
      }
  }
};

struct EpiIn {
  static constexpr bool PERM = false;
  const P* pp; int l;
  DI void operator()(const f32x4 (&acc)[2][2][4][2], const pg8::Unit& u, int wr, int wc, int fr, int fq) const {
    const P& p = *pp;
    const int c0 = u.pn * 256 + wc * 64;
    const int rb = u.pm * 256 + wr * 64 + fr;
    const bool prm = u.pm * 256 < TP;
    int region, hh;
    if (c0 < 256) { region = 0; hh = c0 >> 6; }
    else if (c0 < 512) { region = 1; hh = (c0 - 256) >> 6; }
    else if (c0 < 768) { region = 2; hh = (c0 - 512) >> 6; }
    else if (c0 < 1280) { region = 3; hh = (c0 - 768) >> 6; }
    else if (c0 < 1408) { region = 4; hh = (c0 - 1280) >> 6; }
    else if (c0 < 1536) { region = 5; hh = (c0 - 1408) >> 6; }
    else if (c0 < 1792) { region = 6; hh = (c0 - 1536) >> 6; }
    else if (c0 < 2048) { region = 7; hh = (c0 - 1792) >> 6; }
    else if (c0 < 2304) { region = 8; hh = (c0 - 2048) >> 6; }
    else { region = 9; hh = (c0 - 2304) >> 6; }
    const unsigned dl = fq * 4;
    if (region == 2 || region == 5 || region == 8 || region == 7) {
      u16* vt = region == 2 ? p.vt_na() : (region == 5 ? p.vt_gqa() : (region == 7 ? p.kt_ml() : p.vt_ml()));
      const int H = region == 5 ? 2 : 4;
      const float mul = region == 7 ? 0.125f : 1.f;
      const unsigned Tlen = prm ? 256u : 1024u;
#pragma unroll
      for (int ai = 0; ai < 2; ++ai)
#pragma unroll
        for (int m = 0; m < 4; ++m) {
          const int row = rb + ai * 128 + m * 16;
          unsigned vbase;
          if (prm) vbase = (unsigned)(((row >> 8) * H + hh) * 64) * 256u + (unsigned)(row & 255);
          else { const int r = row - TP; vbase = (unsigned)(16 * H * 64 * 256) + (unsigned)((((r >> 10) * H + hh) * 64)) * 1024u + (unsigned)(r & 1023); }
          u16* vp = vt + vbase + dl * Tlen;
#pragma unroll
          for (int bj = 0; bj < 2; ++bj)
#pragma unroll
            for (int n = 0; n < 2; ++n)
#pragma unroll
              for (int j = 0; j < 4; ++j) vp[(unsigned)(bj * 32 + n * 16 + j) * Tlen] = f2bf(acc[ai][bj][m][n][j] * mul);
        }
    }
    if (prm && (region == 1 || region == 2 || region == 5)) {
#pragma unroll
      for (int ai = 0; ai < 2; ++ai)
#pragma unroll
        for (int m = 0; m < 4; ++m) {
          const int row = rb + ai * 128 + m * 16, b = row >> 8, t = row & 255;
          unsigned base;
          if (region == 5) base = (unsigned)O_GQA + (unsigned)((((b * 4 + l) * 2 + 1) * 2 + hh) * 256 + t) * 64u;
          else base = (unsigned)O_NA + (unsigned)((((b * 4 + l) * 2 + (region == 2 ? 1 : 0)) * 4 + hh) * 256 + t) * 64u;
          float* op = p.out + base + dl;
#pragma unroll
          for (int bj = 0; bj < 2; ++bj)
#pragma unroll
            for (int n = 0; n < 2; ++n) *(f32x4*)(op + bj * 32 + n * 16) = acc[ai][bj][m][n];
        }
    }
    if (region == 2 || region == 5 || region == 8) return;
    if (region == 3 || region == 4) {
      const float* gq = p.g_qk + (l * 2 + (region == 4 ? 1 : 0)) * 64 + dl;
      f32x4 gv[2][2];
#pragma unroll
      for (int bj = 0; bj < 2; ++bj)
#pragma unroll
        for (int n = 0; n < 2; ++n) gv[bj][n] = *(const f32x4*)(gq + bj * 32 + n * 16);
#pragma unroll
      for (int ai = 0; ai < 2; ++ai)
#pragma unroll
        for (int m = 0; m < 4; ++m) {
          const int row = rb + ai * 128 + m * 16;
          f32x4 v[2][2];
          float ss = 0.f;
#pragma unroll
          for (int bj = 0; bj < 2; ++bj)
#pragma unroll
            for (int n = 0; n < 2; ++n) {
              v[bj][n] = acc[ai][bj][m][n];
#pragma unroll
              for (int j = 0; j < 4; ++j) ss += v[bj][n][j] * v[bj][n][j];
            }
          ss += __shfl_xor(ss, 16);
          ss += __shfl_xor(ss, 32);
          const float rs = rsqrtf(ss * (1.f / 64.f) + EPS);
#pragma unroll
          for (int bj = 0; bj < 2; ++bj)
#pragma unroll
            for (int n = 0; n < 2; ++n) v[bj][n] = v[bj][n] * rs * gv[bj][n];
          if (prm) {
            if (region == 4) {
              const int b = row >> 8, t = row & 255;
              float* op = p.out + (unsigned)O_GQA + (unsigned)((((b * 4 + l) * 2 + 0) * 2 + hh) * 256 + t) * 64u + dl;
#pragma unroll
              for (int bj = 0; bj < 2; ++bj)
#pragma unroll
                for (int n = 0; n < 2; ++n) *(f32x4*)(op + bj * 32 + n * 16) = v[bj][n];
            }
          } else {
            const int t = (row - TP) & 1023, pr = t >> 6, pc = t & 63;
#pragma unroll
            for (int bj = 0; bj < 2; ++bj) {
              const int pos = bj ? pc : pr;
              const f32x4 cs = *(const f32x4*)(p.rope() + pos * 16 + dl), sn = *(const f32x4*)(p.rope() + 1024 + pos * 16 + dl);
              const f32x4 x1 = v[bj][0], x2 = v[bj][1];
              v[bj][0] = x1 * cs - x2 * sn;
              v[bj][1] = x2 * cs + x1 * sn;
            }
          }
          u16* zp = p.zb() + (unsigned)row * (unsigned)ZW + (unsigned)c0 + dl;
#pragma unroll
          for (int bj = 0; bj < 2; ++bj)
#pragma unroll
            for (int n = 0; n < 2; ++n) {
              uint2 w; w.x = pg8::cvt_pk_bf16(v[bj][n][0], v[bj][n][1]); w.y = pg8::cvt_pk_bf16(v[bj][n][2], v[bj][n][3]);
              *(uint2*)(zp + bj * 32 + n * 16) = w;
            }
        }
      return;
    }
    {
      const float mul = region == 7 ? 0.125f : 1.f;
#pragma unroll
      for (int ai = 0; ai < 2; ++ai)
#pragma unroll
        for (int m = 0; m < 4; ++m) {
          const int row = rb + ai * 128 + m * 16;
          u16* zp = p.zb() + (unsigned)row * (unsigned)ZW + (unsigned)c0 + dl;
#pragma unroll
          for (int bj = 0; bj < 2; ++bj)
#pragma unroll
            for (int n = 0; n < 2; ++n) {
              const f32x4 v = acc[ai][bj][m][n] * mul;
              uint2 w; w.x = pg8::cvt_pk_bf16(v[0], v[1]); w.y = pg8::cvt_pk_bf16(v[2], v[3]);
              *(uint2*)(zp + bj * 32 + n * 16) = w;
            }
        }
    }
  }
};

DI void phase_gemm(const P& p, int which, int l, char* smem) {
  PG8_LAS unsigned char* lds = (PG8_LAS unsigned char*)smem;
  pg8::StaticOrder S;
  pg8::Gemm g;
  if (which == 0) {
    g.A = p.hn(); g.Bt = p.wt_in() + (size_t)l * ZW * 1024; g.M = TT; g.N = ZW; g.K = 1024;
    S.init(g.M, g.N, p.nblk, blockIdx.x);
    EpiIn E; E.pp = &p; E.l = l;
    pg8::gemm_phase(lds, g, S, E);
  } else if (which == 1) {
    g.A = p.mix(); g.Bt = p.wt_out() + (size_t)l * 1024 * 1024; g.M = TT; g.N = 1024; g.K = 1024;
    S.init(g.M, g.N, p.nblk, blockIdx.x);
    EpiO E; E.C = (u16*)p.obuf();
    pg8::gemm_phase(lds, g, S, E);
  } else if (which == 2) {
    g.A = p.hn(); g.Bt = p.wt_gu() + (size_t)l * 5632 * 1024; g.M = TT; g.N = 5632; g.K = 1024;
    S.init(g.M, g.N, p.nblk, blockIdx.x);
    EpiGU E; E.act = p.act();
    pg8::gemm_phase(lds, g, S, E);
  } else {
    g.A = p.act(); g.Bt = p.wt_down() + (size_t)l * 1024 * FF; g.M = TT; g.N = 1024; g.K = FF;
    S.init(g.M, g.N, p.nblk, blockIdx.x);
    EpiO E; E.C = (u16*)p.obuf();
    pg8::gemm_phase(lds, g, S, E);
  }
}

template <bool WIN>
DI void attn_seg(const u16* __restrict__ K, int ldk, const u16* __restrict__ V, int ldv, int nkeys, const bf16x8 (&qf)[4][2],
                 f32x4 (&o)[4][4], float (&m)[4], float (&lsum)[4], const float* __restrict__ bias, int rdelta, int fr, int fq) {
  const float L2E = 1.44269504f;
  for (int key0 = 0; key0 < nkeys; key0 += 32) {
    bf16x8 kf[2][2];
#pragma unroll
    for (int mt = 0; mt < 2; ++mt)
#pragma unroll
      for (int ks = 0; ks < 2; ++ks) kf[mt][ks] = ld8(K + (size_t)(key0 + mt * 16 + fr) * ldk + ks * 32 + fq * 8);
    bf16x8 va[4];
#pragma unroll
    for (int dt = 0; dt < 4; ++dt) {
      const u16* vp = V + (size_t)(dt * 16 + fr) * ldv + key0 + fq * 4;
      va[dt] = ld4x2(vp, vp + 16);
    }
    f32x4 s[2][4];
#pragma unroll
    for (int mt = 0; mt < 2; ++mt)
#pragma unroll
      for (int nt = 0; nt < 4; ++nt) {
        s[mt][nt] = zero4();
#pragma unroll
        for (int ks = 0; ks < 2; ++ks) s[mt][nt] = MFMA16(kf[mt][ks], qf[nt][ks], s[mt][nt]);
      }
    const float SC = 0.125f * L2E;
    if (WIN) {
      const int krel = key0 >> 6, ckb = key0 & 63;
      const float* brow = bias + (rdelta + krel) * 31;
#pragma unroll
      for (int nt = 0; nt < 4; ++nt) {
        const int cq = nt * 16 + fr;
        const int cw = min(max(cq - 8, 0), 48);
#pragma unroll
        for (int mt = 0; mt < 2; ++mt)
#pragma unroll
          for (int j = 0; j < 4; ++j) {
            const int ck = ckb + mt * 16 + fq * 4 + j;
            const bool valid = (ck >= cw) && (ck < cw + 16);
            const int dc = min(max(ck - cq, -15), 15) + 15;
            const float bv = brow[dc];
            s[mt][nt][j] = valid ? (s[mt][nt][j] + bv * 8.f) : -INFINITY;
          }
      }
    }
    bf16x8 pb[4];
    float tmx[4];
    bool grow = false;
#pragma unroll
    for (int nt = 0; nt < 4; ++nt) {
      float tm = fmaxf(fmaxf(fmaxf(s[0][nt][0], s[0][nt][1]), fmaxf(s[0][nt][2], s[0][nt][3])),
                       fmaxf(fmaxf(s[1][nt][0], s[1][nt][1]), fmaxf(s[1][nt][2], s[1][nt][3])));
      tm = fmaxf(tm, __shfl_xor(tm, 16));
      tm = fmaxf(tm, __shfl_xor(tm, 32));
      tm *= SC;
      tmx[nt] = tm;
      grow = grow || (tm > m[nt]);
    }
    if (__any(grow)) {
#pragma unroll
      for (int nt = 0; nt < 4; ++nt) {
        const float mn = fmaxf(m[nt], tmx[nt]);
        const float alpha = __builtin_amdgcn_exp2f(m[nt] - mn);
        m[nt] = mn;
        lsum[nt] *= alpha;
#pragma unroll
        for (int dt = 0; dt < 4; ++dt) o[dt][nt] *= alpha;
      }
    }
#pragma unroll
    for (int nt = 0; nt < 4; ++nt) {
      const float nm = -m[nt];
      float ps = 0.f;
#pragma unroll
      for (int mt = 0; mt < 2; ++mt)
#pragma unroll
        for (int j = 0; j < 4; ++j) { float pv = __builtin_amdgcn_exp2f(__builtin_fmaf(s[mt][nt][j], SC, nm)); s[mt][nt][j] = pv; ps += pv; }
      lsum[nt] += ps;
      pb[nt] = pack8(s[0][nt], s[1][nt]);
    }
#pragma unroll
    for (int dt = 0; dt < 4; ++dt)
#pragma unroll
      for (int nt = 0; nt < 4; ++nt) o[dt][nt] = MFMA16(va[dt], pb[nt], o[dt][nt]);
  }
}

template <bool WIN>
DI void attn_wave(const u16* Q, int ldq, const u16* K0, int ldk0, const u16* V0, int ldv0, int n0, const u16* K1, int ldk1,
                  const u16* V1, int ldv1, int n1, u16* O, int ldo, const float* bias, int rdelta, int lane) {
  const int fr = lane & 15, fq = lane >> 4;
  bf16x8 qf[4][2];
#pragma unroll
  for (int nt = 0; nt < 4; ++nt)
#pragma unroll
    for (int ks = 0; ks < 2; ++ks) qf[nt][ks] = ld8(Q + (size_t)(nt * 16 + fr) * ldq + ks * 32 + fq * 8);
  f32x4 o[4][4];
  float m[4], lsum[4];
#pragma unroll
  for (int i = 0; i < 4; ++i) {
    m[i] = -1e30f; lsum[i] = 0.f;
#pragma unroll
    for (int j = 0; j < 4; ++j) o[i][j] = zero4();
  }
  attn_seg<WIN>(K0, ldk0, V0, ldv0, n0, qf, o, m, lsum, bias, rdelta, fr, fq);
  if (n1 > 0) attn_seg<false>(K1, ldk1, V1, ldv1, n1, qf, o, m, lsum, bias, rdelta, fr, fq);
#pragma unroll
  for (int nt = 0; nt < 4; ++nt) {
    float lt = lsum[nt];
    lt += __shfl_xor(lt, 16);
    lt += __shfl_xor(lt, 32);
    const float inv = 1.f / lt;
#pragma unroll
    for (int dt = 0; dt < 4; ++dt) {
      uint2 w; w.x = pack2(o[dt][nt][0] * inv, o[dt][nt][1] * inv); w.y = pack2(o[dt][nt][2] * inv, o[dt][nt][3] * inv);
      *(uint2*)(O + (size_t)(nt * 16 + fr) * ldo + dt * 16 + fq * 4) = w;
    }
  }
}

template <bool WIN>
DI void attn_block(LAS unsigned char* lds, int tid, const u16* Q, int ldq,
                   const u16* K0, int ldk0, const u16* V0, int ldv0, int nt0,
                   const u16* K1, int ldk1, const u16* V1, int ldv1, int nt1,
                   u16* O, int ldo, const LAS float* bias, int rdelta, int wlo) {
  const int lane = tid & 63, fr = lane & 15, fq = lane >> 4;
  const int wid = __builtin_amdgcn_readfirstlane(tid >> 6);
  const float L2E = 1.44269504f, SC = 0.125f * L2E;
  bf16x8 qf[4][2];
#pragma unroll
  for (int nt = 0; nt < 4; ++nt)
#pragma unroll
    for (int ks = 0; ks < 2; ++ks) qf[nt][ks] = ld8(Q + (size_t)(nt * 16 + fr) * ldq + ks * 32 + fq * 8);
  f32x4 o[4][4];
  float m[4], lsum[4];
#pragma unroll
  for (int i = 0; i < 4; ++i) {
    m[i] = -1e30f; lsum[i] = 0.f;
#pragma unroll
    for (int j = 0; j < 4; ++j) o[i][j] = zero4();
  }
  const int ntl = nt0 + nt1;
  const int rr = tid >> 3, pp = tid & 7, part = pp ^ (rr & 7);
#define AB_ISSUE(t) do { const int _t = (t); const u16* _k; const u16* _v; \
    if (_t < nt0) { _k = K0 + (size_t)(_t * 64 + rr) * ldk0 + part * 8; _v = V0 + (size_t)rr * ldv0 + _t * 64 + part * 8; } \
    else { _k = K1 + (size_t)((_t - nt0) * 64 + rr) * ldk1 + part * 8; _v = V1 + (size_t)rr * ldv1 + (_t - nt0) * 64 + part * 8; } \
    LAS unsigned char* _s = lds + (_t & 3) * 16384 + wid * 1024; \
    __builtin_amdgcn_global_load_lds((const unsigned*)_k, (LAS unsigned*)_s, 16, 0, 0); \
    __builtin_amdgcn_global_load_lds((const unsigned*)_v, (LAS unsigned*)(_s + 8192), 16, 0, 0); } while (0)
  if (0 < ntl) AB_ISSUE(0);
  if (1 < ntl) AB_ISSUE(1);
  if (2 < ntl) AB_ISSUE(2);
  for (int t = 0; t < ntl; ++t) {
    const int rem = ntl - 1 - t;
    if (rem >= 2) asm volatile("s_waitcnt vmcnt(4)" ::: "memory");
    else if (rem == 1) asm volatile("s_waitcnt vmcnt(2)" ::: "memory");
    else asm volatile("s_waitcnt vmcnt(0)" ::: "memory");
    __builtin_amdgcn_s_barrier();
    asm volatile("" ::: "memory");
    if (t + 3 < ntl) AB_ISSUE(t + 3);
    const bool win_tile = WIN && (t < nt0);
    if (win_tile && (t < wlo || t >= wlo + 8)) continue;
    const LAS unsigned char* sk = lds + (t & 3) * 16384;
    const LAS unsigned char* sv = sk + 8192;
#pragma unroll
    for (int sub = 0; sub < 2; ++sub) {
      bf16x8 kf[2][2];
#pragma unroll
      for (int mt = 0; mt < 2; ++mt)
#pragma unroll
        for (int ks = 0; ks < 2; ++ks) {
          const int key = sub * 32 + mt * 16 + fr;
          kf[mt][ks] = *(const LAS bf16x8*)(sk + key * 128 + (((ks * 4 + fq) ^ (key & 7)) << 4));
        }
      bf16x8 va[4];
#pragma unroll
      for (int dt = 0; dt < 4; ++dt) {
        const int d = dt * 16 + fr, q1 = sub * 4 + (fq >> 1);
        const u32x2 a = *(const LAS u32x2*)(sv + d * 128 + ((q1 ^ (d & 7)) << 4) + (fq & 1) * 8);
        const u32x2 b = *(const LAS u32x2*)(sv + d * 128 + (((q1 + 2) ^ (d & 7)) << 4) + (fq & 1) * 8);
        u32x4 r4; r4.x = a.x; r4.y = a.y; r4.z = b.x; r4.w = b.y;
        va[dt] = __builtin_bit_cast(bf16x8, r4);
      }
      f32x4 s[2][4];
#pragma unroll
      for (int mt = 0; mt < 2; ++mt)
#pragma unroll
        for (int nt = 0; nt < 4; ++nt) {
          s[mt][nt] = zero4();
#pragma unroll
          for (int ks = 0; ks < 2; ++ks) s[mt][nt] = MFMA16(kf[mt][ks], qf[nt][ks], s[mt][nt]);
        }
      if (win_tile) {
        const LAS float* brow = bias + (rdelta + (t - wlo)) * 31;
        const int ckb = sub * 32;
#pragma unroll
        for (int nt = 0; nt < 4; ++nt) {
          const int cq = nt * 16 + fr;
          const int cw = min(max(cq - 8, 0), 48);
#pragma unroll
          for (int mt = 0; mt < 2; ++mt)
#pragma unroll
            for (int j = 0; j < 4; ++j) {
              const int ck = ckb + mt * 16 + fq * 4 + j;
              const bool valid = (ck >= cw) && (ck < cw + 16);
              const int dc = min(max(ck - cq, -15), 15) + 15;
              const float bv = brow[dc];
              s[mt][nt][j] = valid ? (s[mt][nt][j] + bv * 8.f) : -INFINITY;
            }
        }
      }
      bf16x8 pb[4];
      float tmx[4];
      bool grow = false;
#pragma unroll
      for (int nt = 0; nt < 4; ++nt) {
        float tm = fmaxf(fmaxf(fmaxf(s[0][nt][0], s[0][nt][1]), fmaxf(s[0][nt][2], s[0][nt][3])),
                         fmaxf(fmaxf(s[1][nt][0], s[1][nt][1]), fmaxf(s[1][nt][2], s[1][nt][3])));
        tm = fmaxf(tm, __shfl_xor(tm, 16));
        tm = fmaxf(tm, __shfl_xor(tm, 32));
        tm *= SC;
        tmx[nt] = tm;
        grow = grow || (tm > m[nt]);
      }
      if (__any(grow)) {
#pragma unroll
        for (int nt = 0; nt < 4; ++nt) {
          const float mn = fmaxf(m[nt], tmx[nt]);
          const float alpha = __builtin_amdgcn_exp2f(m[nt] - mn);
          m[nt] = mn;
          lsum[nt] *= alpha;
#pragma unroll
          for (int dt = 0; dt < 4; ++dt) o[dt][nt] *= alpha;
        }
      }
#pragma unroll
      for (int nt = 0; nt < 4; ++nt) {
        const float nm = -m[nt];
        float ps = 0.f;
#pragma unroll
        for (int mt = 0; mt < 2; ++mt)
#pragma unroll
          for (int j = 0; j < 4; ++j) { float pv = __builtin_amdgcn_exp2f(__builtin_fmaf(s[mt][nt][j], SC, nm)); s[mt][nt][j] = pv; ps += pv; }
        lsum[nt] += ps;
        pb[nt] = pack8(s[0][nt], s[1][nt]);
      }
#pragma unroll
      for (int dt = 0; dt < 4; ++dt)
#pragma unroll
        for (int nt = 0; nt < 4; ++nt) o[dt][nt] = MFMA16(va[dt], pb[nt], o[dt][nt]);
    }
  }
#undef AB_ISSUE
#pragma unroll
  for (int nt = 0; nt < 4; ++nt) {
    float lt = lsum[nt];
    lt += __shfl_xor(lt, 16);
    lt += __shfl_xor(lt, 32);
    const float inv = 1.f / lt;
#pragma unroll
    for (int dt = 0; dt < 4; ++dt) {
      uint2 w; w.x = pack2(o[dt][nt][0] * inv, o[dt][nt][1] * inv); w.y = pack2(o[dt][nt][2] * inv, o[dt][nt][3] * inv);
      *(uint2*)(O + (size_t)(nt * 16 + fr) * ldo + dt * 16 + fq * 4) = w;
    }
  }
}

DI float logsig(float x) { return fminf(x, 0.f) - __logf(1.f + __expf(-fabsf(x))); }

DI void mlstm_item(const P& p, int l, int u, char* smem, int tid, int stages, int cdbase, int ugrp) {
  const int wid = tid >> 6;
  const bool samp = u < 32;
  int b, h, NC, rowbase, ldT, cs0;
  size_t tb;
  if (samp) { b = u >> 2; h = u & 3; NC = 16; rowbase = TP + b * 1024; ldT = 1024; tb = 1048576 + (size_t)((b * 4 + h) * 64) * 1024; cs0 = u * 32; }
  else { int v = u - 32; b = v >> 2; h = v & 3; NC = 4; rowbase = b * 256; ldT = 256; tb = (size_t)((b * 4 + h) * 64) * 256; cs0 = 1024 + v * 8; }
  float* fl = (float*)smem + wid * 768;
  float* W = fl;
  float* U = fl + 64;
  float* MX = fl + 192;
  float* DEC = fl + 320;
  float* EN = fl + 448;
  float* NQ = fl + 576;

  if (stages & 1)
  for (int cd = cdbase + wid; cd < NC * 2 && cd < cdbase + 8; cd += 8) {
    int lane = tid & 63;
    asm volatile("" : "+v"(lane));
    const int fr = lane & 15, fq = lane >> 4;
    const int j = cd >> 1, dir = cd & 1;
    const int cs = cs0 + dir * NC + j;
    const int row = rowbase + j * 64 + lane;
    const float gi = p.gates()[(size_t)row * 16 + dir * 8 + h], gf = p.gates()[(size_t)row * 16 + dir * 8 + 4 + h];
    float bb = logsig(gf);
    if (dir == 0) {
#pragma unroll
      for (int off = 1; off < 64; off <<= 1) { float t = __shfl_up(bb, off); if (lane >= off) bb += t; }
    } else {
#pragma unroll
      for (int off = 1; off < 64; off <<= 1) { float t = __shfl_down(bb, off); if (lane + off < 64) bb += t; }
    }
    const float bend = __shfl(bb, dir ? 0 : 63);
    const float lw = bend - bb + gi;
    const float a = wave_max(lw);
    W[lane] = __expf(lw - a);
    wave_sync();
    f32x4 acc[4][4];
#pragma unroll
    for (int i = 0; i < 4; ++i)
#pragma unroll
      for (int jj = 0; jj < 4; ++jj) acc[i][jj] = zero4();
    const u16* vt = p.vt_ml() + tb + j * 64;
    const u16* kt = p.kt_ml() + tb + j * 64;
#pragma unroll 1
    for (int ks = 0; ks < 2; ++ks) {
      const float4 w0 = *(const float4*)(W + ks * 32 + fq * 8), w1 = *(const float4*)(W + ks * 32 + fq * 8 + 4);
      bf16x8 af[4], bfr[4];
#pragma unroll
      for (int mt = 0; mt < 4; ++mt) {
        bf16x8 raw = ld8(vt + (size_t)(mt * 16 + fr) * ldT + ks * 32 + fq * 8);
        f32x4 lo, hi;
        lo[0] = bf2f((u16)raw[0]) * w0.x; lo[1] = bf2f((u16)raw[1]) * w0.y; lo[2] = bf2f((u16)raw[2]) * w0.z; lo[3] = bf2f((u16)raw[3]) * w0.w;
        hi[0] = bf2f((u16)raw[4]) * w1.x; hi[1] = bf2f((u16)raw[5]) * w1.y; hi[2] = bf2f((u16)raw[6]) * w1.z; hi[3] = bf2f((u16)raw[7]) * w1.w;
        af[mt] = pack8(lo, hi);
      }
#pragma unroll
      for (int nt = 0; nt < 4; ++nt) bfr[nt] = ld8(kt + (size_t)(nt * 16 + fr) * ldT + ks * 32 + fq * 8);
#pragma unroll
      for (int mt = 0; mt < 4; ++mt)
#pragma unroll
        for (int nt = 0; nt < 4; ++nt) acc[mt][nt] = MFMA16(af[mt], bfr[nt], acc[mt][nt]);
    }
    float* ch = p.ml_chat() + (size_t)cs * 4096;
#pragma unroll
    for (int mt = 0; mt < 4; ++mt)
#pragma unroll
      for (int nt = 0; nt < 4; ++nt)
#pragma unroll
        for (int jj = 0; jj < 4; ++jj) ch[(mt * 16 + fq * 4 + jj) * 64 + nt * 16 + fr] = acc[mt][nt][jj];
    float nh = 0.f;
    const u16* kr = kt + (size_t)lane * ldT;
#pragma unroll 1
    for (int c8 = 0; c8 < 8; ++c8) {
      bf16x8 kk = ld8(kr + c8 * 8);
      const float4 wa = *(const float4*)(W + c8 * 8), wb = *(const float4*)(W + c8 * 8 + 4);
      nh += bf2f((u16)kk[0]) * wa.x + bf2f((u16)kk[1]) * wa.y + bf2f((u16)kk[2]) * wa.z + bf2f((u16)kk[3]) * wa.w;
      nh += bf2f((u16)kk[4]) * wb.x + bf2f((u16)kk[5]) * wb.y + bf2f((u16)kk[6]) * wb.z + bf2f((u16)kk[7]) * wb.w;
    }
    p.ml_nhat()[(size_t)cs * 64 + lane] = nh;
    if (lane == 0) { p.ml_ab()[cs * 2] = a; p.ml_ab()[cs * 2 + 1] = bend; }
    wave_sync();
  }
  __syncthreads();

  if (stages & 2) {
    const int dir = tid >> 8, tt = tid & 255, e0 = tt * 16;
    float C[16];
    float n = 0.f, m = 0.f;
    const int sidx = ((b * 4 + l) * 2 + dir) * 4 + h;
    if (samp) {
#pragma unroll
      for (int i = 0; i < 4; ++i) {
        float4 v = *(const float4*)(p.stC + (size_t)sidx * 4096 + e0 + i * 4);
        C[i * 4] = v.x; C[i * 4 + 1] = v.y; C[i * 4 + 2] = v.z; C[i * 4 + 3] = v.w;
      }
      if (tt < 64) n = p.stn[sidx * 64 + tt];
      m = p.stm[sidx];
    } else {
#pragma unroll
      for (int i = 0; i < 16; ++i) { float z = 0.f; asm volatile("" : "+v"(z)); C[i] = z; }
    }
    for (int c4 = 0; c4 < NC; c4 += 4) {
      float4 chv[4][4];
      float av[4], bev[4], nhv[4];
#pragma unroll
      for (int q = 0; q < 4; ++q) {
        const int c = c4 + q, j = dir ? NC - 1 - c : c, cs = cs0 + dir * NC + j;
        av[q] = p.ml_ab()[cs * 2]; bev[q] = p.ml_ab()[cs * 2 + 1];
        nhv[q] = tt < 64 ? p.ml_nhat()[(size_t)cs * 64 + tt] : 0.f;
        const float* ch = p.ml_chat() + (size_t)cs * 4096 + e0;
#pragma unroll
        for (int i = 0; i < 4; ++i) chv[q][i] = *(const float4*)(ch + i * 4);
      }
#pragma unroll
      for (int q = 0; q < 4; ++q) {
        const int c = c4 + q, j = dir ? NC - 1 - c : c, cs = cs0 + dir * NC + j;
        uint4 w0, w1;
        w0.x = pack2(C[0], C[1]); w0.y = pack2(C[2], C[3]); w0.z = pack2(C[4], C[5]); w0.w = pack2(C[6], C[7]);
        w1.x = pack2(C[8], C[9]); w1.y = pack2(C[10], C[11]); w1.z = pack2(C[12], C[13]); w1.w = pack2(C[14], C[15]);
        *(uint4*)(p.ml_cst() + (size_t)cs * 4096 + e0) = w0;
        *(uint4*)(p.ml_cst() + (size_t)cs * 4096 + e0 + 8) = w1;
        if (tt < 64) p.ml_nst()[(size_t)cs * 64 + tt] = n;
        if (tt == 0) p.ml_mst()[cs] = m;
        const float mn = fmaxf(bev[q] + m, av[q]);
        const float carry = __expf(bev[q] + m - mn), beta = __expf(av[q] - mn);
#pragma unroll
        for (int i = 0; i < 4; ++i) {
          C[i * 4] = carry * C[i * 4] + beta * chv[q][i].x; C[i * 4 + 1] = carry * C[i * 4 + 1] + beta * chv[q][i].y;
          C[i * 4 + 2] = carry * C[i * 4 + 2] + beta * chv[q][i].z; C[i * 4 + 3] = carry * C[i * 4 + 3] + beta * chv[q][i].w;
        }
        n = carry * n + beta * nhv[q];
        m = mn;
      }
    }
    if (!samp) {
      float* oc = p.out + O_C + (size_t)sidx * 4096 + e0;
#pragma unroll
      for (int i = 0; i < 4; ++i) { float4 v; v.x = C[i * 4]; v.y = C[i * 4 + 1]; v.z = C[i * 4 + 2]; v.w = C[i * 4 + 3]; *(float4*)(oc + i * 4) = v; }
      if (tt < 64) p.out[O_N + (size_t)sidx * 64 + tt] = n;
      if (tt == 0) p.out[O_M + sidx] = m;
    }
  }
  __syncthreads();

  if (stages & 4)
  for (int uu = ugrp * 8 + wid; uu < NC * 2 && uu < ugrp * 8 + 8; uu += 8) {
    const int j = uu >> 1, half0 = uu & 1;
    int lane = tid & 63;
    asm volatile("" : "+v"(lane));
    const int fr = lane & 15, fq = lane >> 4;
    const int row = rowbase + j * 64 + lane;
    for (int dir = 0; dir < 2; ++dir) {
      const int cs = cs0 + dir * NC + j;
      const float m0 = p.ml_mst()[cs];
      const float gi = p.gates()[(size_t)row * 16 + dir * 8 + h], gf = p.gates()[(size_t)row * 16 + dir * 8 + 4 + h];
      float bb = logsig(gf);
      if (dir == 0) {
#pragma unroll
        for (int off = 1; off < 64; off <<= 1) { float t = __shfl_up(bb, off); if (lane >= off) bb += t; }
      } else {
#pragma unroll
        for (int off = 1; off < 64; off <<= 1) { float t = __shfl_down(bb, off); if (lane + off < 64) bb += t; }
      }
      const float uu = gi - bb;
      float cm = uu;
      if (dir == 0) {
#pragma unroll
        for (int off = 1; off < 64; off <<= 1) { float t = __shfl_up(cm, off); if (lane >= off) cm = fmaxf(cm, t); }
      } else {
#pragma unroll
        for (int off = 1; off < 64; off <<= 1) { float t = __shfl_down(cm, off); if (lane + off < 64) cm = fmaxf(cm, t); }
      }
      const float M = fmaxf(cm, m0);
      U[dir * 64 + lane] = uu;
      MX[dir * 64 + lane] = M;
      DEC[dir * 64 + lane] = __expf(m0 - M);
      EN[dir * 64 + lane] = __expf(-(bb + M));
      const u16* qr = p.zb() + (size_t)row * ZW + 1536 + h * 64;
      const float* ns = p.ml_nst() + (size_t)cs * 64;
      float nq = 0.f;
#pragma unroll
      for (int c8 = 0; c8 < 8; ++c8) {
        bf16x8 qq = ld8(qr + c8 * 8);
#pragma unroll
        for (int jj = 0; jj < 8; ++jj) nq += bf2f((u16)qq[jj]) * ns[c8 * 8 + jj];
      }
      NQ[dir * 64 + lane] = nq;
    }
    wave_sync();
#pragma unroll 1
    for (int half = half0; half < half0 + 1; ++half) {
      int lane_h = lane;
      asm volatile("" : "+v"(lane_h));
      const int fr = lane_h & 15, fq = lane_h >> 4;
      bf16x8 qf[2][2];
#pragma unroll
      for (int nt = 0; nt < 2; ++nt)
#pragma unroll
        for (int ks = 0; ks < 2; ++ks)
          qf[nt][ks] = ld8(p.zb() + (size_t)(rowbase + j * 64 + half * 32 + nt * 16 + fr) * ZW + 1536 + h * 64 + ks * 32 + fq * 8);
      f32x4 hs[4][2];
#pragma unroll
      for (int i = 0; i < 4; ++i) { hs[i][0] = zero4(); hs[i][1] = zero4(); }
#pragma unroll 1
      for (int dir = 0; dir < 2; ++dir) {
        const int cs = cs0 + dir * NC + j;
        f32x4 acc[4][2];
#pragma unroll
        for (int i = 0; i < 4; ++i) { acc[i][0] = zero4(); acc[i][1] = zero4(); }
        const u16* cst = p.ml_cst() + (size_t)cs * 4096;
#pragma unroll
        for (int ks = 0; ks < 2; ++ks)
#pragma unroll
          for (int dt = 0; dt < 4; ++dt) {
            bf16x8 cf = ld8(cst + (dt * 16 + fr) * 64 + ks * 32 + fq * 8);
#pragma unroll
            for (int nt = 0; nt < 2; ++nt) acc[dt][nt] = MFMA16(cf, qf[nt][ks], acc[dt][nt]);
          }
        float dec[2], Mt[2], dsum[2];
#pragma unroll
        for (int nt = 0; nt < 2; ++nt) {
          const int t = half * 32 + nt * 16 + fr;
          dec[nt] = DEC[dir * 64 + t]; Mt[nt] = MX[dir * 64 + t]; dsum[nt] = 0.f;
#pragma unroll
          for (int dt = 0; dt < 4; ++dt) acc[dt][nt] *= dec[nt];
        }
#pragma unroll 1
        for (int sk = 0; sk < 2; ++sk) {
          bf16x8 kf[2][2];
#pragma unroll
          for (int mt = 0; mt < 2; ++mt)
#pragma unroll
            for (int ks = 0; ks < 2; ++ks)
              kf[mt][ks] = ld8(p.zb() + (size_t)(rowbase + j * 64 + sk * 32 + mt * 16 + fr) * ZW + 1792 + h * 64 + ks * 32 + fq * 8);
          f32x4 s[2][2];
#pragma unroll
          for (int mt = 0; mt < 2; ++mt)
#pragma unroll
            for (int nt = 0; nt < 2; ++nt) {
              s[mt][nt] = zero4();
#pragma unroll
              for (int ks = 0; ks < 2; ++ks) s[mt][nt] = MFMA16(kf[mt][ks], qf[nt][ks], s[mt][nt]);
            }
#pragma unroll
          for (int mt = 0; mt < 2; ++mt) {
            const float4 u4 = *(const float4*)(U + dir * 64 + sk * 32 + mt * 16 + fq * 4);
            const float uv[4] = {u4.x, u4.y, u4.z, u4.w};
#pragma unroll
            for (int jj = 0; jj < 4; ++jj) {
              const int stok = sk * 32 + mt * 16 + fq * 4 + jj;
#pragma unroll
              for (int nt = 0; nt < 2; ++nt) {
                const int t = half * 32 + nt * 16 + fr;
                const bool valid = dir ? (stok >= t) : (stok <= t);
                const float w = valid ? __expf(uv[jj] - Mt[nt]) : 0.f;
                const float pv = s[mt][nt][jj] * w;
                s[mt][nt][jj] = pv;
                dsum[nt] += pv;
              }
            }
          }
          bf16x8 pb[2];
#pragma unroll
          for (int nt = 0; nt < 2; ++nt) pb[nt] = pack8(s[0][nt], s[1][nt]);
#pragma unroll
          for (int dt = 0; dt < 4; ++dt) {
            const u16* vp = p.vt_ml() + tb + (size_t)(dt * 16 + fr) * ldT + j * 64 + sk * 32 + fq * 4;
            bf16x8 va = ld4x2(vp, vp + 16);
#pragma unroll
            for (int nt = 0; nt < 2; ++nt) acc[dt][nt] = MFMA16(va, pb[nt], acc[dt][nt]);
          }
        }
#pragma unroll
        for (int nt = 0; nt < 2; ++nt) {
          const int t = half * 32 + nt * 16 + fr;
          float ds = dsum[nt];
          ds += __shfl_xor(ds, 16);
          ds += __shfl_xor(ds, 32);
          const float den = ds + dec[nt] * NQ[dir * 64 + t];
          const float dv = 1.f / fmaxf(fabsf(den), EN[dir * 64 + t]);
#pragma unroll
          for (int dt = 0; dt < 4; ++dt) hs[dt][nt] += acc[dt][nt] * dv;
        }
      }
#pragma unroll
      for (int nt = 0; nt < 2; ++nt) {
        float ss = 0.f;
#pragma unroll
        for (int dt = 0; dt < 4; ++dt)
#pragma unroll
          for (int jj = 0; jj < 4; ++jj) ss += hs[dt][nt][jj] * hs[dt][nt][jj];
        ss += __shfl_xor(ss, 16);
        ss += __shfl_xor(ss, 32);
        const float rs = rsqrtf(ss * (1.f / 64.f) + EPS);
        const int orow = rowbase + j * 64 + half * 32 + nt * 16 + fr;
#pragma unroll
        for (int dt = 0; dt < 4; ++dt) {
          const int v0 = dt * 16 + fq * 4;
          const float4 gn = *(const float4*)(p.g_ml + l * 256 + h * 64 + v0);
          const uint2 mo = *(const uint2*)(p.zb() + (size_t)orow * ZW + 2304 + h * 64 + v0);
          const float o0 = bf2f((u16)(mo.x & 0xffff)), o1 = bf2f((u16)(mo.x >> 16)), o2 = bf2f((u16)(mo.y & 0xffff)), o3 = bf2f((u16)(mo.y >> 16));
          const float r0 = hs[dt][nt][0] * rs * gn.x / (1.f + __expf(-o0));
          const float r1 = hs[dt][nt][1] * rs * gn.y / (1.f + __expf(-o1));
          const float r2 = hs[dt][nt][2] * rs * gn.z / (1.f + __expf(-o2));
          const float r3 = hs[dt][nt][3] * rs * gn.w / (1.f + __expf(-o3));
          uint2 w; w.x = pack2(r0, r1); w.y = pack2(r2, r3);
          *(uint2*)(p.mix() + (size_t)orow * 1024 + 768 + h * 64 + v0) = w;
        }
      }
    }
    wave_sync();
  }
  __syncthreads();
}

#define QCTR_BASE XCD_BAR_WORDS
#define BAR_TOTAL_WORDS (XCD_BAR_WORDS + 4 * 64)
DI void phase_mix(const P& p, int l, char* smem, int tid0) {
  volatile LAS int* sit = (volatile LAS int*)((LAS char*)smem + STAGE_LDS + 64);
  for (;;) {
    __syncthreads();
    if (tid0 == 0) *sit = (int)atomicAdd(&p.bar()[QCTR_BASE + l * 64], 1u);
    __syncthreads();
    const int it = *sit;
    if (it >= 480) break;
    int tv = tid0;
    asm volatile("" : "+v"(tv));
    const int wid = tv >> 6, lane = tv & 63;
    if (it >= 192 && it < 320) {
      mlstm_item(p, l, (it - 192) >> 2, smem, tv, 6, 0, (it - 192) & 3);
    } else if (it < 128) {
      const int x = it, b = x >> 4, kvh = (x >> 3) & 1, qt = (x & 7) * 2 + (wid >> 2), head = kvh * 4 + (wid & 3);
      const int rowbase = TP + b * 1024;
      const int ci = (b * 4 + l) * 2 + kvh;
      attn_block<false>((LAS unsigned char*)smem, tv, p.zb() + (size_t)(rowbase + qt * 64) * ZW + 768 + head * 64, ZW,
                        p.zb() + (size_t)rowbase * ZW + 1280 + kvh * 64, ZW, p.vt_gqa() + 524288 + (size_t)((b * 2 + kvh) * 64) * 1024, 1024, 16,
                        p.kc_gqa() + (size_t)ci * 16384, 64, p.vct_gqa() + (size_t)ci * 16384, 256, 4,
                        p.mix() + (size_t)(rowbase + qt * 64) * 1024 + 256 + head * 64, 1024, nullptr, 0, 0);
    } else if (it < 192) {
      const int x = it - 128, b = x >> 3, h = (x >> 1) & 3, rg = x & 1, r = rg * 8 + wid;
      const int rowbase = TP + b * 1024;
      const int r0 = min(max(r - 4, 0), 8);
      const int ulo = rg ? 4 : 0, nt0 = rg ? 12 : 11;
      const int ci = (b * 4 + l) * 4 + h;
      LAS float* btab = (LAS float*)((LAS char*)smem + 65536);
      for (int i = tv; i < 15 * 31; i += NTHR) btab[i] = p.na_bias[(size_t)(l * 4 + h) * 15 * 31 + i];
      __syncthreads();
      attn_block<true>((LAS unsigned char*)smem, tv, p.zb() + (size_t)(rowbase + r * 64) * ZW + h * 64, ZW,
                       p.zb() + (size_t)(rowbase + ulo * 64) * ZW + 256 + h * 64, ZW, p.vt_na() + 1048576 + (size_t)((b * 4 + h) * 64) * 1024 + ulo * 64, 1024, nt0,
                       p.kc_na() + (size_t)ci * 16384, 64, p.vct_na() + (size_t)ci * 16384, 256, 4,
                       p.mix() + (size_t)(rowbase + r * 64) * 1024 + h * 64, 1024, btab, r0 - r + 7, r0 - ulo);
    } else if (it < 384) {
      mlstm_item(p, l, 32 + (it - 320), smem, tv, 6, 0, 0);
    } else if (it < 448) {
      const int x = it - 384, b = x >> 2, kvh = (x >> 1) & 1, qt = (x & 1) * 2 + (wid >> 2), head = kvh * 4 + (wid & 3);
      const int rowbase = b * 256;
      attn_block<false>((LAS unsigned char*)smem, tv, p.zb() + (size_t)(rowbase + qt * 64) * ZW + 768 + head * 64, ZW,
                        p.zb() + (size_t)rowbase * ZW + 1280 + kvh * 64, ZW, p.vt_gqa() + (size_t)((b * 2 + kvh) * 64) * 256, 256, 4,
                        nullptr, 0, nullptr, 0, 0,
                        p.mix() + (size_t)(rowbase + qt * 64) * 1024 + 256 + head * 64, 1024, nullptr, 0, 0);
    } else {
      const int x = it - 448, b = x >> 1, h = (x & 1) * 2 + (wid >> 2), qt = wid & 3;
      const int rowbase = b * 256;
      attn_wave<false>(p.zb() + (size_t)(rowbase + qt * 64) * ZW + h * 64, ZW,
                       p.zb() + (size_t)rowbase * ZW + 256 + h * 64, ZW, p.vt_na() + (size_t)((b * 4 + h) * 64) * 256, 256, 256,
                       nullptr, 0, nullptr, 0, 0,
                       p.mix() + (size_t)(rowbase + qt * 64) * 1024 + h * 64, 1024, nullptr, 0, lane);
    }
  }
}

DI void phase_ml1(const P& p, int l, char* smem, int tid0) {
  for (int bi = blockIdx.x; bi < 192; bi += p.nblk) {
    int tv = tid0;
    asm volatile("" : "+v"(tv));
    if (bi < 128) mlstm_item(p, l, bi >> 2, smem, tv, 1, (bi & 3) * 8, 0);
    else mlstm_item(p, l, 32 + (bi - 128), smem, tv, 1, 0, 0);
  }
}

DI void run_phase(const P& p, int ph, int l, char* smem) {
  int tid = threadIdx.x;
  asm volatile("" : "+v"(tid));
  switch (ph) {
    case 0: phase_init(p, smem, tid); break;
    case 1: phase_row(p, 0, 0, smem, tid); break;
    case 2: phase_gemm(p, 0, l, smem); break;
    case 3: phase_ml1(p, l, smem, tid); break;
    case 4: phase_mix(p, l, smem, tid); break;
    case 5: phase_gemm(p, 1, l, smem); break;
    case 6: phase_row(p, 1, l, smem, tid); break;
    case 7: phase_gemm(p, 2, l, smem); break;
    case 8: phase_gemm(p, 3, l, smem); break;
    default: phase_row(p, 2, l, smem, tid); break;
  }
}

#if !ONE_LAUNCH
__global__ void __launch_bounds__(512, 2) k_phase(P p, int ph, int l) {
  extern __shared__ __attribute__((aligned(16))) char smem[];
  run_phase(p, ph, l, smem);
}
#else
__global__ void __launch_bounds__(512, 2) k_mega(P p) {
  extern __shared__ __attribute__((aligned(16))) char smem[];
  uint4* xbw = (uint4*)(smem + STAGE_LDS);
  if (threadIdx.x == 0) *xbw = make_uint4(0u, 0u, 0u, 0u);
  __syncthreads();
  XcdBarrier xb = xcd_barrier_post(p.bar(), (volatile LAS unsigned*)xbw, (unsigned)p.nblk);
#if TPROBE
  unsigned long long* ts = (unsigned long long*)(p.bar() + BAR_TOTAL_WORDS);
  const bool rec = blockIdx.x == 0 && threadIdx.x == 0;
  if (rec) ts[0] = __builtin_amdgcn_s_memrealtime();
#endif
  run_phase(p, 0, 0, smem);
  xcd_barrier(xb);
#if TPROBE
  if (rec) ts[1] = __builtin_amdgcn_s_memrealtime();
#endif
  run_phase(p, 1, 0, smem);
#if TPROBE
#define TSREC(ph) if (rec) ts[2 + l * 8 + ((ph) - 2)] = __builtin_amdgcn_s_memrealtime();
#else
#define TSREC(ph)
#endif
#pragma unroll 1
  for (int l = 0; l < 4; ++l) {
    xcd_barrier(xb); TSREC(2) run_phase(p, 2, l, smem);
    xcd_barrier(xb); TSREC(3) run_phase(p, 3, l, smem);
    xcd_barrier(xb); TSREC(4) run_phase(p, 4, l, smem);
    xcd_barrier(xb); TSREC(5) run_phase(p, 5, l, smem);
    xcd_barrier(xb); TSREC(6) run_phase(p, 6, l, smem);
    xcd_barrier(xb); TSREC(7) run_phase(p, 7, l, smem);
    xcd_barrier(xb); TSREC(8) run_phase(p, 8, l, smem);
    xcd_barrier(xb); TSREC(9) run_phase(p, 9, l, smem);
  }
#if TPROBE
  xcd_barrier(xb);
  if (rec) {
    ts[34] = __builtin_amdgcn_s_memrealtime();
    unsigned long long sum = 0;
    for (int i = 0; i < 34; ++i) {
      int ph = i < 2 ? i : 2 + (i - 2) % 8;
      if ((TPROBE >> ph) & 1) sum += ts[i + 1] - ts[i];
    }
    p.out[0] += TQ * floorf((float)sum * 0.01f * (1.f / TQ));
  }
#endif
}
#endif

extern "C" void kernel_launch(void* const* d_in, const int* in_sizes, int n_in, void* d_out, int out_size, void* d_ws,
                              size_t ws_size, hipStream_t stream) {
  P p{};
  p.x_prompt = (const float*)d_in[0]; p.x_sample = (const float*)d_in[1]; p.cache_na = (const float*)d_in[2];
  p.cache_gqa = (const float*)d_in[3]; p.stC = (const float*)d_in[4]; p.stn = (const float*)d_in[5]; p.stm = (const float*)d_in[6];
  p.c = (const float*)d_in[7]; p.c_ctx = (const float*)d_in[8]; p.w_in = (const float*)d_in[9]; p.b_gates = (const float*)d_in[10];
  p.w_out = (const float*)d_in[11]; p.g_norm = (const float*)d_in[12]; p.g_qk = (const float*)d_in[13]; p.g_ml = (const float*)d_in[14];
  p.na_bias = (const float*)d_in[15]; p.w_ada = (const float*)d_in[16]; p.b_ada = (const float*)d_in[17]; p.w_gu = (const float*)d_in[18];
  p.w_down = (const float*)d_in[19];
  p.out = (float*)d_out;
  p.ws = (char*)d_ws;
  if (WS_TOTAL_X > ws_size) { fprintf(stderr, "workspace too small: need %zu have %zu\n", (size_t)WS_TOTAL, ws_size); return; }

  static int grid_blocks = 0;
  if (!grid_blocks) {
    int dev = 0, cus = 0, per_cu = 0;
    (void)hipGetDevice(&dev);
    (void)hipDeviceGetAttribute(&cus, hipDeviceAttributeMultiprocessorCount, dev);
#if ONE_LAUNCH
    (void)hipFuncSetAttribute((const void*)k_mega, hipFuncAttributeMaxDynamicSharedMemorySize, DYN_LDS);
    (void)hipOccupancyMaxActiveBlocksPerMultiprocessor(&per_cu, k_mega, NTHR, DYN_LDS);
#else
    (void)hipFuncSetAttribute((const void*)k_phase, hipFuncAttributeMaxDynamicSharedMemorySize, DYN_LDS);
    (void)hipOccupancyMaxActiveBlocksPerMultiprocessor(&per_cu, k_phase, NTHR, DYN_LDS);
#endif
    if (per_cu < 1) { fprintf(stderr, "occupancy query returned %d\n", per_cu); per_cu = 1; }
    if (per_cu > 1) per_cu = 1;
    grid_blocks = cus * per_cu;
  }
  p.nblk = grid_blocks;
  (void)hipMemsetAsync(p.bar(), 0, (size_t)BAR_TOTAL_WORDS * 4, stream);
#if ONE_LAUNCH
  void* args[] = {&p};
  hipError_t e = hipLaunchCooperativeKernel((void*)k_mega, dim3(grid_blocks), dim3(NTHR), args, DYN_LDS, stream);
  if (e != hipSuccess) fprintf(stderr, "cooperative launch failed: %s (grid %d)\n", hipGetErrorString(e), grid_blocks);
#else
  k_phase<<<grid_blocks, NTHR, DYN_LDS, stream>>>(p, 0, 0);
  k_phase<<<grid_blocks, NTHR, DYN_LDS, stream>>>(p, 1, 0);
  for (int l = 0; l < 4; ++l)
    for (int ph = 2; ph <= 9; ++ph) k_phase<<<grid_blocks, NTHR, DYN_LDS, stream>>>(p, ph, l);
#endif
}
```

```cpp
#include <hip/hip_runtime.h>
#include <stdint.h>
#include <stdio.h>

#ifndef ONE_LAUNCH
#define ONE_LAUNCH 1
#endif
#ifndef TPROBE
#define TPROBE 0
#endif
#ifndef TQ
#define TQ 200.f
#endif
constexpr int NTHR = 512, NWAVE = 8;
constexpr int STAGE_LDS = 131072, DYN_LDS = STAGE_LDS + 256;

#define DI __device__ __forceinline__
typedef unsigned short u16;
typedef __attribute__((ext_vector_type(8))) short bf16x8;
typedef __attribute__((ext_vector_type(4))) float f32x4;

constexpr int TP = 4096, TS = 8192, TT = 12288, ZW = 2560, NIN = 2688, FF = 2816;
constexpr float EPS = 1e-6f;
constexpr size_t O_YP = 0, O_NA = 12582912, O_GQA = 20971520, O_C = 25165824, O_N = 27262976, O_M = 27295744;
constexpr int SMEM_BYTES = 73728;

struct P {
  const float *x_prompt, *x_sample, *cache_na, *cache_gqa, *stC, *stn, *stm, *c, *c_ctx, *w_in, *b_gates, *w_out,
      *g_norm, *g_qk, *g_ml, *na_bias, *w_ada, *b_ada, *w_gu, *w_down;
  float* out;
  char* ws;
  int nblk, pad_;
  __host__ __device__ __forceinline__ u16* wt_in() const { return (u16*)(ws + 0ull); }
  __host__ __device__ __forceinline__ u16* wt_out() const { return (u16*)(ws + 20971520ull); }
  __host__ __device__ __forceinline__ u16* wt_gu() const { return (u16*)(ws + 29360128ull); }
  __host__ __device__ __forceinline__ u16* wt_down() const { return (u16*)(ws + 75497472ull); }
  __host__ __device__ __forceinline__ float* mods() const { return (float*)(ws + 98566144ull); }
  __host__ __device__ __forceinline__ float* rope() const { return (float*)(ws + 99450880ull); }
  __host__ __device__ __forceinline__ u16* kc_na() const { return (u16*)(ws + 99459072ull); }
  __host__ __device__ __forceinline__ u16* vct_na() const { return (u16*)(ws + 103653376ull); }
  __host__ __device__ __forceinline__ u16* kc_gqa() const { return (u16*)(ws + 107847680ull); }
  __host__ __device__ __forceinline__ u16* vct_gqa() const { return (u16*)(ws + 109944832ull); }
  __host__ __device__ __forceinline__ u16* hn() const { return (u16*)(ws + 112041984ull); }
  __host__ __device__ __forceinline__ u16* zb() const { return (u16*)(ws + 137207808ull); }
  __host__ __device__ __forceinline__ u16* act() const { return (u16*)(ws + 137207808ull); }
  __host__ __device__ __forceinline__ u16* vt_na() const { return (u16*)(ws + 206413824ull); }
  __host__ __device__ __forceinline__ u16* vt_gqa() const { return (u16*)(ws + 212705280ull); }
  __host__ __device__ __forceinline__ u16* kt_ml() const { return (u16*)(ws + 215851008ull); }
  __host__ __device__ __forceinline__ u16* vt_ml() const { return (u16*)(ws + 222142464ull); }
  __host__ __device__ __forceinline__ u16* mix() const { return (u16*)(ws + 228433920ull); }
  __host__ __device__ __forceinline__ float* gates() const { return (float*)(ws + 253599744ull); }
  __host__ __device__ __forceinline__ float* obuf() const { return (float*)(ws + 254386176ull); }
  __host__ __device__ __forceinline__ float* ml_chat() const { return (float*)(ws + 304717824ull); }
  __host__ __device__ __forceinline__ float* ml_nhat() const { return (float*)(ws + 329883648ull); }
  __host__ __device__ __forceinline__ float* ml_ab() const { return (float*)(ws + 330276864ull); }
  __host__ __device__ __forceinline__ float* ml_nst() const { return (float*)(ws + 330289152ull); }
  __host__ __device__ __forceinline__ float* ml_mst() const { return (float*)(ws + 330682368ull); }
  __host__ __device__ __forceinline__ u16* ml_cst() const { return (u16*)(ws + 330688512ull); }
  __host__ __device__ __forceinline__ unsigned* bar() const { return (unsigned*)(ws + 343271424ull); }
};
constexpr size_t X16_OFF = 343351808ull;
constexpr size_t WS_TOTAL_X = X16_OFF + (size_t)12288 * 1024 * 2;
constexpr size_t WS_TOTAL = 343286272ull;

DI u16 f2bf(float x) { unsigned u = __float_as_uint(x); u += 0x7fffu + ((u >> 16) & 1u); return (u16)(u >> 16); }
DI float bf2f(u16 h) { return __uint_as_float(((unsigned)h) << 16); }
DI unsigned pack2(float a, float b) { unsigned r; asm volatile("v_cvt_pk_bf16_f32 %0, %1, %2" : "=v"(r) : "v"(a), "v"(b)); return r; }
#define DPP_F(v, ctrl, rmask) __int_as_float(__builtin_amdgcn_update_dpp(0, __float_as_int(v), (ctrl), (rmask), 0xF, false))
DI float wave_sum(float v) {
  v += DPP_F(v, 0xB1, 0xF);
  v += DPP_F(v, 0x4E, 0xF);
  v += DPP_F(v, 0x141, 0xF);
  v += DPP_F(v, 0x140, 0xF);
  v += DPP_F(v, 0x142, 0xA);
  v += DPP_F(v, 0x143, 0xC);
  return __int_as_float(__builtin_amdgcn_readlane(__float_as_int(v), 63));
}
DI float wave_max(float v) { for (int o = 32; o >= 1; o >>= 1) v = fmaxf(v, __shfl_xor(v, o)); return v; }
DI void wave_sync() { __builtin_amdgcn_fence(__ATOMIC_RELEASE, "wavefront"); __builtin_amdgcn_wave_barrier(); __builtin_amdgcn_fence(__ATOMIC_ACQUIRE, "wavefront"); }
#define MFMA16(a, b, c) __builtin_amdgcn_mfma_f32_16x16x32_bf16((a), (b), (c), 0, 0, 0)
DI bf16x8 ld8(const u16* p) { return *(const bf16x8*)p; }
DI bf16x8 ld4x2(const u16* p0, const u16* p1) {
  uint2 a = *(const uint2*)p0, b = *(const uint2*)p1;
  uint4 r; r.x = a.x; r.y = a.y; r.z = b.x; r.w = b.y;
  return __builtin_bit_cast(bf16x8, r);
}
DI bf16x8 pack8(const f32x4& a, const f32x4& b) {
  uint4 r; r.x = pack2(a[0], a[1]); r.y = pack2(a[2], a[3]); r.z = pack2(b[0], b[1]); r.w = pack2(b[2], b[3]);
  return __builtin_bit_cast(bf16x8, r);
}
DI f32x4 zero4() { f32x4 z = {0.f, 0.f, 0.f, 0.f}; return z; }

DI size_t vt_index(int row, int H, int h, int d) {
  if (row < TP) { int b = row >> 8, t = row & 255; return ((size_t)((b * H + h) * 64 + d)) * 256 + t; }
  int r = row - TP; int b = r >> 10, t = r & 1023;
  return (size_t)16 * H * 64 * 256 + ((size_t)((b * H + h) * 64 + d)) * 1024 + t;
}


#define XB_TMO      128
#define XB_XCNT(j)  (256  + 64 * (j))
#define XB_XSUB(j)  (1280 + 64 * (j))
#define XB_XGEN(j)  (2304 + 64 * (j))
#define XB_TOP      3328
#define XB_TOPGEN   3392
#define XCD_BAR_WORDS 3456
#define XB_SPIN_CAP (1u << 20)
#define LAS __attribute__((address_space(3)))
DI unsigned xb_ld(unsigned* p) { return __hip_atomic_load(p, __ATOMIC_RELAXED, __HIP_MEMORY_SCOPE_AGENT); }
DI unsigned xb_add(unsigned* p, unsigned v) { return __hip_atomic_fetch_add(p, v, __ATOMIC_RELAXED, __HIP_MEMORY_SCOPE_AGENT); }
DI unsigned xb_xcc_id() { return (unsigned)__builtin_amdgcn_s_getreg((3 << 11) | 20) & 0xFu; }
#define XB_SPIN(cond, bar) do { unsigned _sp = 0; while (cond) { __builtin_amdgcn_s_sleep(1); \
    if ((++_sp & 255u) == 0u) { if (xb_ld(&(bar)[XB_TMO])) break; if (_sp > XB_SPIN_CAP) { atomicAdd(&(bar)[XB_TMO], 1u); break; } } } } while (0)
struct XcdBarrier { unsigned* bar; unsigned x; unsigned G; volatile LAS unsigned* st; };
DI XcdBarrier xcd_barrier_post(unsigned* bar, volatile LAS unsigned* st, unsigned G) {
  XcdBarrier b; b.bar = bar; b.x = xb_xcc_id(); b.st = st; b.G = G;
  if (threadIdx.x == 0) (void)xb_add(&bar[XB_XCNT(b.x)], 1u);
  return b;
}
DI void xcd_barrier_complete(unsigned* bar, unsigned x, unsigned& nloc, unsigned& nx, unsigned G) {
  unsigned sum, cnt, mine, sp = 0u;
  for (;;) {
    sum = 0u; cnt = 0u; mine = 0u;
#pragma unroll
    for (unsigned j = 0; j < 16; ++j) { const unsigned c = xb_ld(&bar[XB_XCNT(j)]); sum += c; cnt += (c > 0u) ? 1u : 0u; mine = (j == x) ? c : mine; }
    if (sum == G) break;
    __builtin_amdgcn_s_sleep(1);
    if ((++sp & 255u) == 0u) { if (xb_ld(&bar[XB_TMO])) break; if (sp > XB_SPIN_CAP) { atomicAdd(&bar[XB_TMO], 1u); break; } }
  }
  nloc = mine > 0u ? mine : 1u; nx = cnt > 0u ? cnt : 1u;
}
DI void xcd_barrier(const XcdBarrier& b) {
  asm volatile("s_waitcnt vmcnt(0)" ::: "memory");
  __syncthreads();
  if (threadIdx.x == 0) {
    unsigned* bar = b.bar;
    __builtin_amdgcn_s_waitcnt(0);
    unsigned nloc = b.st[0], nx = b.st[1];
    if (nloc == 0u) { xcd_barrier_complete(bar, b.x, nloc, nx, b.G); b.st[0] = nloc; b.st[1] = nx; }
    const unsigned old = xb_add(&bar[XB_XSUB(b.x)], 1u);
    const unsigned gen = old / nloc;
    if (old + 1u == (gen + 1u) * nloc) {
      __builtin_amdgcn_fence(__ATOMIC_RELEASE, "agent");
      asm volatile("s_waitcnt vmcnt(0)" ::: "memory");
      const unsigned og = xb_add(&bar[XB_TOP], 1u);
      const unsigned tg = og / nx;
      if (og + 1u == (tg + 1u) * nx) xb_add(&bar[XB_TOPGEN], 1u);
      else XB_SPIN(xb_ld(&bar[XB_TOPGEN]) == tg, bar);
      __builtin_amdgcn_fence(__ATOMIC_ACQUIRE, "agent");
      xb_add(&bar[XB_XGEN(b.x)], 1u);
      asm volatile("s_waitcnt vmcnt(0)" ::: "memory");
    } else {
      XB_SPIN(xb_ld(&bar[XB_XGEN(b.x)]) == gen, bar);
      __builtin_amdgcn_fence(__ATOMIC_ACQUIRE, "agent");
      asm volatile("s_waitcnt vmcnt(0)" ::: "memory");
    }
  }
  __syncthreads();
}

DI void transpose_tile(const float* __restrict__ src, int ldsrc, int k0, int n0, int mode, int nvalid,
                       u16* __restrict__ dst, int ldd, float* tile, int tid) {
  const int nn = tid & 63, kq = tid >> 6;
  int rr = n0 + nn, col;
  if (mode == 1) {
    int tl = rr >> 8, c = rr & 255, bj = c >> 7, wc = (c >> 5) & 3, w = c & 31;
    col = tl * 128 + wc * 32 + w + bj * FF;
  } else if (mode == 2) {
    int tl = rr >> 8, c = rr & 255, bj = c >> 7, wc = (c >> 5) & 3, w = c & 31;
    col = tl * 256 + wc * 64 + bj * 32 + w;
  } else col = rr < nvalid ? rr : -1;
#pragma unroll
  for (int i = 0; i < 8; ++i) {
    int kk = i * 8 + kq;
    tile[kk * 65 + nn] = col >= 0 ? src[(size_t)(k0 + kk) * ldsrc + col] : 0.f;
  }
  __syncthreads();
  const int k2 = (tid & 31) * 2, nq = tid >> 5;
#pragma unroll
  for (int i = 0; i < 4; ++i) {
    int n = i * 16 + nq;
    *(unsigned*)(dst + (size_t)(n0 + n) * ldd + k0 + k2) = pack2(tile[k2 * 65 + n], tile[(k2 + 1) * 65 + n]);
  }
  __syncthreads();
}

DI void phase_init(const P& p, char* smem, int tid) {
  float* tile = (float*)smem;
  const int NTR = 12032, NCV = 768, NADA = 384;
  const int total = NTR + NCV + NADA + 1;
  for (int it = blockIdx.x; it < total; it += p.nblk) {
    if (it < NTR) {
      int l = it / 3008, r = it % 3008;
      if (r < 640) {
        int kt = r / 40, nt = r % 40;
        transpose_tile(p.w_in + (size_t)l * 1024 * 2576, 2576, kt * 64, nt * 64, 2, 2560, p.wt_in() + (size_t)l * ZW * 1024, 1024, tile, tid);
      } else if (r < 896) {
        int x = r - 640, kt = x / 16, nt = x % 16;
        transpose_tile(p.w_out + (size_t)l * 1024 * 1024, 1024, kt * 64, nt * 64, 0, 1024, p.wt_out() + (size_t)l * 1024 * 1024, 1024, tile, tid);
      } else if (r < 2304) {
        int x = r - 896, kt = x / 88, nt = x % 88;
        transpose_tile(p.w_gu + (size_t)l * 1024 * 5632, 5632, kt * 64, nt * 64, 1, 5632, p.wt_gu() + (size_t)l * 5632 * 1024, 1024, tile, tid);
      } else {
        int x = r - 2304, kt = x / 16, nt = x % 16;
        transpose_tile(p.w_down + (size_t)l * FF * 1024, 1024, kt * 64, nt * 64, 0, 1024, p.wt_down() + (size_t)l * 1024 * FF, FF, tile, tid);
      }
    } else if (it < NTR + NCV) {
      int it2 = it - NTR;
      if (it2 < 512) {
        int idx = it2 >> 2, tt = it2 & 3, bl = idx >> 2, h = idx & 3;
        transpose_tile(p.cache_na + (size_t)((bl * 2 + 1) * 4 + h) * 16384, 64, tt * 64, 0, 0, 64, p.vct_na() + (size_t)idx * 16384, 256, tile, tid);
      } else {
        int it3 = it2 - 512;
        int idx = it3 >> 2, tt = it3 & 3, bl = idx >> 1, h = idx & 1;
        transpose_tile(p.cache_gqa + (size_t)((bl * 2 + 1) * 2 + h) * 16384, 64, tt * 64, 0, 0, 64, p.vct_gqa() + (size_t)idx * 16384, 256, tile, tid);
      }
    } else if (it < NTR + NCV + NADA) {
      int ia = it - NTR - NCV;
      int l = ia / 96, colbase = (ia % 96) * 64;
      float* sl = (float*)smem;
      for (int i = tid; i < 9 * 1024; i += NTHR) {
        int n = i >> 10, d = i & 1023;
        float cv = n == 0 ? p.c_ctx[d] : p.c[(n - 1) * 1024 + d];
        sl[i] = cv / (1.f + __expf(-cv));
      }
      __syncthreads();
      const int col = tid & 63, kg = tid >> 6;
      float acc[9];
#pragma unroll
      for (int n = 0; n < 9; ++n) acc[n] = 0.f;
      const float* w = p.w_ada + ((size_t)l * 1024 + kg * 128) * 6144 + colbase + col;
#pragma unroll 4
      for (int k = 0; k < 128; ++k) {
        float wv = w[(size_t)k * 6144];
#pragma unroll
        for (int n = 0; n < 9; ++n) acc[n] += sl[n * 1024 + kg * 128 + k] * wv;
      }
      float* red = sl + 9216;
#pragma unroll
      for (int n = 0; n < 9; ++n) red[(kg * 9 + n) * 64 + col] = acc[n];
      __syncthreads();
      for (int i = tid; i < 576; i += NTHR) {
        int n = i >> 6, cc = i & 63;
        float s = 0.f;
#pragma unroll
        for (int g = 0; g < 8; ++g) s += red[(g * 9 + n) * 64 + cc];
        p.mods()[(size_t)(l * 9 + n) * 6144 + colbase + cc] = s + p.b_ada[l * 6144 + colbase + cc];
      }
      __syncthreads();
    } else {
      for (int i = tid; i < 1024; i += NTHR) {
        int pos = i >> 4, fi = i & 15;
        float inv = __builtin_amdgcn_exp2f(-(float)fi * 0.8304820237f);
        float ang = (float)pos * inv;
        p.rope()[i] = __cosf(ang);
        p.rope()[1024 + i] = __sinf(ang);
      }
    }
  }
  const int gtid = blockIdx.x * NTHR + tid, gsz = p.nblk * NTHR;
  for (int i = gtid; i < 128 * 4096; i += gsz) {
    int idx = i >> 12, e = (i & 4095) * 4, bl = idx >> 2, h = idx & 3;
    float4 v = *(const float4*)(p.cache_na + (size_t)((bl * 2 + 0) * 4 + h) * 16384 + e);
    uint2 o; o.x = pack2(v.x, v.y); o.y = pack2(v.z, v.w);
    *(uint2*)(p.kc_na() + (size_t)idx * 16384 + e) = o;
  }
  for (int i = gtid; i < 64 * 4096; i += gsz) {
    int idx = i >> 12, e = (i & 4095) * 4, bl = idx >> 1, h = idx & 1;
    float4 v = *(const float4*)(p.cache_gqa + (size_t)((bl * 2 + 0) * 2 + h) * 16384 + e);
    uint2 o; o.x = pack2(v.x, v.y); o.y = pack2(v.z, v.w);
    *(uint2*)(p.kc_gqa() + (size_t)idx * 16384 + e) = o;
  }
}

DI void phase_row(const P& p, int mode, int l, char* smem, int tid) {
  const int lane = tid & 63, wid = tid >> 6;
  const bool last = (mode == 2 && l == 3);
  const int ln = mode == 1 ? l : (mode == 0 ? 0 : l + 1);
  const bool do_gates = (mode != 1) && !last;
  u16* x16 = (u16*)(p.ws + X16_OFF);
  float* Wg = (float*)smem;
  if (do_gates) {
    for (int idx = tid; idx < 16384; idx += NTHR) {
      int k = idx >> 4, g = idx & 15;
      Wg[g * 1024 + k] = p.w_in[((size_t)ln * 1024 + k) * 2576 + 2560 + g];
    }
    __syncthreads();
  }
  uint2 obn[4], xbn[4];
  if (mode != 0) {
    const int r0_ = blockIdx.x * NWAVE + wid;
    if (r0_ < TT) {
#pragma unroll
      for (int i = 0; i < 4; ++i) { obn[i] = *(const uint2*)((const u16*)p.obuf() + (size_t)r0_ * 1024 + i * 256 + lane * 4); xbn[i] = *(const uint2*)(x16 + (size_t)r0_ * 1024 + i * 256 + lane * 4); }
    }
  }
  for (int row_ = blockIdx.x * NWAVE + wid; row_ < TT; row_ += p.nblk * NWAVE) {
    int row = row_;
    asm volatile("" : "+v"(row));
    const int nidx = row < TP ? 0 : 1 + ((row - TP) >> 10);
    float4 x[4];
    const int gi = mode == 1 ? 2 : 0, shi = mode == 1 ? 3 : 0;
    const float* g2 = p.g_norm + (size_t)(ln * 4 + gi) * 1024;
    const float* sh = p.mods() + ((size_t)(ln * 9 + nidx) * 6 + shi) * 1024;
    const float* sc = sh + 1024;
    float4 g2v[4], shv[4], scv[4];
    if (mode == 0) {
      const float* src = row < TP ? p.x_prompt + (size_t)row * 1024 : p.x_sample + (size_t)(row - TP) * 1024;
#pragma unroll
      for (int i = 0; i < 4; ++i) x[i] = *(const float4*)(src + i * 256 + lane * 4);
#pragma unroll
      for (int i = 0; i < 4; ++i) { const int cidx = i * 256 + lane * 4; g2v[i] = *(const float4*)(g2 + cidx); shv[i] = *(const float4*)(sh + cidx); scv[i] = *(const float4*)(sc + cidx); }
    } else {
      const float* ga = p.mods() + ((size_t)(l * 9 + nidx) * 6 + (mode == 1 ? 2 : 5)) * 1024;
      const float* g = p.g_norm + (size_t)(l * 4 + (mode == 1 ? 1 : 3)) * 1024;
      uint2 ob[4], xb[4];
      float4 gav[4], gv[4];
#pragma unroll
      for (int i = 0; i < 4; ++i) { ob[i] = obn[i]; xb[i] = xbn[i]; }
      {
        const int rnx = row_ + p.nblk * NWAVE;
        if (rnx < TT) {
#pragma unroll
          for (int i = 0; i < 4; ++i) { obn[i] = *(const uint2*)((const u16*)p.obuf() + (size_t)rnx * 1024 + i * 256 + lane * 4); xbn[i] = *(const uint2*)(x16 + (size_t)rnx * 1024 + i * 256 + lane * 4); }
        }
      }
#pragma unroll
      for (int i = 0; i < 4; ++i) { const int cidx = i * 256 + lane * 4; gav[i] = *(const float4*)(ga + cidx); gv[i] = *(const float4*)(g + cidx); }
      if (!last) {
#pragma unroll
        for (int i = 0; i < 4; ++i) { const int cidx = i * 256 + lane * 4; g2v[i] = *(const float4*)(g2 + cidx); shv[i] = *(const float4*)(sh + cidx); scv[i] = *(const float4*)(sc + cidx); }
      }
      float4 o[4];
      float ss = 0.f;
#pragma unroll
      for (int i = 0; i < 4; ++i) {
        o[i].x = __uint_as_float(ob[i].x << 16); o[i].y = __uint_as_float(ob[i].x & 0xffff0000u);
        o[i].z = __uint_as_float(ob[i].y << 16); o[i].w = __uint_as_float(ob[i].y & 0xffff0000u);
        x[i].x = __uint_as_float(xb[i].x << 16); x[i].y = __uint_as_float(xb[i].x & 0xffff0000u);
        x[i].z = __uint_as_float(xb[i].y << 16); x[i].w = __uint_as_float(xb[i].y & 0xffff0000u);
        ss += o[i].x * o[i].x + o[i].y * o[i].y + o[i].z * o[i].z + o[i].w * o[i].w;
      }
      ss = wave_sum(ss);
      const float rs = rsqrtf(ss * (1.f / 1024.f) + EPS);
#pragma unroll
      for (int i = 0; i < 4; ++i) {
        x[i].x += gav[i].x * (o[i].x * rs * gv[i].x); x[i].y += gav[i].y * (o[i].y * rs * gv[i].y);
        x[i].z += gav[i].z * (o[i].z * rs * gv[i].z); x[i].w += gav[i].w * (o[i].w * rs * gv[i].w);
      }
    }
    if (last) {
#pragma unroll
      for (int i = 0; i < 4; ++i) *(float4*)(p.out + (size_t)row * 1024 + i * 256 + lane * 4) = x[i];
      continue;
    }
#pragma unroll
    for (int i = 0; i < 4; ++i) {
      uint2 w; w.x = pack2(x[i].x, x[i].y); w.y = pack2(x[i].z, x[i].w);
      *(uint2*)(x16 + (size_t)row * 1024 + i * 256 + lane * 4) = w;
      x[i].x = __uint_as_float(w.x << 16); x[i].y = __uint_as_float(w.x & 0xffff0000u);
      x[i].z = __uint_as_float(w.y << 16); x[i].w = __uint_as_float(w.y & 0xffff0000u);
    }
    float ss2 = 0.f;
#pragma unroll
    for (int i = 0; i < 4; ++i) ss2 += x[i].x * x[i].x + x[i].y * x[i].y + x[i].z * x[i].z + x[i].w * x[i].w;
    ss2 = wave_sum(ss2);
    const float rs2 = rsqrtf(ss2 * (1.f / 1024.f) + EPS);
#pragma unroll
    for (int i = 0; i < 4; ++i) {
      const int cidx = i * 256 + lane * 4;
      x[i].x = x[i].x * rs2 * g2v[i].x * (1.f + scv[i].x) + shv[i].x;
      x[i].y = x[i].y * rs2 * g2v[i].y * (1.f + scv[i].y) + shv[i].y;
      x[i].z = x[i].z * rs2 * g2v[i].z * (1.f + scv[i].z) + shv[i].z;
      x[i].w = x[i].w * rs2 * g2v[i].w * (1.f + scv[i].w) + shv[i].w;
      uint2 o2; o2.x = pack2(x[i].x, x[i].y); o2.y = pack2(x[i].z, x[i].w);
      *(uint2*)(p.hn() + (size_t)row * 1024 + cidx) = o2;
    }
    if (do_gates) {
      float part[16];
#pragma unroll 2
      for (int g16 = 0; g16 < 16; ++g16) {
        float a = 0.f;
#pragma unroll
        for (int i = 0; i < 4; ++i) {
          const float4 wv = *(const float4*)(Wg + g16 * 1024 + i * 256 + lane * 4);
          a += x[i].x * wv.x + x[i].y * wv.y + x[i].z * wv.z + x[i].w * wv.w;
        }
        part[g16] = a;
      }
      const bool b5 = (lane & 32) != 0, b4 = (lane & 16) != 0, b3 = (lane & 8) != 0, b2 = (lane & 4) != 0;
      float w8[8], w4[4], w2[2];
#pragma unroll
      for (int k = 0; k < 8; ++k) { const float send = b5 ? part[k] : part[k + 8], keep = b5 ? part[k + 8] : part[k]; w8[k] = keep + __shfl_xor(send, 32); }
#pragma unroll
      for (int k = 0; k < 4; ++k) { const float send = b4 ? w8[k] : w8[k + 4], keep = b4 ? w8[k + 4] : w8[k]; w4[k] = keep + __shfl_xor(send, 16); }
#pragma unroll
      for (int k = 0; k < 2; ++k) { const float send = b3 ? w4[k] : w4[k + 2], keep = b3 ? w4[k + 2] : w4[k]; w2[k] = keep + __shfl_xor(send, 8); }
      float w1;
      { const float send = b2 ? w2[0] : w2[1], keep = b2 ? w2[1] : w2[0]; w1 = keep + __shfl_xor(send, 4); }
      w1 += __shfl_xor(w1, 2);
      w1 += __shfl_xor(w1, 1);
      const int gidx = (b5 ? 8 : 0) + (b4 ? 4 : 0) + (b3 ? 2 : 0) + (b2 ? 1 : 0);
      if ((lane & 3) == 0) p.gates()[(size_t)row * 16 + gidx] = w1 + p.b_gates[ln * 16 + gidx];
    }
  }
  if (do_gates) __syncthreads();
}

#define PG8_LAS __attribute__((address_space(3)))
typedef unsigned u32x4 __attribute__((ext_vector_type(4)));
typedef unsigned u32x2 __attribute__((ext_vector_type(2)));
namespace pg8 {
constexpr int BM = 256, BK = 64, HALF = 128, HTB = HALF * BK * 2, NXCD = 8, WGM = 8;
DI int lds_byte(int r, int c) { const int st = (r >> 4) * 2 + (c >> 5), rr = r & 15, cc = c & 31, ob = rr * 64 + cc * 2; return st * 1024 + (ob ^ (((ob >> 9) & 1) << 5)); }
DI void stage_rc(int b, int& R, int& C) { const int st = b / 1024, sb = b % 1024, swz = sb ^ (((sb >> 9) & 1) << 5); R = (st >> 1) * 16 + swz / 64; C = (st & 1) * 32 + (swz % 64) / 2; }
DI int perm32(int rho) { const int n = rho >> 4, i = rho & 15; return 8 * (i >> 2) + 4 * n + (i & 3); }
struct Unit { int pm, pn; };
struct Gemm { const u16* A; const u16* Bt; int M, N, K; };
struct StaticOrder {
  int nM, nN, nwg, G, c;
  DI void init(int M, int N, int G_, int c_) { nM = M / BM; nN = N / BM; nwg = nM * nN; G = G_; c = c_; }
  DI bool next(int i, Unit& u) const {
    const long L = (long)i * G + c; if (L >= nwg) return false;
    int wgid = (int)L; { const int q = nwg / NXCD, r = nwg % NXCD, xcd = wgid % NXCD, off = wgid / NXCD; wgid = (xcd < r ? xcd * (q + 1) : r * (q + 1) + (xcd - r) * q) + off; }
    const int nig = WGM * nN, gid = wgid / nig, fm = gid * WGM, gsz = (nM - fm) < WGM ? (nM - fm) : WGM;
    u.pm = fm + ((wgid % nig) % gsz); u.pn = (wgid % nig) / gsz; return true;
  }
};
DI unsigned cvt_pk_bf16(float lo, float hi) { unsigned r; asm volatile("v_cvt_pk_bf16_f32 %0, %1, %2" : "=v"(r) : "v"(lo), "v"(hi)); return r; }

template <class Epi>
DI void gemm_phase(PG8_LAS unsigned char* lds, const Gemm g, const StaticOrder& S, const Epi& E) {
  int tid = threadIdx.x;
  asm volatile("" : "+v"(tid));
  const int wid = __builtin_amdgcn_readfirstlane(tid >> 6), lane = tid & 63, wr = wid >> 2, wc = wid & 3, fr = lane & 15, fq = lane >> 4;
  const int K = g.K, nt = K / BK;
  unsigned voffA[2], voffB[2];
#pragma unroll
  for (int i = 0; i < 2; ++i) { int R, C; stage_rc(tid * 16 + i * 8192, R, C); const int Rb = Epi::PERM ? ((R & ~31) + perm32(R & 31)) : R;
    voffA[i] = (unsigned)(R * K + C) * 2u; voffB[i] = (unsigned)(Rb * K + C) * 2u; }
  const size_t kstep = (size_t)(BK * 2);
  const size_t hstep = (size_t)HALF * K * 2;
  const size_t tstep = 2 * hstep;
  const unsigned ldsw = (unsigned)wid * 1024u;
  const int aoff = lds_byte(wr * 64 + fr, fq * 8), boff = lds_byte(wc * 32 + fr, fq * 8);
#define PG8_SA(b, h) (((b) * 2 + (h)) * HTB)
#define PG8_SB(b, h) ((4 + (b) * 2 + (h)) * HTB)
#define PG8_STAGE(bufoff, gbase, voff) do { _Pragma("unroll") for (int _i = 0; _i < 2; ++_i) \
    __builtin_amdgcn_global_load_lds((const unsigned*)((const char*)(gbase) + (voff)[_i]), (PG8_LAS unsigned*)(lds + (bufoff) + ldsw + _i * 8192), 16, 0, 0); } while (0)
#define PG8_LDA(dst, b, h) do { _Pragma("unroll") for (int m = 0; m < 4; ++m) _Pragma("unroll") for (int k = 0; k < 2; ++k) dst[m][k] = *(const PG8_LAS bf16x8*)(lds + PG8_SA(b, h) + aoff + m * 2048 + k * 1024); } while (0)
#define PG8_LDB(dst, b, h) do { _Pragma("unroll") for (int n = 0; n < 2; ++n) _Pragma("unroll") for (int k = 0; k < 2; ++k) dst[n][k] = *(const PG8_LAS bf16x8*)(lds + PG8_SB(b, h) + boff + n * 2048 + k * 1024); } while (0)
#define PG8_MMA(ai, bj, At, Bt) do { __builtin_amdgcn_s_setprio(1); _Pragma("unroll") for (int m = 0; m < 4; ++m) _Pragma("unroll") for (int n = 0; n < 2; ++n) _Pragma("unroll") for (int k = 0; k < 2; ++k) \
    acc[ai][bj][m][n] = __builtin_amdgcn_mfma_f32_16x16x32_bf16(Bt[n][k], At[m][k], acc[ai][bj][m][n], 0, 0, 0); __builtin_amdgcn_s_setprio(0); } while (0)
#define PG8_WAIT_V(n) asm volatile("s_waitcnt vmcnt(" #n ")" ::: "memory")
#define PG8_WAIT_L(n) asm volatile("s_waitcnt lgkmcnt(" #n ")" ::: "memory")
#define PG8_BAR __builtin_amdgcn_s_barrier()
#define PG8_SCHED __builtin_amdgcn_sched_barrier(0)
  Unit cur, nxt; int ui = 0;
  if (!S.next(0, cur)) return;
  f32x4 acc[2][2][4][2];
#pragma unroll
  for (int a = 0; a < 2; ++a)
#pragma unroll
    for (int b = 0; b < 2; ++b)
#pragma unroll
      for (int m = 0; m < 4; ++m)
#pragma unroll
        for (int n = 0; n < 2; ++n) acc[a][b][m][n] = (f32x4){0.f, 0.f, 0.f, 0.f};
  bf16x8 At[4][2], B0[2][2], B1[2][2];
  const char* cA = (const char*)g.A + (size_t)cur.pm * tstep; const char* cB = (const char*)g.Bt + (size_t)cur.pn * tstep;
  PG8_STAGE(PG8_SB(0, 0), cB, voffB); PG8_STAGE(PG8_SA(0, 0), cA, voffA); PG8_STAGE(PG8_SB(0, 1), cB + hstep, voffB); PG8_STAGE(PG8_SA(0, 1), cA + hstep, voffA);
  if (wr == 1) PG8_BAR;
  PG8_WAIT_V(4); PG8_BAR;
  PG8_STAGE(PG8_SB(1, 0), cB + kstep, voffB); PG8_STAGE(PG8_SA(1, 0), cA + kstep, voffA); PG8_STAGE(PG8_SB(1, 1), cB + hstep + kstep, voffB);
  PG8_WAIT_V(6); PG8_BAR;
  for (;;) {
    const bool has_next = S.next(ui + 1, nxt);
    const char* nA = has_next ? (const char*)g.A + (size_t)nxt.pm * tstep : cA; const char* nB = has_next ? (const char*)g.Bt + (size_t)nxt.pn * tstep : cB;
    for (int t = 0; t < nt; t += 2) {
      const bool last = (t == nt - 2);
      const char* a1 = cA + (size_t)(t + 1) * kstep;
      const char* a2 = last ? nA : cA + (size_t)(t + 2) * kstep; const char* b2 = last ? nB : cB + (size_t)(t + 2) * kstep;
      const char* a3 = a2 + kstep; const char* b3 = b2 + kstep;
      PG8_LDB(B0, 0, 0); PG8_SCHED; PG8_LDA(At, 0, 0); PG8_STAGE(PG8_SA(1, 1), a1 + hstep, voffA);
      PG8_WAIT_L(8); PG8_BAR; PG8_WAIT_L(0); PG8_MMA(0, 0, At, B0); PG8_BAR; PG8_SCHED;
      PG8_LDB(B1, 0, 1); PG8_STAGE(PG8_SB(0, 0), b2, voffB);
      PG8_BAR; PG8_WAIT_L(0); PG8_MMA(0, 1, At, B1); PG8_BAR;
      PG8_LDA(At, 0, 1); PG8_STAGE(PG8_SA(0, 0), a2, voffA);
      PG8_BAR; PG8_WAIT_L(0); PG8_MMA(1, 0, At, B0); PG8_BAR; PG8_SCHED;
      PG8_STAGE(PG8_SB(0, 1), b2 + hstep, voffB);
      PG8_WAIT_V(6); PG8_BAR; PG8_MMA(1, 1, At, B1); PG8_BAR;
      PG8_LDB(B0, 1, 0); PG8_SCHED; PG8_LDA(At, 1, 0); PG8_STAGE(PG8_SA(0, 1), a2 + hstep, voffA);
      PG8_WAIT_L(8); PG8_BAR; PG8_WAIT_L(0); PG8_MMA(0, 0, At, B0); PG8_BAR; PG8_SCHED;
      PG8_LDB(B1, 1, 1); PG8_STAGE(PG8_SB(1, 0), b3, voffB);
      PG8_BAR; PG8_WAIT_L(0); PG8_MMA(0, 1, At, B1); PG8_BAR;
      PG8_LDA(At, 1, 1); PG8_STAGE(PG8_SA(1, 0), a3, voffA);
      PG8_BAR; PG8_WAIT_L(0); PG8_MMA(1, 0, At, B0); PG8_BAR; PG8_SCHED;
      PG8_STAGE(PG8_SB(1, 1), b3 + hstep, voffB);
      PG8_WAIT_V(6); PG8_BAR; PG8_MMA(1, 1, At, B1); PG8_BAR;
    }
    E(acc, cur, wr, wc, fr, fq);
    if (!has_next) break;
#pragma unroll
    for (int a = 0; a < 2; ++a)
#pragma unroll
      for (int b = 0; b < 2; ++b)
#pragma unroll
        for (int m = 0; m < 4; ++m)
#pragma unroll
          for (int n = 0; n < 2; ++n) acc[a][b][m][n] = (f32x4){0.f, 0.f, 0.f, 0.f};
    cur = nxt; cA = nA; cB = nB; ++ui;
  }
  PG8_WAIT_V(0);
  if (wr == 0) PG8_BAR;
  PG8_BAR;
#undef PG8_SA
#undef PG8_SB
#undef PG8_STAGE
#undef PG8_LDA
#undef PG8_LDB
#undef PG8_MMA
#undef PG8_WAIT_V
#undef PG8_WAIT_L
#undef PG8_BAR
#undef PG8_SCHED
}
}

struct EpiO {
  static constexpr bool PERM = true;
  u16* C;
  DI void operator()(const f32x4 (&acc)[2][2][4][2], const pg8::Unit& u, int wr, int wc, int fr, int fq) const {
    const int row0 = u.pm * 256 + wr * 64 + fr, col0 = u.pn * 256 + wc * 32 + 8 * fq;
#pragma unroll
    for (int ai = 0; ai < 2; ++ai)
#pragma unroll
      for (int m = 0; m < 4; ++m) {
        u16* rowp = C + (unsigned)(row0 + ai * 128 + m * 16) * 1024u + (unsigned)col0;
#pragma unroll
        for (int bj = 0; bj < 2; ++bj) {
          const f32x4 v0 = acc[ai][bj][m][0], v1 = acc[ai][bj][m][1];
          u32x4 w; w.x = pg8::cvt_pk_bf16(v0[0], v0[1]); w.y = pg8::cvt_pk_bf16(v0[2], v0[3]); w.z = pg8::cvt_pk_bf16(v1[0], v1[1]); w.w = pg8::cvt_pk_bf16(v1[2], v1[3]);
          *(u32x4*)(rowp + bj * 128) = w;
        }
      }
  }
};

struct EpiGU {
  static constexpr bool PERM = true;
  u16* act;
  DI void operator()(const f32x4 (&acc)[2][2][4][2], const pg8::Unit& u, int wr, int wc, int fr, int fq) const {
    const int row0 = u.pm * 256 + wr * 64 + fr, col0 = u.pn * 128 + wc * 32 + 8 * fq;
#pragma unroll
    for (int ai = 0; ai < 2; ++ai)
#pragma unroll
      for (int m = 0; m < 4; ++m) {
        float r[8];
#pragma unroll
        for (int n = 0; n < 2; ++n)
#pragma unroll
          for (int j = 0; j < 4; ++j) {
            const float g = acc[ai][0][m][n][j], up = acc[ai][1][m][n][j];
            r[n * 4 + j] = g * __builtin_amdgcn_rcpf(1.f + __expf(-g)) * up;
          }
        u32x4 w; w.x = pg8::cvt_pk_bf16(r[0], r[1]); w.y = pg8::cvt_pk_bf16(r[2], r[3]); w.z = pg8::cvt_pk_bf16(r[4], r[5]); w.w = pg8::cvt_pk_bf16(r[6], r[7]);
        *(u32x4*)(act + (size_t)(row0 + ai * 128 + m * 16) * FF + col0) = w;
      }
  }
};

struct EpiIn {
  static constexpr bool PERM = false;
  const P* pp; int l;
  DI void operator()(const f32x4 (&acc)[2][2][4][2], const pg8::Unit& u, int wr, int wc, int fr, int fq) const {
    const P& p = *pp;
    const int c0 = u.pn * 256 + wc * 64;
    const int rb = u.pm * 256 + wr * 64 + fr;
    const bool prm = u.pm * 256 < TP;
    int region, hh;
    if (c0 < 256) { region = 0; hh = c0 >> 6; }
    else if (c0 < 512) { region = 1; hh = (c0 - 256) >> 6; }
    else if (c0 < 768) { region = 2; hh = (c0 - 512) >> 6; }
    else if (c0 < 1280) { region = 3; hh = (c0 - 768) >> 6; }
    else if (c0 < 1408) { region = 4; hh = (c0 - 1280) >> 6; }
    else if (c0 < 1536) { region = 5; hh = (c0 - 1408) >> 6; }
    else if (c0 < 1792) { region = 6; hh = (c0 - 1536) >> 6; }
    else if (c0 < 2048) { region = 7; hh = (c0 - 1792) >> 6; }
    else if (c0 < 2304) { region = 8; hh = (c0 - 2048) >> 6; }
    else { region = 9; hh = (c0 - 2304) >> 6; }
    const unsigned dl = fq * 4;
    if (region == 2 || region == 5 || region == 8 || region == 7) {
      u16* vt = region == 2 ? p.vt_na() : (region == 5 ? p.vt_gqa() : (region == 7 ? p.kt_ml() : p.vt_ml()));
      const int H = region == 5 ? 2 : 4;
      const float mul = region == 7 ? 0.125f : 1.f;
      const unsigned Tlen = prm ? 256u : 1024u;
#pragma unroll
      for (int ai = 0; ai < 2; ++ai)
#pragma unroll
        for (int m = 0; m < 4; ++m) {
          const int row = rb + ai * 128 + m * 16;
          unsigned vbase;
          if (prm) vbase = (unsigned)(((row >> 8) * H + hh) * 64) * 256u + (unsigned)(row & 255);
          else { const int r = row - TP; vbase = (unsigned)(16 * H * 64 * 256) + (unsigned)((((r >> 10) * H + hh) * 64)) * 1024u + (unsigned)(r & 1023); }
          u16* vp = vt + vbase + dl * Tlen;
#pragma unroll
          for (int bj = 0; bj < 2; ++bj)
#pragma unroll
            for (int n = 0; n < 2; ++n)
#pragma unroll
              for (int j = 0; j < 4; ++j) vp[(unsigned)(bj * 32 + n * 16 + j) * Tlen] = f2bf(acc[ai][bj][m][n][j] * mul);
        }
    }
    if (prm && (region == 1 || region == 2 || region == 5)) {
#pragma unroll
      for (int ai = 0; ai < 2; ++ai)
#pragma unroll
        for (int m = 0; m < 4; ++m) {
          const int row = rb + ai * 128 + m * 16, b = row >> 8, t = row & 255;
          unsigned base;
          if (region == 5) base = (unsigned)O_GQA + (unsigned)((((b * 4 + l) * 2 + 1) * 2 + hh) * 256 + t) * 64u;
          else base = (unsigned)O_NA + (unsigned)((((b * 4 + l) * 2 + (region == 2 ? 1 : 0)) * 4 + hh) * 256 + t) * 64u;
          float* op = p.out + base + dl;
#pragma unroll
          for (int bj = 0; bj < 2; ++bj)
#pragma unroll
            for (int n = 0; n < 2; ++n) *(f32x4*)(op + bj * 32 + n * 16) = acc[ai][bj][m][n];
        }
    }
    if (region == 2 || region == 5 || region == 8) return;
    if (region == 3 || region == 4) {
      const float* gq = p.g_qk + (l * 2 + (region == 4 ? 1 : 0)) * 64 + dl;
      f32x4 gv[2][2];
#pragma unroll
      for (int bj = 0; bj < 2; ++bj)
#pragma unroll
        for (int n = 0; n < 2; ++n) gv[bj][n] = *(const f32x4*)(gq + bj * 32 + n * 16);
#pragma unroll
      for (int ai = 0; ai < 2; ++ai)
#pragma unroll
        for (int m = 0; m < 4; ++m) {
          const int row = rb + ai * 128 + m * 16;
          f32x4 v[2][2];
          float ss = 0.f;
#pragma unroll
          for (int bj = 0; bj < 2; ++bj)
#pragma unroll
            for (int n = 0; n < 2; ++n) {
              v[bj][n] = acc[ai][bj][m][n];
#pragma unroll
              for (int j = 0; j < 4; ++j) ss += v[bj][n][j] * v[bj][n][j];
            }
          ss += __shfl_xor(ss, 16);
          ss += __shfl_xor(ss, 32);
          const float rs = rsqrtf(ss * (1.f / 64.f) + EPS);
#pragma unroll
          for (int bj = 0; bj < 2; ++bj)
#pragma unroll
            for (int n = 0; n < 2; ++n) v[bj][n] = v[bj][n] * rs * gv[bj][n];
          if (prm) {
            if (region == 4) {
              const int b = row >> 8, t = row & 255;
              float* op = p.out + (unsigned)O_GQA + (unsigned)((((b * 4 + l) * 2 + 0) * 2 + hh) * 256 + t) * 64u + dl;
#pragma unroll
              for (int bj = 0; bj < 2; ++bj)
#pragma unroll
                for (int n = 0; n < 2; ++n) *(f32x4*)(op + bj * 32 + n * 16) = v[bj][n];
            }
          } else {
            const int t = (row - TP) & 1023, pr = t >> 6, pc = t & 63;
#pragma unroll
            for (int bj = 0; bj < 2; ++bj) {
              const int pos = bj ? pc : pr;
              const f32x4 cs = *(const f32x4*)(p.rope() + pos * 16 + dl), sn = *(const f32x4*)(p.rope() + 1024 + pos * 16 + dl);
              const f32x4 x1 = v[bj][0], x2 = v[bj][1];
              v[bj][0] = x1 * cs - x2 * sn;
              v[bj][1] = x2 * cs + x1 * sn;
            }
          }
          u16* zp = p.zb() + (unsigned)row * (unsigned)ZW + (unsigned)c0 + dl;
#pragma unroll
          for (int bj = 0; bj < 2; ++bj)
#pragma unroll
            for (int n = 0; n < 2; ++n) {
              uint2 w; w.x = pg8::cvt_pk_bf16(v[bj][n][0], v[bj][n][1]); w.y = pg8::cvt_pk_bf16(v[bj][n][2], v[bj][n][3]);
              *(uint2*)(zp + bj * 32 + n * 16) = w;
            }
        }
      return;
    }
    {
      const float mul = region == 7 ? 0.125f : 1.f;
#pragma unroll
      for (int ai = 0; ai < 2; ++ai)
#pragma unroll
        for (int m = 0; m < 4; ++m) {
          const int row = rb + ai * 128 + m * 16;
          u16* zp = p.zb() + (unsigned)row * (unsigned)ZW + (unsigned)c0 + dl;
#pragma unroll
          for (int bj = 0; bj < 2; ++bj)
#pragma unroll
            for (int n = 0; n < 2; ++n) {
              const f32x4 v = acc[ai][bj][m][n] * mul;
              uint2 w; w.x = pg8::cvt_pk_bf16(v[0], v[1]); w.y = pg8::cvt_pk_bf16(v[2], v[3]);
              *(uint2*)(zp + bj * 32 + n * 16) = w;
            }
        }
    }
  }
};

DI void phase_gemm(const P& p, int which, int l, char* smem) {
  PG8_LAS unsigned char* lds = (PG8_LAS unsigned char*)smem;
  pg8::StaticOrder S;
  pg8::Gemm g;
  if (which == 0) {
    g.A = p.hn(); g.Bt = p.wt_in() + (size_t)l * ZW * 1024; g.M = TT; g.N = ZW; g.K = 1024;
    S.init(g.M, g.N, p.nblk, blockIdx.x);
    EpiIn E; E.pp = &p; E.l = l;
    pg8::gemm_phase(lds, g, S, E);
  } else if (which == 1) {
    g.A = p.mix(); g.Bt = p.wt_out() + (size_t)l * 1024 * 1024; g.M = TT; g.N = 1024; g.K = 1024;
    S.init(g.M, g.N, p.nblk, blockIdx.x);
    EpiO E; E.C = (u16*)p.obuf();
    pg8::gemm_phase(lds, g, S, E);
  } else if (which == 2) {
    g.A = p.hn(); g.Bt = p.wt_gu() + (size_t)l * 5632 * 1024; g.M = TT; g.N = 5632; g.K = 1024;
    S.init(g.M, g.N, p.nblk, blockIdx.x);
    EpiGU E; E.act = p.act();
    pg8::gemm_phase(lds, g, S, E);
  } else {
    g.A = p.act(); g.Bt = p.wt_down() + (size_t)l * 1024 * FF; g.M = TT; g.N = 1024; g.K = FF;
    S.init(g.M, g.N, p.nblk, blockIdx.x);
    EpiO E; E.C = (u16*)p.obuf();
    pg8::gemm_phase(lds, g, S, E);
  }
}

template <bool WIN>
DI void attn_seg(const u16* __restrict__ K, int ldk, const u16* __restrict__ V, int ldv, int nkeys, const bf16x8 (&qf)[4][2],
                 f32x4 (&o)[4][4], float (&m)[4], float (&lsum)[4], const float* __restrict__ bias, int rdelta, int fr, int fq) {
  const float L2E = 1.44269504f;
  for (int key0 = 0; key0 < nkeys; key0 += 32) {
    bf16x8 kf[2][2];
#pragma unroll
    for (int mt = 0; mt < 2; ++mt)
#pragma unroll
      for (int ks = 0; ks < 2; ++ks) kf[mt][ks] = ld8(K + (size_t)(key0 + mt * 16 + fr) * ldk + ks * 32 + fq * 8);
    bf16x8 va[4];
#pragma unroll
    for (int dt = 0; dt < 4; ++dt) {
      const u16* vp = V + (size_t)(dt * 16 + fr) * ldv + key0 + fq * 4;
      va[dt] = ld4x2(vp, vp + 16);
    }
    f32x4 s[2][4];
#pragma unroll
    for (int mt = 0; mt < 2; ++mt)
#pragma unroll
      for (int nt = 0; nt < 4; ++nt) {
        s[mt][nt] = zero4();
#pragma unroll
        for (int ks = 0; ks < 2; ++ks) s[mt][nt] = MFMA16(kf[mt][ks], qf[nt][ks], s[mt][nt]);
      }
    const float SC = 0.125f * L2E;
    if (WIN) {
      const int krel = key0 >> 6, ckb = key0 & 63;
      const float* brow = bias + (rdelta + krel) * 31;
#pragma unroll
      for (int nt = 0; nt < 4; ++nt) {
        const int cq = nt * 16 + fr;
        const int cw = min(max(cq - 8, 0), 48);
#pragma unroll
        for (int mt = 0; mt < 2; ++mt)
#pragma unroll
          for (int j = 0; j < 4; ++j) {
            const int ck = ckb + mt * 16 + fq * 4 + j;
            const bool valid = (ck >= cw) && (ck < cw + 16);
            const int dc = min(max(ck - cq, -15), 15) + 15;
            const float bv = brow[dc];
            s[mt][nt][j] = valid ? (s[mt][nt][j] + bv * 8.f) : -INFINITY;
          }
      }
    }
    bf16x8 pb[4];
    float tmx[4];
    bool grow = false;
#pragma unroll
    for (int nt = 0; nt < 4; ++nt) {
      float tm = fmaxf(fmaxf(fmaxf(s[0][nt][0], s[0][nt][1]), fmaxf(s[0][nt][2], s[0][nt][3])),
                       fmaxf(fmaxf(s[1][nt][0], s[1][nt][1]), fmaxf(s[1][nt][2], s[1][nt][3])));
      tm = fmaxf(tm, __shfl_xor(tm, 16));
      tm = fmaxf(tm, __shfl_xor(tm, 32));
      tm *= SC;
      tmx[nt] = tm;
      grow = grow || (tm > m[nt]);
    }
    if (__any(grow)) {
#pragma unroll
      for (int nt = 0; nt < 4; ++nt) {
        const float mn = fmaxf(m[nt], tmx[nt]);
        const float alpha = __builtin_amdgcn_exp2f(m[nt] - mn);
        m[nt] = mn;
        lsum[nt] *= alpha;
#pragma unroll
        for (int dt = 0; dt < 4; ++dt) o[dt][nt] *= alpha;
      }
    }
#pragma unroll
    for (int nt = 0; nt < 4; ++nt) {
      const float nm = -m[nt];
      float ps = 0.f;
#pragma unroll
      for (int mt = 0; mt < 2; ++mt)
#pragma unroll
        for (int j = 0; j < 4; ++j) { float pv = __builtin_amdgcn_exp2f(__builtin_fmaf(s[mt][nt][j], SC, nm)); s[mt][nt][j] = pv; ps += pv; }
      lsum[nt] += ps;
      pb[nt] = pack8(s[0][nt], s[1][nt]);
    }
#pragma unroll
    for (int dt = 0; dt < 4; ++dt)
#pragma unroll
      for (int nt = 0; nt < 4; ++nt) o[dt][nt] = MFMA16(va[dt], pb[nt], o[dt][nt]);
  }
}

template <bool WIN>
DI void attn_wave(const u16* Q, int ldq, const u16* K0, int ldk0, const u16* V0, int ldv0, int n0, const u16* K1, int ldk1,
                  const u16* V1, int ldv1, int n1, u16* O, int ldo, const float* bias, int rdelta, int lane) {
  const int fr = lane & 15, fq = lane >> 4;
  bf16x8 qf[4][2];
#pragma unroll
  for (int nt = 0; nt < 4; ++nt)
#pragma unroll
    for (int ks = 0; ks < 2; ++ks) qf[nt][ks] = ld8(Q + (size_t)(nt * 16 + fr) * ldq + ks * 32 + fq * 8);
  f32x4 o[4][4];
  float m[4], lsum[4];
#pragma unroll
  for (int i = 0; i < 4; ++i) {
    m[i] = -1e30f; lsum[i] = 0.f;
#pragma unroll
    for (int j = 0; j < 4; ++j) o[i][j] = zero4();
  }
  attn_seg<WIN>(K0, ldk0, V0, ldv0, n0, qf, o, m, lsum, bias, rdelta, fr, fq);
  if (n1 > 0) attn_seg<false>(K1, ldk1, V1, ldv1, n1, qf, o, m, lsum, bias, rdelta, fr, fq);
#pragma unroll
  for (int nt = 0; nt < 4; ++nt) {
    float lt = lsum[nt];
    lt += __shfl_xor(lt, 16);
    lt += __shfl_xor(lt, 32);
    const float inv = 1.f / lt;
#pragma unroll
    for (int dt = 0; dt < 4; ++dt) {
      uint2 w; w.x = pack2(o[dt][nt][0] * inv, o[dt][nt][1] * inv); w.y = pack2(o[dt][nt][2] * inv, o[dt][nt][3] * inv);
      *(uint2*)(O + (size_t)(nt * 16 + fr) * ldo + dt * 16 + fq * 4) = w;
    }
  }
}

template <bool WIN>
DI void attn_block(LAS unsigned char* lds, int tid, const u16* Q, int ldq,
                   const u16* K0, int ldk0, const u16* V0, int ldv0, int nt0,
                   const u16* K1, int ldk1, const u16* V1, int ldv1, int nt1,
                   u16* O, int ldo, const LAS float* bias, int rdelta, int wlo) {
  const int lane = tid & 63, fr = lane & 15, fq = lane >> 4;
  const int wid = __builtin_amdgcn_readfirstlane(tid >> 6);
  const float L2E = 1.44269504f, SC = 0.125f * L2E;
  bf16x8 qf[4][2];
#pragma unroll
  for (int nt = 0; nt < 4; ++nt)
#pragma unroll
    for (int ks = 0; ks < 2; ++ks) qf[nt][ks] = ld8(Q + (size_t)(nt * 16 + fr) * ldq + ks * 32 + fq * 8);
  f32x4 o[4][4];
  float m[4], lsum[4];
#pragma unroll
  for (int i = 0; i < 4; ++i) {
    m[i] = -1e30f; lsum[i] = 0.f;
#pragma unroll
    for (int j = 0; j < 4; ++j) o[i][j] = zero4();
  }
  const int ntl = nt0 + nt1;
  const int rr = tid >> 3, pp = tid & 7, part = pp ^ (rr & 7);
#define AB_ISSUE(t) do { const int _t = (t); const u16* _k; const u16* _v; \
    if (_t < nt0) { _k = K0 + (size_t)(_t * 64 + rr) * ldk0 + part * 8; _v = V0 + (size_t)rr * ldv0 + _t * 64 + part * 8; } \
    else { _k = K1 + (size_t)((_t - nt0) * 64 + rr) * ldk1 + part * 8; _v = V1 + (size_t)rr * ldv1 + (_t - nt0) * 64 + part * 8; } \
    LAS unsigned char* _s = lds + (_t & 3) * 16384 + wid * 1024; \
    __builtin_amdgcn_global_load_lds((const unsigned*)_k, (LAS unsigned*)_s, 16, 0, 0); \
    __builtin_amdgcn_global_load_lds((const unsigned*)_v, (LAS unsigned*)(_s + 8192), 16, 0, 0); } while (0)
  if (0 < ntl) AB_ISSUE(0);
  if (1 < ntl) AB_ISSUE(1);
  if (2 < ntl) AB_ISSUE(2);
  for (int t = 0; t < ntl; ++t) {
    const int rem = ntl - 1 - t;
    if (rem >= 2) asm volatile("s_waitcnt vmcnt(4)" ::: "memory");
    else if (rem == 1) asm volatile("s_waitcnt vmcnt(2)" ::: "memory");
    else asm volatile("s_waitcnt vmcnt(0)" ::: "memory");
    __builtin_amdgcn_s_barrier();
    asm volatile("" ::: "memory");
    if (t + 3 < ntl) AB_ISSUE(t + 3);
    const bool win_tile = WIN && (t < nt0);
    if (win_tile && (t < wlo || t >= wlo + 8)) continue;
    const LAS unsigned char* sk = lds + (t & 3) * 16384;
    const LAS unsigned char* sv = sk + 8192;
    f32x4 s[2][2][4];
#pragma unroll
    for (int sub = 0; sub < 2; ++sub) {
      bf16x8 kf[2][2];
#pragma unroll
      for (int mt = 0; mt < 2; ++mt)
#pragma unroll
        for (int ks = 0; ks < 2; ++ks) {
          const int key = sub * 32 + mt * 16 + fr;
          kf[mt][ks] = *(const LAS bf16x8*)(sk + key * 128 + (((ks * 4 + fq) ^ (key & 7)) << 4));
        }
#pragma unroll
      for (int mt = 0; mt < 2; ++mt)
#pragma unroll
        for (int nt = 0; nt < 4; ++nt) {
          s[sub][mt][nt] = zero4();
#pragma unroll
          for (int ks = 0; ks < 2; ++ks) s[sub][mt][nt] = MFMA16(kf[mt][ks], qf[nt][ks], s[sub][mt][nt]);
        }
    }
    if (win_tile) {
      const LAS float* brow = bias + (rdelta + (t - wlo)) * 31;
#pragma unroll
      for (int sub = 0; sub < 2; ++sub)
#pragma unroll
        for (int nt = 0; nt < 4; ++nt) {
          const int cq = nt * 16 + fr;
          const int cw = min(max(cq - 8, 0), 48);
#pragma unroll
          for (int mt = 0; mt < 2; ++mt)
#pragma unroll
            for (int j = 0; j < 4; ++j) {
              const int ck = sub * 32 + mt * 16 + fq * 4 + j;
              const bool valid = (ck >= cw) && (ck < cw + 16);
              const int dc = min(max(ck - cq, -15), 15) + 15;
              const float bv = brow[dc];
              s[sub][mt][nt][j] = valid ? (s[sub][mt][nt][j] + bv * 8.f) : -INFINITY;
            }
        }
    }
    float tmx[4];
    bool grow = false;
#pragma unroll
    for (int nt = 0; nt < 4; ++nt) {
      float tm = -INFINITY;
#pragma unroll
      for (int sub = 0; sub < 2; ++sub)
#pragma unroll
        for (int mt = 0; mt < 2; ++mt)
          tm = fmaxf(tm, fmaxf(fmaxf(s[sub][mt][nt][0], s[sub][mt][nt][1]), fmaxf(s[sub][mt][nt][2], s[sub][mt][nt][3])));
      tm = fmaxf(tm, __shfl_xor(tm, 16));
      tm = fmaxf(tm, __shfl_xor(tm, 32));
      tm *= SC;
      tmx[nt] = tm;
      grow = grow || (tm > m[nt]);
    }
    if (__any(grow)) {
#pragma unroll
      for (int nt = 0; nt < 4; ++nt) {
        const float mn = fmaxf(m[nt], tmx[nt]);
        const float alpha = __builtin_amdgcn_exp2f(m[nt] - mn);
        m[nt] = mn;
        lsum[nt] *= alpha;
#pragma unroll
        for (int dt = 0; dt < 4; ++dt) o[dt][nt] *= alpha;
      }
    }
#pragma unroll
    for (int sub = 0; sub < 2; ++sub) {
      bf16x8 pb[4];
#pragma unroll
      for (int nt = 0; nt < 4; ++nt) {
        const float nm = -m[nt];
        float ps = 0.f;
#pragma unroll
        for (int mt = 0; mt < 2; ++mt)
#pragma unroll
          for (int j = 0; j < 4; ++j) { float pv = __builtin_amdgcn_exp2f(__builtin_fmaf(s[sub][mt][nt][j], SC, nm)); s[sub][mt][nt][j] = pv; ps += pv; }
        lsum[nt] += ps;
        pb[nt] = pack8(s[sub][0][nt], s[sub][1][nt]);
      }
      bf16x8 va[4];
#pragma unroll
      for (int dt = 0; dt < 4; ++dt) {
        const int d = dt * 16 + fr, q1 = sub * 4 + (fq >> 1);
        const u32x2 a = *(const LAS u32x2*)(sv + d * 128 + ((q1 ^ (d & 7)) << 4) + (fq & 1) * 8);
        const u32x2 b = *(const LAS u32x2*)(sv + d * 128 + (((q1 + 2) ^ (d & 7)) << 4) + (fq & 1) * 8);
        u32x4 r4; r4.x = a.x; r4.y = a.y; r4.z = b.x; r4.w = b.y;
        va[dt] = __builtin_bit_cast(bf16x8, r4);
      }
#pragma unroll
      for (int dt = 0; dt < 4; ++dt)
#pragma unroll
        for (int nt = 0; nt < 4; ++nt) o[dt][nt] = MFMA16(va[dt], pb[nt], o[dt][nt]);
    }
  }
#undef AB_ISSUE
#pragma unroll
  for (int nt = 0; nt < 4; ++nt) {
    float lt = lsum[nt];
    lt += __shfl_xor(lt, 16);
    lt += __shfl_xor(lt, 32);
    const float inv = 1.f / lt;
#pragma unroll
    for (int dt = 0; dt < 4; ++dt) {
      uint2 w; w.x = pack2(o[dt][nt][0] * inv, o[dt][nt][1] * inv); w.y = pack2(o[dt][nt][2] * inv, o[dt][nt][3] * inv);
      *(uint2*)(O + (size_t)(nt * 16 + fr) * ldo + dt * 16 + fq * 4) = w;
    }
  }
}

DI float logsig(float x) { return fminf(x, 0.f) - __logf(1.f + __expf(-fabsf(x))); }

DI void mlstm_item(const P& p, int l, int u, char* smem, int tid, int stages, int cdbase, int ugrp) {
  const int wid = tid >> 6;
  const bool samp = u < 32;
  int b, h, NC, rowbase, ldT, cs0;
  size_t tb;
  if (samp) { b = u >> 2; h = u & 3; NC = 16; rowbase = TP + b * 1024; ldT = 1024; tb = 1048576 + (size_t)((b * 4 + h) * 64) * 1024; cs0 = u * 32; }
  else { int v = u - 32; b = v >> 2; h = v & 3; NC = 4; rowbase = b * 256; ldT = 256; tb = (size_t)((b * 4 + h) * 64) * 256; cs0 = 1024 + v * 8; }
  float* fl = (float*)smem + wid * 768;
  float* W = fl;
  float* U = fl + 64;
  float* MX = fl + 192;
  float* DEC = fl + 320;
  float* EN = fl + 448;
  float* NQ = fl + 576;

  if (stages & 1)
  for (int cd = cdbase + wid; cd < NC * 2 && cd < cdbase + 8; cd += 8) {
    int lane = tid & 63;
    asm volatile("" : "+v"(lane));
    const int fr = lane & 15, fq = lane >> 4;
    const int j = cd >> 1, dir = cd & 1;
    const int cs = cs0 + dir * NC + j;
    const int row = rowbase + j * 64 + lane;
    const float gi = p.gates()[(size_t)row * 16 + dir * 8 + h], gf = p.gates()[(size_t)row * 16 + dir * 8 + 4 + h];
    float bb = logsig(gf);
    if (dir == 0) {
#pragma unroll
      for (int off = 1; off < 64; off <<= 1) { float t = __shfl_up(bb, off); if (lane >= off) bb += t; }
    } else {
#pragma unroll
      for (int off = 1; off < 64; off <<= 1) { float t = __shfl_down(bb, off); if (lane + off < 64) bb += t; }
    }
    const float bend = __shfl(bb, dir ? 0 : 63);
    const float lw = bend - bb + gi;
    const float a = wave_max(lw);
    W[lane] = __expf(lw - a);
    wave_sync();
    f32x4 acc[4][4];
#pragma unroll
    for (int i = 0; i < 4; ++i)
#pragma unroll
      for (int jj = 0; jj < 4; ++jj) acc[i][jj] = zero4();
    const u16* vt = p.vt_ml() + tb + j * 64;
    const u16* kt = p.kt_ml() + tb + j * 64;
#pragma unroll 1
    for (int ks = 0; ks < 2; ++ks) {
      const float4 w0 = *(const float4*)(W + ks * 32 + fq * 8), w1 = *(const float4*)(W + ks * 32 + fq * 8 + 4);
      bf16x8 af[4], bfr[4];
#pragma unroll
      for (int mt = 0; mt < 4; ++mt) {
        bf16x8 raw = ld8(vt + (size_t)(mt * 16 + fr) * ldT + ks * 32 + fq * 8);
        f32x4 lo, hi;
        lo[0] = bf2f((u16)raw[0]) * w0.x; lo[1] = bf2f((u16)raw[1]) * w0.y; lo[2] = bf2f((u16)raw[2]) * w0.z; lo[3] = bf2f((u16)raw[3]) * w0.w;
        hi[0] = bf2f((u16)raw[4]) * w1.x; hi[1] = bf2f((u16)raw[5]) * w1.y; hi[2] = bf2f((u16)raw[6]) * w1.z; hi[3] = bf2f((u16)raw[7]) * w1.w;
        af[mt] = pack8(lo, hi);
      }
#pragma unroll
      for (int nt = 0; nt < 4; ++nt) bfr[nt] = ld8(kt + (size_t)(nt * 16 + fr) * ldT + ks * 32 + fq * 8);
#pragma unroll
      for (int mt = 0; mt < 4; ++mt)
#pragma unroll
        for (int nt = 0; nt < 4; ++nt) acc[mt][nt] = MFMA16(af[mt], bfr[nt], acc[mt][nt]);
    }
    float* ch = p.ml_chat() + (size_t)cs * 4096;
#pragma unroll
    for (int mt = 0; mt < 4; ++mt)
#pragma unroll
      for (int nt = 0; nt < 4; ++nt)
#pragma unroll
        for (int jj = 0; jj < 4; ++jj) ch[(mt * 16 + fq * 4 + jj) * 64 + nt * 16 + fr] = acc[mt][nt][jj];
    float nh = 0.f;
    const u16* kr = kt + (size_t)lane * ldT;
#pragma unroll 1
    for (int c8 = 0; c8 < 8; ++c8) {
      bf16x8 kk = ld8(kr + c8 * 8);
      const float4 wa = *(const float4*)(W + c8 * 8), wb = *(const float4*)(W + c8 * 8 + 4);
      nh += bf2f((u16)kk[0]) * wa.x + bf2f((u16)kk[1]) * wa.y + bf2f((u16)kk[2]) * wa.z + bf2f((u16)kk[3]) * wa.w;
      nh += bf2f((u16)kk[4]) * wb.x + bf2f((u16)kk[5]) * wb.y + bf2f((u16)kk[6]) * wb.z + bf2f((u16)kk[7]) * wb.w;
    }
    p.ml_nhat()[(size_t)cs * 64 + lane] = nh;
    if (lane == 0) { p.ml_ab()[cs * 2] = a; p.ml_ab()[cs * 2 + 1] = bend; }
    wave_sync();
  }
  __syncthreads();

  if (stages & 2) {
    const int dir = tid >> 8, tt = tid & 255, e0 = tt * 16;
    float C[16];
    float n = 0.f, m = 0.f;
    const int sidx = ((b * 4 + l) * 2 + dir) * 4 + h;
    if (samp) {
#pragma unroll
      for (int i = 0; i < 4; ++i) {
        float4 v = *(const float4*)(p.stC + (size_t)sidx * 4096 + e0 + i * 4);
        C[i * 4] = v.x; C[i * 4 + 1] = v.y; C[i * 4 + 2] = v.z; C[i * 4 + 3] = v.w;
      }
      if (tt < 64) n = p.stn[sidx * 64 + tt];
      m = p.stm[sidx];
    } else {
#pragma unroll
      for (int i = 0; i < 16; ++i) { float z = 0.f; asm volatile("" : "+v"(z)); C[i] = z; }
    }
    for (int c4 = 0; c4 < NC; c4 += 4) {
      float4 chv[4][4];
      float av[4], bev[4], nhv[4];
#pragma unroll
      for (int q = 0; q < 4; ++q) {
        const int c = c4 + q, j = dir ? NC - 1 - c : c, cs = cs0 + dir * NC + j;
        av[q] = p.ml_ab()[cs * 2]; bev[q] = p.ml_ab()[cs * 2 + 1];
        nhv[q] = tt < 64 ? p.ml_nhat()[(size_t)cs * 64 + tt] : 0.f;
        const float* ch = p.ml_chat() + (size_t)cs * 4096 + e0;
#pragma unroll
        for (int i = 0; i < 4; ++i) chv[q][i] = *(const float4*)(ch + i * 4);
      }
#pragma unroll
      for (int q = 0; q < 4; ++q) {
        const int c = c4 + q, j = dir ? NC - 1 - c : c, cs = cs0 + dir * NC + j;
        uint4 w0, w1;
        w0.x = pack2(C[0], C[1]); w0.y = pack2(C[2], C[3]); w0.z = pack2(C[4], C[5]); w0.w = pack2(C[6], C[7]);
        w1.x = pack2(C[8], C[9]); w1.y = pack2(C[10], C[11]); w1.z = pack2(C[12], C[13]); w1.w = pack2(C[14], C[15]);
        *(uint4*)(p.ml_cst() + (size_t)cs * 4096 + e0) = w0;
        *(uint4*)(p.ml_cst() + (size_t)cs * 4096 + e0 + 8) = w1;
        if (tt < 64) p.ml_nst()[(size_t)cs * 64 + tt] = n;
        if (tt == 0) p.ml_mst()[cs] = m;
        const float mn = fmaxf(bev[q] + m, av[q]);
        const float carry = __expf(bev[q] + m - mn), beta = __expf(av[q] - mn);
#pragma unroll
        for (int i = 0; i < 4; ++i) {
          C[i * 4] = carry * C[i * 4] + beta * chv[q][i].x; C[i * 4 + 1] = carry * C[i * 4 + 1] + beta * chv[q][i].y;
          C[i * 4 + 2] = carry * C[i * 4 + 2] + beta * chv[q][i].z; C[i * 4 + 3] = carry * C[i * 4 + 3] + beta * chv[q][i].w;
        }
        n = carry * n + beta * nhv[q];
        m = mn;
      }
    }
    if (!samp) {
      float* oc = p.out + O_C + (size_t)sidx * 4096 + e0;
#pragma unroll
      for (int i = 0; i < 4; ++i) { float4 v; v.x = C[i * 4]; v.y = C[i * 4 + 1]; v.z = C[i * 4 + 2]; v.w = C[i * 4 + 3]; *(float4*)(oc + i * 4) = v; }
      if (tt < 64) p.out[O_N + (size_t)sidx * 64 + tt] = n;
      if (tt == 0) p.out[O_M + sidx] = m;
    }
  }
  __syncthreads();

  if (stages & 4)
  for (int uu = ugrp * 8 + wid; uu < NC * 2 && uu < ugrp * 8 + 8; uu += 8) {
    const int j = uu >> 1, half0 = uu & 1;
    int lane = tid & 63;
    asm volatile("" : "+v"(lane));
    const int fr = lane & 15, fq = lane >> 4;
    const int row = rowbase + j * 64 + lane;
    for (int dir = 0; dir < 2; ++dir) {
      const int cs = cs0 + dir * NC + j;
      const float m0 = p.ml_mst()[cs];
      const float gi = p.gates()[(size_t)row * 16 + dir * 8 + h], gf = p.gates()[(size_t)row * 16 + dir * 8 + 4 + h];
      float bb = logsig(gf);
      if (dir == 0) {
#pragma unroll
        for (int off = 1; off < 64; off <<= 1) { float t = __shfl_up(bb, off); if (lane >= off) bb += t; }
      } else {
#pragma unroll
        for (int off = 1; off < 64; off <<= 1) { float t = __shfl_down(bb, off); if (lane + off < 64) bb += t; }
      }
      const float uu = gi - bb;
      float cm = uu;
      if (dir == 0) {
#pragma unroll
        for (int off = 1; off < 64; off <<= 1) { float t = __shfl_up(cm, off); if (lane >= off) cm = fmaxf(cm, t); }
      } else {
#pragma unroll
        for (int off = 1; off < 64; off <<= 1) { float t = __shfl_down(cm, off); if (lane + off < 64) cm = fmaxf(cm, t); }
      }
      const float M = fmaxf(cm, m0);
      U[dir * 64 + lane] = uu;
      MX[dir * 64 + lane] = M;
      DEC[dir * 64 + lane] = __expf(m0 - M);
      EN[dir * 64 + lane] = __expf(-(bb + M));
      const u16* qr = p.zb() + (size_t)row * ZW + 1536 + h * 64;
      const float* ns = p.ml_nst() + (size_t)cs * 64;
      float nq = 0.f;
#pragma unroll
      for (int c8 = 0; c8 < 8; ++c8) {
        bf16x8 qq = ld8(qr + c8 * 8);
#pragma unroll
        for (int jj = 0; jj < 8; ++jj) nq += bf2f((u16)qq[jj]) * ns[c8 * 8 + jj];
      }
      NQ[dir * 64 + lane] = nq;
    }
    wave_sync();
#pragma unroll 1
    for (int half = half0; half < half0 + 1; ++half) {
      int lane_h = lane;
      asm volatile("" : "+v"(lane_h));
      const int fr = lane_h & 15, fq = lane_h >> 4;
      bf16x8 qf[2][2];
#pragma unroll
      for (int nt = 0; nt < 2; ++nt)
#pragma unroll
        for (int ks = 0; ks < 2; ++ks)
          qf[nt][ks] = ld8(p.zb() + (size_t)(rowbase + j * 64 + half * 32 + nt * 16 + fr) * ZW + 1536 + h * 64 + ks * 32 + fq * 8);
      f32x4 hs[4][2];
#pragma unroll
      for (int i = 0; i < 4; ++i) { hs[i][0] = zero4(); hs[i][1] = zero4(); }
#pragma unroll 1
      for (int dir = 0; dir < 2; ++dir) {
        const int cs = cs0 + dir * NC + j;
        f32x4 acc[4][2];
#pragma unroll
        for (int i = 0; i < 4; ++i) { acc[i][0] = zero4(); acc[i][1] = zero4(); }
        const u16* cst = p.ml_cst() + (size_t)cs * 4096;
#pragma unroll
        for (int ks = 0; ks < 2; ++ks)
#pragma unroll
          for (int dt = 0; dt < 4; ++dt) {
            bf16x8 cf = ld8(cst + (dt * 16 + fr) * 64 + ks * 32 + fq * 8);
#pragma unroll
            for (int nt = 0; nt < 2; ++nt) acc[dt][nt] = MFMA16(cf, qf[nt][ks], acc[dt][nt]);
          }
        float dec[2], Mt[2], dsum[2];
#pragma unroll
        for (int nt = 0; nt < 2; ++nt) {
          const int t = half * 32 + nt * 16 + fr;
          dec[nt] = DEC[dir * 64 + t]; Mt[nt] = MX[dir * 64 + t]; dsum[nt] = 0.f;
#pragma unroll
          for (int dt = 0; dt < 4; ++dt) acc[dt][nt] *= dec[nt];
        }
#pragma unroll 1
        for (int sk = 0; sk < 2; ++sk) {
          bf16x8 kf[2][2];
#pragma unroll
          for (int mt = 0; mt < 2; ++mt)
#pragma unroll
            for (int ks = 0; ks < 2; ++ks)
              kf[mt][ks] = ld8(p.zb() + (size_t)(rowbase + j * 64 + sk * 32 + mt * 16 + fr) * ZW + 1792 + h * 64 + ks * 32 + fq * 8);
          f32x4 s[2][2];
#pragma unroll
          for (int mt = 0; mt < 2; ++mt)
#pragma unroll
            for (int nt = 0; nt < 2; ++nt) {
              s[mt][nt] = zero4();
#pragma unroll
              for (int ks = 0; ks < 2; ++ks) s[mt][nt] = MFMA16(kf[mt][ks], qf[nt][ks], s[mt][nt]);
            }
#pragma unroll
          for (int mt = 0; mt < 2; ++mt) {
            const float4 u4 = *(const float4*)(U + dir * 64 + sk * 32 + mt * 16 + fq * 4);
            const float uv[4] = {u4.x, u4.y, u4.z, u4.w};
#pragma unroll
            for (int jj = 0; jj < 4; ++jj) {
              const int stok = sk * 32 + mt * 16 + fq * 4 + jj;
#pragma unroll
              for (int nt = 0; nt < 2; ++nt) {
                const int t = half * 32 + nt * 16 + fr;
                const bool valid = dir ? (stok >= t) : (stok <= t);
                const float w = valid ? __expf(uv[jj] - Mt[nt]) : 0.f;
                const float pv = s[mt][nt][jj] * w;
                s[mt][nt][jj] = pv;
                dsum[nt] += pv;
              }
            }
          }
          bf16x8 pb[2];
#pragma unroll
          for (int nt = 0; nt < 2; ++nt) pb[nt] = pack8(s[0][nt], s[1][nt]);
#pragma unroll
          for (int dt = 0; dt < 4; ++dt) {
            const u16* vp = p.vt_ml() + tb + (size_t)(dt * 16 + fr) * ldT + j * 64 + sk * 32 + fq * 4;
            bf16x8 va = ld4x2(vp, vp + 16);
#pragma unroll
            for (int nt = 0; nt < 2; ++nt) acc[dt][nt] = MFMA16(va, pb[nt], acc[dt][nt]);
          }
        }
#pragma unroll
        for (int nt = 0; nt < 2; ++nt) {
          const int t = half * 32 + nt * 16 + fr;
          float ds = dsum[nt];
          ds += __shfl_xor(ds, 16);
          ds += __shfl_xor(ds, 32);
          const float den = ds + dec[nt] * NQ[dir * 64 + t];
          const float dv = 1.f / fmaxf(fabsf(den), EN[dir * 64 + t]);
#pragma unroll
          for (int dt = 0; dt < 4; ++dt) hs[dt][nt] += acc[dt][nt] * dv;
        }
      }
#pragma unroll
      for (int nt = 0; nt < 2; ++nt) {
        float ss = 0.f;
#pragma unroll
        for (int dt = 0; dt < 4; ++dt)
#pragma unroll
          for (int jj = 0; jj < 4; ++jj) ss += hs[dt][nt][jj] * hs[dt][nt][jj];
        ss += __shfl_xor(ss, 16);
        ss += __shfl_xor(ss, 32);
        const float rs = rsqrtf(ss * (1.f / 64.f) + EPS);
        const int orow = rowbase + j * 64 + half * 32 + nt * 16 + fr;
#pragma unroll
        for (int dt = 0; dt < 4; ++dt) {
          const int v0 = dt * 16 + fq * 4;
          const float4 gn = *(const float4*)(p.g_ml + l * 256 + h * 64 + v0);
          const uint2 mo = *(const uint2*)(p.zb() + (size_t)orow * ZW + 2304 + h * 64 + v0);
          const float o0 = bf2f((u16)(mo.x & 0xffff)), o1 = bf2f((u16)(mo.x >> 16)), o2 = bf2f((u16)(mo.y & 0xffff)), o3 = bf2f((u16)(mo.y >> 16));
          const float r0 = hs[dt][nt][0] * rs * gn.x / (1.f + __expf(-o0));
          const float r1 = hs[dt][nt][1] * rs * gn.y / (1.f + __expf(-o1));
          const float r2 = hs[dt][nt][2] * rs * gn.z / (1.f + __expf(-o2));
          const float r3 = hs[dt][nt][3] * rs * gn.w / (1.f + __expf(-o3));
          uint2 w; w.x = pack2(r0, r1); w.y = pack2(r2, r3);
          *(uint2*)(p.mix() + (size_t)orow * 1024 + 768 + h * 64 + v0) = w;
        }
      }
    }
    wave_sync();
  }
  __syncthreads();
}

#define QCTR_BASE XCD_BAR_WORDS
#define BAR_TOTAL_WORDS (XCD_BAR_WORDS + 4 * 64)
DI void phase_mix(const P& p, int l, char* smem, int tid0) {
  volatile LAS int* sit = (volatile LAS int*)((LAS char*)smem + STAGE_LDS + 64);
  for (;;) {
    __syncthreads();
    if (tid0 == 0) *sit = (int)atomicAdd(&p.bar()[QCTR_BASE + l * 64], 1u);
    __syncthreads();
    const int it = *sit;
    if (it >= 480) break;
    int tv = tid0;
    asm volatile("" : "+v"(tv));
    const int wid = tv >> 6, lane = tv & 63;
    if (it >= 192 && it < 320) {
      mlstm_item(p, l, (it - 192) >> 2, smem, tv, 6, 0, (it - 192) & 3);
    } else if (it < 128) {
      const int x = it, b = x >> 4, kvh = (x >> 3) & 1, qt = (x & 7) * 2 + (wid >> 2), head = kvh * 4 + (wid & 3);
      const int rowbase = TP + b * 1024;
      const int ci = (b * 4 + l) * 2 + kvh;
      attn_block<false>((LAS unsigned char*)smem, tv, p.zb() + (size_t)(rowbase + qt * 64) * ZW + 768 + head * 64, ZW,
                        p.zb() + (size_t)rowbase * ZW + 1280 + kvh * 64, ZW, p.vt_gqa() + 524288 + (size_t)((b * 2 + kvh) * 64) * 1024, 1024, 16,
                        p.kc_gqa() + (size_t)ci * 16384, 64, p.vct_gqa() + (size_t)ci * 16384, 256, 4,
                        p.mix() + (size_t)(rowbase + qt * 64) * 1024 + 256 + head * 64, 1024, nullptr, 0, 0);
    } else if (it < 192) {
      const int x = it - 128, b = x >> 3, h = (x >> 1) & 3, rg = x & 1, r = rg * 8 + wid;
      const int rowbase = TP + b * 1024;
      const int r0 = min(max(r - 4, 0), 8);
      const int ulo = rg ? 4 : 0, nt0 = rg ? 12 : 11;
      const int ci = (b * 4 + l) * 4 + h;
      LAS float* btab = (LAS float*)((LAS char*)smem + 65536);
      for (int i = tv; i < 15 * 31; i += NTHR) btab[i] = p.na_bias[(size_t)(l * 4 + h) * 15 * 31 + i];
      __syncthreads();
      attn_block<true>((LAS unsigned char*)smem, tv, p.zb() + (size_t)(rowbase + r * 64) * ZW + h * 64, ZW,
                       p.zb() + (size_t)(rowbase + ulo * 64) * ZW + 256 + h * 64, ZW, p.vt_na() + 1048576 + (size_t)((b * 4 + h) * 64) * 1024 + ulo * 64, 1024, nt0,
                       p.kc_na() + (size_t)ci * 16384, 64, p.vct_na() + (size_t)ci * 16384, 256, 4,
                       p.mix() + (size_t)(rowbase + r * 64) * 1024 + h * 64, 1024, btab, r0 - r + 7, r0 - ulo);
    } else if (it < 384) {
      mlstm_item(p, l, 32 + (it - 320), smem, tv, 6, 0, 0);
    } else if (it < 448) {
      const int x = it - 384, b = x >> 2, kvh = (x >> 1) & 1, qt = (x & 1) * 2 + (wid >> 2), head = kvh * 4 + (wid & 3);
      const int rowbase = b * 256;
      attn_block<false>((LAS unsigned char*)smem, tv, p.zb() + (size_t)(rowbase + qt * 64) * ZW + 768 + head * 64, ZW,
                        p.zb() + (size_t)rowbase * ZW + 1280 + kvh * 64, ZW, p.vt_gqa() + (size_t)((b * 2 + kvh) * 64) * 256, 256, 4,
                        nullptr, 0, nullptr, 0, 0,
                        p.mix() + (size_t)(rowbase + qt * 64) * 1024 + 256 + head * 64, 1024, nullptr, 0, 0);
    } else {
      const int x = it - 448, b = x >> 1, h = (x & 1) * 2 + (wid >> 2), qt = wid & 3;
      const int rowbase = b * 256;
      attn_wave<false>(p.zb() + (size_t)(rowbase + qt * 64) * ZW + h * 64, ZW,
                       p.zb() + (size_t)rowbase * ZW + 256 + h * 64, ZW, p.vt_na() + (size_t)((b * 4 + h) * 64) * 256, 256, 256,
                       nullptr, 0, nullptr, 0, 0,
                       p.mix() + (size_t)(rowbase + qt * 64) * 1024 + h * 64, 1024, nullptr, 0, lane);
    }
  }
}

DI void phase_ml1(const P& p, int l, char* smem, int tid0) {
  for (int bi = blockIdx.x; bi < 192; bi += p.nblk) {
    int tv = tid0;
    asm volatile("" : "+v"(tv));
    if (bi < 128) mlstm_item(p, l, bi >> 2, smem, tv, 1, (bi & 3) * 8, 0);
    else mlstm_item(p, l, 32 + (bi - 128), smem, tv, 1, 0, 0);
  }
}

DI void run_phase(const P& p, int ph, int l, char* smem) {
  int tid = threadIdx.x;
  asm volatile("" : "+v"(tid));
  switch (ph) {
    case 0: phase_init(p, smem, tid); break;
    case 1: phase_row(p, 0, 0, smem, tid); break;
    case 2: phase_gemm(p, 0, l, smem); break;
    case 3: phase_ml1(p, l, smem, tid); break;
    case 4: phase_mix(p, l, smem, tid); break;
    case 5: phase_gemm(p, 1, l, smem); break;
    case 6: phase_row(p, 1, l, smem, tid); break;
    case 7: phase_gemm(p, 2, l, smem); break;
    case 8: phase_gemm(p, 3, l, smem); break;
    default: phase_row(p, 2, l, smem, tid); break;
  }
}

#if !ONE_LAUNCH
__global__ void __launch_bounds__(512, 2) k_phase(P p, int ph, int l) {
  extern __shared__ __attribute__((aligned(16))) char smem[];
  run_phase(p, ph, l, smem);
}
#else
__global__ void __launch_bounds__(512, 2) k_mega(P p) {
  extern __shared__ __attribute__((aligned(16))) char smem[];
  uint4* xbw = (uint4*)(smem + STAGE_LDS);
  if (threadIdx.x == 0) *xbw = make_uint4(0u, 0u, 0u, 0u);
  __syncthreads();
  XcdBarrier xb = xcd_barrier_post(p.bar(), (volatile LAS unsigned*)xbw, (unsigned)p.nblk);
#if TPROBE
  unsigned long long* ts = (unsigned long long*)(p.bar() + BAR_TOTAL_WORDS);
  const bool rec = blockIdx.x == 0 && threadIdx.x == 0;
  if (rec) ts[0] = __builtin_amdgcn_s_memrealtime();
#endif
  run_phase(p, 0, 0, smem);
  xcd_barrier(xb);
#if TPROBE
  if (rec) ts[1] = __builtin_amdgcn_s_memrealtime();
#endif
  run_phase(p, 1, 0, smem);
#if TPROBE
#define TSREC(ph) if (rec) ts[2 + l * 8 + ((ph) - 2)] = __builtin_amdgcn_s_memrealtime();
#else
#define TSREC(ph)
#endif
#pragma unroll 1
  for (int l = 0; l < 4; ++l) {
    xcd_barrier(xb); TSREC(2) run_phase(p, 2, l, smem);
    xcd_barrier(xb); TSREC(3) run_phase(p, 3, l, smem);
    xcd_barrier(xb); TSREC(4) run_phase(p, 4, l, smem);
    xcd_barrier(xb); TSREC(5) run_phase(p, 5, l, smem);
    xcd_barrier(xb); TSREC(6) run_phase(p, 6, l, smem);
    xcd_barrier(xb); TSREC(7) run_phase(p, 7, l, smem);
    xcd_barrier(xb); TSREC(8) run_phase(p, 8, l, smem);
    xcd_barrier(xb); TSREC(9) run_phase(p, 9, l, smem);
  }
#if TPROBE
  xcd_barrier(xb);
  if (rec) {
    ts[34] = __builtin_amdgcn_s_memrealtime();
    unsigned long long sum = 0;
    for (int i = 0; i < 34; ++i) {
      int ph = i < 2 ? i : 2 + (i - 2) % 8;
      if ((TPROBE >> ph) & 1) sum += ts[i + 1] - ts[i];
    }
    p.out[0] += TQ * floorf((float)sum * 0.01f * (1.f / TQ));
  }
#endif
}
#endif

extern "C" void kernel_launch(void* const* d_in, const int* in_sizes, int n_in, void* d_out, int out_size, void* d_ws,
                              size_t ws_size, hipStream_t stream) {
  P p{};
  p.x_prompt = (const float*)d_in[0]; p.x_sample = (const float*)d_in[1]; p.cache_na = (const float*)d_in[2];
  p.cache_gqa = (const float*)d_in[3]; p.stC = (const float*)d_in[4]; p.stn = (const float*)d_in[5]; p.stm = (const float*)d_in[6];
  p.c = (const float*)d_in[7]; p.c_ctx = (const float*)d_in[8]; p.w_in = (const float*)d_in[9]; p.b_gates = (const float*)d_in[10];
  p.w_out = (const float*)d_in[11]; p.g_norm = (const float*)d_in[12]; p.g_qk = (const float*)d_in[13]; p.g_ml = (const float*)d_in[14];
  p.na_bias = (const float*)d_in[15]; p.w_ada = (const float*)d_in[16]; p.b_ada = (const float*)d_in[17]; p.w_gu = (const float*)d_in[18];
  p.w_down = (const float*)d_in[19];
  p.out = (float*)d_out;
  p.ws = (char*)d_ws;
  if (WS_TOTAL_X > ws_size) { fprintf(stderr, "workspace too small: need %zu have %zu\n", (size_t)WS_TOTAL, ws_size); return; }

  static int grid_blocks = 0;
  if (!grid_blocks) {
    int dev = 0, cus = 0, per_cu = 0;
    (void)hipGetDevice(&dev);
    (void)hipDeviceGetAttribute(&cus, hipDeviceAttributeMultiprocessorCount, dev);
#if ONE_LAUNCH
    (void)hipFuncSetAttribute((const void*)k_mega, hipFuncAttributeMaxDynamicSharedMemorySize, DYN_LDS);
    (void)hipOccupancyMaxActiveBlocksPerMultiprocessor(&per_cu, k_mega, NTHR, DYN_LDS);
#else
    (void)hipFuncSetAttribute((const void*)k_phase, hipFuncAttributeMaxDynamicSharedMemorySize, DYN_LDS);
    (void)hipOccupancyMaxActiveBlocksPerMultiprocessor(&per_cu, k_phase, NTHR, DYN_LDS);
#endif
    if (per_cu < 1) { fprintf(stderr, "occupancy query returned %d\n", per_cu); per_cu = 1; }
    if (per_cu > 1) per_cu = 1;
    grid_blocks = cus * per_cu;
  }
  p.nblk = grid_blocks;
  (void)hipMemsetAsync(p.bar(), 0, (size_t)BAR_TOTAL_WORDS * 4, stream);
#if ONE_LAUNCH
  void* args[] = {&p};
  hipError_t e = hipLaunchCooperativeKernel((void*)k_mega, dim3(grid_blocks), dim3(NTHR), args, DYN_LDS, stream);
  if (e != hipSuccess) fprintf(stderr, "cooperative launch failed: %s (grid %d)\n", hipGetErrorString(e), grid_blocks);
#else
  k_phase<<<grid_blocks, NTHR, DYN_LDS, stream>>>(p, 0, 0);
  k_phase<<<grid_blocks, NTHR, DYN_LDS, stream>>>(p, 1, 0);
  for (int l = 0; l < 4; ++l)
    for (int ph = 2; ph <= 9; ++ph) k_phase<<<grid_blocks, NTHR, DYN_LDS, stream>>>(p, ph, l);
#endif
}
```

```cpp
#include <hip/hip_runtime.h>
#include <stdint.h>
#include <stdio.h>

#ifndef ONE_LAUNCH
#define ONE_LAUNCH 1
#endif
#ifndef TPROBE
#define TPROBE 0
#endif
#ifndef TQ
#define TQ 200.f
#endif
constexpr int NTHR = 512, NWAVE = 8;
constexpr int STAGE_LDS = 131072, DYN_LDS = STAGE_LDS + 256;

#define DI __device__ __forceinline__
typedef unsigned short u16;
typedef __attribute__((ext_vector_type(8))) short bf16x8;
typedef __attribute__((ext_vector_type(4))) float f32x4;

constexpr int TP = 4096, TS = 8192, TT = 12288, ZW = 2560, NIN = 2688, FF = 2816;
constexpr float EPS = 1e-6f;
constexpr size_t O_YP = 0, O_NA = 12582912, O_GQA = 20971520, O_C = 25165824, O_N = 27262976, O_M = 27295744;
constexpr int SMEM_BYTES = 73728;

struct P {
  const float *x_prompt, *x_sample, *cache_na, *cache_gqa, *stC, *stn, *stm, *c, *c_ctx, *w_in, *b_gates, *w_out,
      *g_norm, *g_qk, *g_ml, *na_bias, *w_ada, *b_ada, *w_gu, *w_down;
  float* out;
  char* ws;
  int nblk, pad_;
  __host__ __device__ __forceinline__ u16* wt_in() const { return (u16*)(ws + 0ull); }
  __host__ __device__ __forceinline__ u16* wt_out() const { return (u16*)(ws + 20971520ull); }
  __host__ __device__ __forceinline__ u16* wt_gu() const { return (u16*)(ws + 29360128ull); }
  __host__ __device__ __forceinline__ u16* wt_down() const { return (u16*)(ws + 75497472ull); }
  __host__ __device__ __forceinline__ float* mods() const { return (float*)(ws + 98566144ull); }
  __host__ __device__ __forceinline__ float* rope() const { return (float*)(ws + 99450880ull); }
  __host__ __device__ __forceinline__ u16* kc_na() const { return (u16*)(ws + 99459072ull); }
  __host__ __device__ __forceinline__ u16* vct_na() const { return (u16*)(ws + 103653376ull); }
  __host__ __device__ __forceinline__ u16* kc_gqa() const { return (u16*)(ws + 107847680ull); }
  __host__ __device__ __forceinline__ u16* vct_gqa() const { return (u16*)(ws + 109944832ull); }
  __host__ __device__ __forceinline__ u16* hn() const { return (u16*)(ws + 112041984ull); }
  __host__ __device__ __forceinline__ u16* zb() const { return (u16*)(ws + 137207808ull); }
  __host__ __device__ __forceinline__ u16* act() const { return (u16*)(ws + 137207808ull); }
  __host__ __device__ __forceinline__ u16* vt_na() const { return (u16*)(ws + 206413824ull); }
  __host__ __device__ __forceinline__ u16* vt_gqa() const { return (u16*)(ws + 212705280ull); }
  __host__ __device__ __forceinline__ u16* kt_ml() const { return (u16*)(ws + 215851008ull); }
  __host__ __device__ __forceinline__ u16* vt_ml() const { return (u16*)(ws + 222142464ull); }
  __host__ __device__ __forceinline__ u16* mix() const { return (u16*)(ws + 228433920ull); }
  __host__ __device__ __forceinline__ float* gates() const { return (float*)(ws + 253599744ull); }
  __host__ __device__ __forceinline__ float* obuf() const { return (float*)(ws + 254386176ull); }
  __host__ __device__ __forceinline__ float* ml_chat() const { return (float*)(ws + 304717824ull); }
  __host__ __device__ __forceinline__ float* ml_nhat() const { return (float*)(ws + 329883648ull); }
  __host__ __device__ __forceinline__ float* ml_ab() const { return (float*)(ws + 330276864ull); }
  __host__ __device__ __forceinline__ float* ml_nst() const { return (float*)(ws + 330289152ull); }
  __host__ __device__ __forceinline__ float* ml_mst() const { return (float*)(ws + 330682368ull); }
  __host__ __device__ __forceinline__ u16* ml_cst() const { return (u16*)(ws + 330688512ull); }
  __host__ __device__ __forceinline__ unsigned* bar() const { return (unsigned*)(ws + 343271424ull); }
};
constexpr size_t X16_OFF = 343351808ull;
constexpr size_t WS_TOTAL_X = X16_OFF + (size_t)12288 * 1024 * 2;
constexpr size_t WS_TOTAL = 343286272ull;

DI u16 f2bf(float x) { unsigned u = __float_as_uint(x); u += 0x7fffu + ((u >> 16) & 1u); return (u16)(u >> 16); }
DI float bf2f(u16 h) { return __uint_as_float(((unsigned)h) << 16); }
DI unsigned pack2(float a, float b) { unsigned r; asm volatile("v_cvt_pk_bf16_f32 %0, %1, %2" : "=v"(r) : "v"(a), "v"(b)); return r; }
#define DPP_F(v, ctrl, rmask) __int_as_float(__builtin_amdgcn_update_dpp(0, __float_as_int(v), (ctrl), (rmask), 0xF, false))
DI float wave_sum(float v) {
  v += DPP_F(v, 0xB1, 0xF);
  v += DPP_F(v, 0x4E, 0xF);
  v += DPP_F(v, 0x141, 0xF);
  v += DPP_F(v, 0x140, 0xF);
  v += DPP_F(v, 0x142, 0xA);
  v += DPP_F(v, 0x143, 0xC);
  return __int_as_float(__builtin_amdgcn_readlane(__float_as_int(v), 63));
}
DI float wave_max(float v) { for (int o = 32; o >= 1; o >>= 1) v = fmaxf(v, __shfl_xor(v, o)); return v; }
DI void wave_sync() { __builtin_amdgcn_fence(__ATOMIC_RELEASE, "wavefront"); __builtin_amdgcn_wave_barrier(); __builtin_amdgcn_fence(__ATOMIC_ACQUIRE, "wavefront"); }
#define MFMA16(a, b, c) __builtin_amdgcn_mfma_f32_16x16x32_bf16((a), (b), (c), 0, 0, 0)
DI bf16x8 ld8(const u16* p) { return *(const bf16x8*)p; }
DI bf16x8 ld4x2(const u16* p0, const u16* p1) {
  uint2 a = *(const uint2*)p0, b = *(const uint2*)p1;
  uint4 r; r.x = a.x; r.y = a.y; r.z = b.x; r.w = b.y;
  return __builtin_bit_cast(bf16x8, r);
}
DI bf16x8 pack8(const f32x4& a, const f32x4& b) {
  uint4 r; r.x = pack2(a[0], a[1]); r.y = pack2(a[2], a[3]); r.z = pack2(b[0], b[1]); r.w = pack2(b[2], b[3]);
  return __builtin_bit_cast(bf16x8, r);
}
DI f32x4 zero4() { f32x4 z = {0.f, 0.f, 0.f, 0.f}; return z; }

DI size_t vt_index(int row, int H, int h, int d) {
  if (row < TP) { int b = row >> 8, t = row & 255; return ((size_t)((b * H + h) * 64 + d)) * 256 + t; }
  int r = row - TP; int b = r >> 10, t = r & 1023;
  return (size_t)16 * H * 64 * 256 + ((size_t)((b * H + h) * 64 + d)) * 1024 + t;
}


#define XB_TMO      128
#define XB_XCNT(j)  (256  + 64 * (j))
#define XB_XSUB(j)  (1280 + 64 * (j))
#define XB_XGEN(j)  (2304 + 64 * (j))
#define XB_TOP      3328
#define XB_TOPGEN   3392
#define XCD_BAR_WORDS 3456
#define XB_SPIN_CAP (1u << 20)
#define LAS __attribute__((address_space(3)))
DI unsigned xb_ld(unsigned* p) { return __hip_atomic_load(p, __ATOMIC_RELAXED, __HIP_MEMORY_SCOPE_AGENT); }
DI unsigned xb_add(unsigned* p, unsigned v) { return __hip_atomic_fetch_add(p, v, __ATOMIC_RELAXED, __HIP_MEMORY_SCOPE_AGENT); }
DI unsigned xb_xcc_id() { return (unsigned)__builtin_amdgcn_s_getreg((3 << 11) | 20) & 0xFu; }
#define XB_SPIN(cond, bar) do { unsigned _sp = 0; while (cond) { __builtin_amdgcn_s_sleep(1); \
    if ((++_sp & 255u) == 0u) { if (xb_ld(&(bar)[XB_TMO])) break; if (_sp > XB_SPIN_CAP) { atomicAdd(&(bar)[XB_TMO], 1u); break; } } } } while (0)
struct XcdBarrier { unsigned* bar; unsigned x; unsigned G; volatile LAS unsigned* st; };
DI XcdBarrier xcd_barrier_post(unsigned* bar, volatile LAS unsigned* st, unsigned G) {
  XcdBarrier b; b.bar = bar; b.x = xb_xcc_id(); b.st = st; b.G = G;
  if (threadIdx.x == 0) (void)xb_add(&bar[XB_XCNT(b.x)], 1u);
  return b;
}
DI void xcd_barrier_complete(unsigned* bar, unsigned x, unsigned& nloc, unsigned& nx, unsigned G) {
  unsigned sum, cnt, mine, sp = 0u;
  for (;;) {
    sum = 0u; cnt = 0u; mine = 0u;
#pragma unroll
    for (unsigned j = 0; j < 16; ++j) { const unsigned c = xb_ld(&bar[XB_XCNT(j)]); sum += c; cnt += (c > 0u) ? 1u : 0u; mine = (j == x) ? c : mine; }
    if (sum == G) break;
    __builtin_amdgcn_s_sleep(1);
    if ((++sp & 255u) == 0u) { if (xb_ld(&bar[XB_TMO])) break; if (sp > XB_SPIN_CAP) { atomicAdd(&bar[XB_TMO], 1u); break; } }
  }
  nloc = mine > 0u ? mine : 1u; nx = cnt > 0u ? cnt : 1u;
}
DI void xcd_barrier(const XcdBarrier& b) {
  asm volatile("s_waitcnt vmcnt(0)" ::: "memory");
  __syncthreads();
  if (threadIdx.x == 0) {
    unsigned* bar = b.bar;
    __builtin_amdgcn_s_waitcnt(0);
    unsigned nloc = b.st[0], nx = b.st[1];
    if (nloc == 0u) { xcd_barrier_complete(bar, b.x, nloc, nx, b.G); b.st[0] = nloc; b.st[1] = nx; }
    const unsigned old = xb_add(&bar[XB_XSUB(b.x)], 1u);
    const unsigned gen = old / nloc;
    if (old + 1u == (gen + 1u) * nloc) {
      __builtin_amdgcn_fence(__ATOMIC_RELEASE, "agent");
      asm volatile("s_waitcnt vmcnt(0)" ::: "memory");
      const unsigned og = xb_add(&bar[XB_TOP], 1u);
      const unsigned tg = og / nx;
      if (og + 1u == (tg + 1u) * nx) xb_add(&bar[XB_TOPGEN], 1u);
      else XB_SPIN(xb_ld(&bar[XB_TOPGEN]) == tg, bar);
      __builtin_amdgcn_fence(__ATOMIC_ACQUIRE, "agent");
      xb_add(&bar[XB_XGEN(b.x)], 1u);
      asm volatile("s_waitcnt vmcnt(0)" ::: "memory");
    } else {
      XB_SPIN(xb_ld(&bar[XB_XGEN(b.x)]) == gen, bar);
      __builtin_amdgcn_fence(__ATOMIC_ACQUIRE, "agent");
      asm volatile("s_waitcnt vmcnt(0)" ::: "memory");
    }
  }
  __syncthreads();
}

DI void transpose_tile(const float* __restrict__ src, int ldsrc, int k0, int n0, int mode, int nvalid,
                       u16* __restrict__ dst, int ldd, float* tile, int tid) {
  const int nn = tid & 63, kq = tid >> 6;
  int rr = n0 + nn, col;
  if (mode == 1) {
    int tl = rr >> 8, c = rr & 255, bj = c >> 7, wc = (c >> 5) & 3, w = c & 31;
    col = tl * 128 + wc * 32 + w + bj * FF;
  } else if (mode == 2) {
    int tl = rr >> 8, c = rr & 255, bj = c >> 7, wc = (c >> 5) & 3, w = c & 31;
    col = tl * 256 + wc * 64 + bj * 32 + w;
  } else col = rr < nvalid ? rr : -1;
#pragma unroll
  for (int i = 0; i < 8; ++i) {
    int kk = i * 8 + kq;
    tile[kk * 65 + nn] = col >= 0 ? src[(size_t)(k0 + kk) * ldsrc + col] : 0.f;
  }
  __syncthreads();
  const int k2 = (tid & 31) * 2, nq = tid >> 5;
#pragma unroll
  for (int i = 0; i < 4; ++i) {
    int n = i * 16 + nq;
    *(unsigned*)(dst + (size_t)(n0 + n) * ldd + k0 + k2) = pack2(tile[k2 * 65 + n], tile[(k2 + 1) * 65 + n]);
  }
  __syncthreads();
}

DI void phase_init(const P& p, char* smem, int tid) {
  float* tile = (float*)smem;
  const int NTR = 12032, NCV = 768, NADA = 384;
  const int total = NTR + NCV + NADA + 1;
  for (int it = blockIdx.x; it < total; it += p.nblk) {
    if (it < NTR) {
      int l = it / 3008, r = it % 3008;
      if (r < 640) {
        int kt = r / 40, nt = r % 40;
        transpose_tile(p.w_in + (size_t)l * 1024 * 2576, 2576, kt * 64, nt * 64, 2, 2560, p.wt_in() + (size_t)l * ZW * 1024, 1024, tile, tid);
      } else if (r < 896) {
        int x = r - 640, kt = x / 16, nt = x % 16;
        transpose_tile(p.w_out + (size_t)l * 1024 * 1024, 1024, kt * 64, nt * 64, 0, 1024, p.wt_out() + (size_t)l * 1024 * 1024, 1024, tile, tid);
      } else if (r < 2304) {
        int x = r - 896, kt = x / 88, nt = x % 88;
        transpose_tile(p.w_gu + (size_t)l * 1024 * 5632, 5632, kt * 64, nt * 64, 1, 5632, p.wt_gu() + (size_t)l * 5632 * 1024, 1024, tile, tid);
      } else {
        int x = r - 2304, kt = x / 16, nt = x % 16;
        transpose_tile(p.w_down + (size_t)l * FF * 1024, 1024, kt * 64, nt * 64, 0, 1024, p.wt_down() + (size_t)l * 1024 * FF, FF, tile, tid);
      }
    } else if (it < NTR + NCV) {
      int it2 = it - NTR;
      if (it2 < 512) {
        int idx = it2 >> 2, tt = it2 & 3, bl = idx >> 2, h = idx & 3;
        transpose_tile(p.cache_na + (size_t)((bl * 2 + 1) * 4 + h) * 16384, 64, tt * 64, 0, 0, 64, p.vct_na() + (size_t)idx * 16384, 256, tile, tid);
      } else {
        int it3 = it2 - 512;
        int idx = it3 >> 2, tt = it3 & 3, bl = idx >> 1, h = idx & 1;
        transpose_tile(p.cache_gqa + (size_t)((bl * 2 + 1) * 2 + h) * 16384, 64, tt * 64, 0, 0, 64, p.vct_gqa() + (size_t)idx * 16384, 256, tile, tid);
      }
    } else if (it < NTR + NCV + NADA) {
      int ia = it - NTR - NCV;
      int l = ia / 96, colbase = (ia % 96) * 64;
      float* sl = (float*)smem;
      for (int i = tid; i < 9 * 1024; i += NTHR) {
        int n = i >> 10, d = i & 1023;
        float cv = n == 0 ? p.c_ctx[d] : p.c[(n - 1) * 1024 + d];
        sl[i] = cv / (1.f + __expf(-cv));
      }
      __syncthreads();
      const int col = tid & 63, kg = tid >> 6;
      float acc[9];
#pragma unroll
      for (int n = 0; n < 9; ++n) acc[n] = 0.f;
      const float* w = p.w_ada + ((size_t)l * 1024 + kg * 128) * 6144 + colbase + col;
#pragma unroll 4
      for (int k = 0; k < 128; ++k) {
        float wv = w[(size_t)k * 6144];
#pragma unroll
        for (int n = 0; n < 9; ++n) acc[n] += sl[n * 1024 + kg * 128 + k] * wv;
      }
      float* red = sl + 9216;
#pragma unroll
      for (int n = 0; n < 9; ++n) red[(kg * 9 + n) * 64 + col] = acc[n];
      __syncthreads();
      for (int i = tid; i < 576; i += NTHR) {
        int n = i >> 6, cc = i & 63;
        float s = 0.f;
#pragma unroll
        for (int g = 0; g < 8; ++g) s += red[(g * 9 + n) * 64 + cc];
        p.mods()[(size_t)(l * 9 + n) * 6144 + colbase + cc] = s + p.b_ada[l * 6144 + colbase + cc];
      }
      __syncthreads();
    } else {
      for (int i = tid; i < 1024; i += NTHR) {
        int pos = i >> 4, fi = i & 15;
        float inv = __builtin_amdgcn_exp2f(-(float)fi * 0.8304820237f);
        float ang = (float)pos * inv;
        p.rope()[i] = __cosf(ang);
        p.rope()[1024 + i] = __sinf(ang);
      }
    }
  }
  const int gtid = blockIdx.x * NTHR + tid, gsz = p.nblk * NTHR;
  for (int i = gtid; i < 128 * 4096; i += gsz) {
    int idx = i >> 12, e = (i & 4095) * 4, bl = idx >> 2, h = idx & 3;
    float4 v = *(const float4*)(p.cache_na + (size_t)((bl * 2 + 0) * 4 + h) * 16384 + e);
    uint2 o; o.x = pack2(v.x, v.y); o.y = pack2(v.z, v.w);
    *(uint2*)(p.kc_na() + (size_t)idx * 16384 + e) = o;
  }
  for (int i = gtid; i < 64 * 4096; i += gsz) {
    int idx = i >> 12, e = (i & 4095) * 4, bl = idx >> 1, h = idx & 1;
    float4 v = *(const float4*)(p.cache_gqa + (size_t)((bl * 2 + 0) * 2 + h) * 16384 + e);
    uint2 o; o.x = pack2(v.x, v.y); o.y = pack2(v.z, v.w);
    *(uint2*)(p.kc_gqa() + (size_t)idx * 16384 + e) = o;
  }
}

DI void phase_row(const P& p, int mode, int l, char* smem, int tid) {
  const int lane = tid & 63, wid = tid >> 6;
  const bool last = (mode == 2 && l == 3);
  const int ln = mode == 1 ? l : (mode == 0 ? 0 : l + 1);
  const bool do_gates = (mode != 1) && !last;
  u16* x16 = (u16*)(p.ws + X16_OFF);
  float* Wg = (float*)smem;
  if (do_gates) {
    for (int idx = tid; idx < 16384; idx += NTHR) {
      int k = idx >> 4, g = idx & 15;
      Wg[g * 1024 + k] = p.w_in[((size_t)ln * 1024 + k) * 2576 + 2560 + g];
    }
    __syncthreads();
  }
  uint2 obn[4], xbn[4];
  if (mode != 0) {
    const int r0_ = blockIdx.x * NWAVE + wid;
    if (r0_ < TT) {
#pragma unroll
      for (int i = 0; i < 4; ++i) { obn[i] = *(const uint2*)((const u16*)p.obuf() + (size_t)r0_ * 1024 + i * 256 + lane * 4); xbn[i] = *(const uint2*)(x16 + (size_t)r0_ * 1024 + i * 256 + lane * 4); }
    }
  }
  for (int row_ = blockIdx.x * NWAVE + wid; row_ < TT; row_ += p.nblk * NWAVE) {
    int row = row_;
    asm volatile("" : "+v"(row));
    const int nidx = row < TP ? 0 : 1 + ((row - TP) >> 10);
    float4 x[4];
    const int gi = mode == 1 ? 2 : 0, shi = mode == 1 ? 3 : 0;
    const float* g2 = p.g_norm + (size_t)(ln * 4 + gi) * 1024;
    const float* sh = p.mods() + ((size_t)(ln * 9 + nidx) * 6 + shi) * 1024;
    const float* sc = sh + 1024;
    float4 g2v[4], shv[4], scv[4];
    if (mode == 0) {
      const float* src = row < TP ? p.x_prompt + (size_t)row * 1024 : p.x_sample + (size_t)(row - TP) * 1024;
#pragma unroll
      for (int i = 0; i < 4; ++i) x[i] = *(const float4*)(src + i * 256 + lane * 4);
#pragma unroll
      for (int i = 0; i < 4; ++i) { const int cidx = i * 256 + lane * 4; g2v[i] = *(const float4*)(g2 + cidx); shv[i] = *(const float4*)(sh + cidx); scv[i] = *(const float4*)(sc + cidx); }
    } else {
      const float* ga = p.mods() + ((size_t)(l * 9 + nidx) * 6 + (mode == 1 ? 2 : 5)) * 1024;
      const float* g = p.g_norm + (size_t)(l * 4 + (mode == 1 ? 1 : 3)) * 1024;
      uint2 ob[4], xb[4];
      float4 gav[4], gv[4];
#pragma unroll
      for (int i = 0; i < 4; ++i) { ob[i] = obn[i]; xb[i] = xbn[i]; }
      {
        const int rnx = row_ + p.nblk * NWAVE;
        if (rnx < TT) {
#pragma unroll
          for (int i = 0; i < 4; ++i) { obn[i] = *(const uint2*)((const u16*)p.obuf() + (size_t)rnx * 1024 + i * 256 + lane * 4); xbn[i] = *(const uint2*)(x16 + (size_t)rnx * 1024 + i * 256 + lane * 4); }
        }
      }
#pragma unroll
      for (int i = 0; i < 4; ++i) { const int cidx = i * 256 + lane * 4; gav[i] = *(const float4*)(ga + cidx); gv[i] = *(const float4*)(g + cidx); }
      if (!last) {
#pragma unroll
        for (int i = 0; i < 4; ++i) { const int cidx = i * 256 + lane * 4; g2v[i] = *(const float4*)(g2 + cidx); shv[i] = *(const float4*)(sh + cidx); scv[i] = *(const float4*)(sc + cidx); }
      }
      float4 o[4];
      float ss = 0.f;
#pragma unroll
      for (int i = 0; i < 4; ++i) {
        o[i].x = __uint_as_float(ob[i].x << 16); o[i].y = __uint_as_float(ob[i].x & 0xffff0000u);
        o[i].z = __uint_as_float(ob[i].y << 16); o[i].w = __uint_as_float(ob[i].y & 0xffff0000u);
        x[i].x = __uint_as_float(xb[i].x << 16); x[i].y = __uint_as_float(xb[i].x & 0xffff0000u);
        x[i].z = __uint_as_float(xb[i].y << 16); x[i].w = __uint_as_float(xb[i].y & 0xffff0000u);
        ss += o[i].x * o[i].x + o[i].y * o[i].y + o[i].z * o[i].z + o[i].w * o[i].w;
      }
      ss = wave_sum(ss);
      const float rs = rsqrtf(ss * (1.f / 1024.f) + EPS);
#pragma unroll
      for (int i = 0; i < 4; ++i) {
        x[i].x += gav[i].x * (o[i].x * rs * gv[i].x); x[i].y += gav[i].y * (o[i].y * rs * gv[i].y);
        x[i].z += gav[i].z * (o[i].z * rs * gv[i].z); x[i].w += gav[i].w * (o[i].w * rs * gv[i].w);
      }
    }
    if (last) {
#pragma unroll
      for (int i = 0; i < 4; ++i) *(float4*)(p.out + (size_t)row * 1024 + i * 256 + lane * 4) = x[i];
      continue;
    }
#pragma unroll
    for (int i = 0; i < 4; ++i) {
      uint2 w; w.x = pack2(x[i].x, x[i].y); w.y = pack2(x[i].z, x[i].w);
      *(uint2*)(x16 + (size_t)row * 1024 + i * 256 + lane * 4) = w;
      x[i].x = __uint_as_float(w.x << 16); x[i].y = __uint_as_float(w.x & 0xffff0000u);
      x[i].z = __uint_as_float(w.y << 16); x[i].w = __uint_as_float(w.y & 0xffff0000u);
    }
    float ss2 = 0.f;
#pragma unroll
    for (int i = 0; i < 4; ++i) ss2 += x[i].x * x[i].x + x[i].y * x[i].y + x[i].z * x[i].z + x[i].w * x[i].w;
    ss2 = wave_sum(ss2);
    const float rs2 = rsqrtf(ss2 * (1.f / 1024.f) + EPS);
#pragma unroll
    for (int i = 0; i < 4; ++i) {
      const int cidx = i * 256 + lane * 4;
      x[i].x = x[i].x * rs2 * g2v[i].x * (1.f + scv[i].x) + shv[i].x;
      x[i].y = x[i].y * rs2 * g2v[i].y * (1.f + scv[i].y) + shv[i].y;
      x[i].z = x[i].z * rs2 * g2v[i].z * (1.f + scv[i].z) + shv[i].z;
      x[i].w = x[i].w * rs2 * g2v[i].w * (1.f + scv[i].w) + shv[i].w;
      uint2 o2; o2.x = pack2(x[i].x, x[i].y); o2.y = pack2(x[i].z, x[i].w);
      *(uint2*)(p.hn() + (size_t)row * 1024 + cidx) = o2;
    }
    if (do_gates) {
      float part[16];
#pragma unroll 2
      for (int g16 = 0; g16 < 16; ++g16) {
        float a = 0.f;
#pragma unroll
        for (int i = 0; i < 4; ++i) {
          const float4 wv = *(const float4*)(Wg + g16 * 1024 + i * 256 + lane * 4);
          a += x[i].x * wv.x + x[i].y * wv.y + x[i].z * wv.z + x[i].w * wv.w;
        }
        part[g16] = a;
      }
      const bool b5 = (lane & 32) != 0, b4 = (lane & 16) != 0, b3 = (lane & 8) != 0, b2 = (lane & 4) != 0;
      float w8[8], w4[4], w2[2];
#pragma unroll
      for (int k = 0; k < 8; ++k) { const float send = b5 ? part[k] : part[k + 8], keep = b5 ? part[k + 8] : part[k]; w8[k] = keep + __shfl_xor(send, 32); }
#pragma unroll
      for (int k = 0; k < 4; ++k) { const float send = b4 ? w8[k] : w8[k + 4], keep = b4 ? w8[k + 4] : w8[k]; w4[k] = keep + __shfl_xor(send, 16); }
#pragma unroll
      for (int k = 0; k < 2; ++k) { const float send = b3 ? w4[k] : w4[k + 2], keep = b3 ? w4[k + 2] : w4[k]; w2[k] = keep + __shfl_xor(send, 8); }
      float w1;
      { const float send = b2 ? w2[0] : w2[1], keep = b2 ? w2[1] : w2[0]; w1 = keep + __shfl_xor(send, 4); }
      w1 += __shfl_xor(w1, 2);
      w1 += __shfl_xor(w1, 1);
      const int gidx = (b5 ? 8 : 0) + (b4 ? 4 : 0) + (b3 ? 2 : 0) + (b2 ? 1 : 0);
      if ((lane & 3) == 0) p.gates()[(size_t)row * 16 + gidx] = w1 + p.b_gates[ln * 16 + gidx];
    }
  }
  if (do_gates) __syncthreads();
}

#define PG8_LAS __attribute__((address_space(3)))
typedef unsigned u32x4 __attribute__((ext_vector_type(4)));
typedef unsigned u32x2 __attribute__((ext_vector_type(2)));
namespace pg8 {
constexpr int BM = 256, BK = 64, HALF = 128, HTB = HALF * BK * 2, NXCD = 8, WGM = 8;
DI int lds_byte(int r, int c) { const int st = (r >> 4) * 2 + (c >> 5), rr = r & 15, cc = c & 31, ob = rr * 64 + cc * 2; return st * 1024 + (ob ^ (((ob >> 9) & 1) << 5)); }
DI void stage_rc(int b, int& R, int& C) { const int st = b / 1024, sb = b % 1024, swz = sb ^ (((sb >> 9) & 1) << 5); R = (st >> 1) * 16 + swz / 64; C = (st & 1) * 32 + (swz % 64) / 2; }
DI int perm32(int rho) { const int n = rho >> 4, i = rho & 15; return 8 * (i >> 2) + 4 * n + (i & 3); }
struct Unit { int pm, pn; };
struct Gemm { const u16* A; const u16* Bt; int M, N, K; };
struct StaticOrder {
  int nM, nN, nwg, G, c;
  DI void init(int M, int N, int G_, int c_) { nM = M / BM; nN = N / BM; nwg = nM * nN; G = G_; c = c_; }
  DI bool next(int i, Unit& u) const {
    const long L = (long)i * G + c; if (L >= nwg) return false;
    int wgid = (int)L; { const int q = nwg / NXCD, r = nwg % NXCD, xcd = wgid % NXCD, off = wgid / NXCD; wgid = (xcd < r ? xcd * (q + 1) : r * (q + 1) + (xcd - r) * q) + off; }
    const int nig = WGM * nN, gid = wgid / nig, fm = gid * WGM, gsz = (nM - fm) < WGM ? (nM - fm) : WGM;
    u.pm = fm + ((wgid % nig) % gsz); u.pn = (wgid % nig) / gsz; return true;
  }
};
DI unsigned cvt_pk_bf16(float lo, float hi) { unsigned r; asm volatile("v_cvt_pk_bf16_f32 %0, %1, %2" : "=v"(r) : "v"(lo), "v"(hi)); return r; }

template <class Epi>
DI void gemm_phase(PG8_LAS unsigned char* lds, const Gemm g, const StaticOrder& S, const Epi& E) {
  int tid = threadIdx.x;
  asm volatile("" : "+v"(tid));
  const int wid = __builtin_amdgcn_readfirstlane(tid >> 6), lane = tid & 63, wr = wid >> 2, wc = wid & 3, fr = lane & 15, fq = lane >> 4;
  const int K = g.K, nt = K / BK;
  unsigned voffA[2], voffB[2];
#pragma unroll
  for (int i = 0; i < 2; ++i) { int R, C; stage_rc(tid * 16 + i * 8192, R, C); const int Rb = Epi::PERM ? ((R & ~31) + perm32(R & 31)) : R;
    voffA[i] = (unsigned)(R * K + C) * 2u; voffB[i] = (unsigned)(Rb * K + C) * 2u; }
  const size_t kstep = (size_t)(BK * 2);
  const size_t hstep = (size_t)HALF * K * 2;
  const size_t tstep = 2 * hstep;
  const unsigned ldsw = (unsigned)wid * 1024u;
  const int aoff = lds_byte(wr * 64 + fr, fq * 8), boff = lds_byte(wc * 32 + fr, fq * 8);
#define PG8_SA(b, h) (((b) * 2 + (h)) * HTB)
#define PG8_SB(b, h) ((4 + (b) * 2 + (h)) * HTB)
#define PG8_STAGE(bufoff, gbase, voff) do { _Pragma("unroll") for (int _i = 0; _i < 2; ++_i) \
    __builtin_amdgcn_global_load_lds((const unsigned*)((const char*)(gbase) + (voff)[_i]), (PG8_LAS unsigned*)(lds + (bufoff) + ldsw + _i * 8192), 16, 0, 0); } while (0)
#define PG8_LDA(dst, b, h) do { _Pragma("unroll") for (int m = 0; m < 4; ++m) _Pragma("unroll") for (int k = 0; k < 2; ++k) dst[m][k] = *(const PG8_LAS bf16x8*)(lds + PG8_SA(b, h) + aoff + m * 2048 + k * 1024); } while (0)
#define PG8_LDB(dst, b, h) do { _Pragma("unroll") for (int n = 0; n < 2; ++n) _Pragma("unroll") for (int k = 0; k < 2; ++k) dst[n][k] = *(const PG8_LAS bf16x8*)(lds + PG8_SB(b, h) + boff + n * 2048 + k * 1024); } while (0)
#define PG8_MMA(ai, bj, At, Bt) do { __builtin_amdgcn_s_setprio(1); _Pragma("unroll") for (int m = 0; m < 4; ++m) _Pragma("unroll") for (int n = 0; n < 2; ++n) _Pragma("unroll") for (int k = 0; k < 2; ++k) \
    acc[ai][bj][m][n] = __builtin_amdgcn_mfma_f32_16x16x32_bf16(Bt[n][k], At[m][k], acc[ai][bj][m][n], 0, 0, 0); __builtin_amdgcn_s_setprio(0); } while (0)
#define PG8_WAIT_V(n) asm volatile("s_waitcnt vmcnt(" #n ")" ::: "memory")
#define PG8_WAIT_L(n) asm volatile("s_waitcnt lgkmcnt(" #n ")" ::: "memory")
#define PG8_BAR __builtin_amdgcn_s_barrier()
#define PG8_SCHED __builtin_amdgcn_sched_barrier(0)
  Unit cur, nxt; int ui = 0;
  if (!S.next(0, cur)) return;
  f32x4 acc[2][2][4][2];
#pragma unroll
  for (int a = 0; a < 2; ++a)
#pragma unroll
    for (int b = 0; b < 2; ++b)
#pragma unroll
      for (int m = 0; m < 4; ++m)
#pragma unroll
        for (int n = 0; n < 2; ++n) acc[a][b][m][n] = (f32x4){0.f, 0.f, 0.f, 0.f};
  bf16x8 At[4][2], B0[2][2], B1[2][2];
  const char* cA = (const char*)g.A + (size_t)cur.pm * tstep; const char* cB = (const char*)g.Bt + (size_t)cur.pn * tstep;
  PG8_STAGE(PG8_SB(0, 0), cB, voffB); PG8_STAGE(PG8_SA(0, 0), cA, voffA); PG8_STAGE(PG8_SB(0, 1), cB + hstep, voffB); PG8_STAGE(PG8_SA(0, 1), cA + hstep, voffA);
  if (wr == 1) PG8_BAR;
  PG8_WAIT_V(4); PG8_BAR;
  PG8_STAGE(PG8_SB(1, 0), cB + kstep, voffB); PG8_STAGE(PG8_SA(1, 0), cA + kstep, voffA); PG8_STAGE(PG8_SB(1, 1), cB + hstep + kstep, voffB);
  PG8_WAIT_V(6); PG8_BAR;
  for (;;) {
    const bool has_next = S.next(ui + 1, nxt);
    const char* nA = has_next ? (const char*)g.A + (size_t)nxt.pm * tstep : cA; const char* nB = has_next ? (const char*)g.Bt + (size_t)nxt.pn * tstep : cB;
    for (int t = 0; t < nt; t += 2) {
      const bool last = (t == nt - 2);
      const char* a1 = cA + (size_t)(t + 1) * kstep;
      const char* a2 = last ? nA : cA + (size_t)(t + 2) * kstep; const char* b2 = last ? nB : cB + (size_t)(t + 2) * kstep;
      const char* a3 = a2 + kstep; const char* b3 = b2 + kstep;
      PG8_LDB(B0, 0, 0); PG8_SCHED; PG8_LDA(At, 0, 0); PG8_STAGE(PG8_SA(1, 1), a1 + hstep, voffA);
      PG8_WAIT_L(8); PG8_BAR; PG8_WAIT_L(0); PG8_MMA(0, 0, At, B0); PG8_BAR; PG8_SCHED;
      PG8_LDB(B1, 0, 1); PG8_STAGE(PG8_SB(0, 0), b2, voffB);
      PG8_BAR; PG8_WAIT_L(0); PG8_MMA(0, 1, At, B1); PG8_BAR;
      PG8_LDA(At, 0, 1); PG8_STAGE(PG8_SA(0, 0), a2, voffA);
      PG8_BAR; PG8_WAIT_L(0); PG8_MMA(1, 0, At, B0); PG8_BAR; PG8_SCHED;
      PG8_STAGE(PG8_SB(0, 1), b2 + hstep, voffB);
      PG8_WAIT_V(6); PG8_BAR; PG8_MMA(1, 1, At, B1); PG8_BAR;
      PG8_LDB(B0, 1, 0); PG8_SCHED; PG8_LDA(At, 1, 0); PG8_STAGE(PG8_SA(0, 1), a2 + hstep, voffA);
      PG8_WAIT_L(8); PG8_BAR; PG8_WAIT_L(0); PG8_MMA(0, 0, At, B0); PG8_BAR; PG8_SCHED;
      PG8_LDB(B1, 1, 1); PG8_STAGE(PG8_SB(1, 0), b3, voffB);
      PG8_BAR; PG8_WAIT_L(0); PG8_MMA(0, 1, At, B1); PG8_BAR;
      PG8_LDA(At, 1, 1); PG8_STAGE(PG8_SA(1, 0), a3, voffA);
      PG8_BAR; PG8_WAIT_L(0); PG8_MMA(1, 0, At, B0); PG8_BAR; PG8_SCHED;
      PG8_STAGE(PG8_SB(1, 1), b3 + hstep, voffB);
      PG8_WAIT_V(6); PG8_BAR; PG8_MMA(1, 1, At, B1); PG8_BAR;
    }
    E(acc, cur, wr, wc, fr, fq);
    if (!has_next) break;
#pragma unroll
    for (int a = 0; a < 2; ++a)
#pragma unroll
      for (int b = 0; b < 2; ++b)
#pragma unroll
        for (int m = 0; m < 4; ++m)
#pragma unroll
          for (int n = 0; n < 2; ++n) acc[a][b][m][n] = (f32x4){0.f, 0.f, 0.f, 0.f};
    cur = nxt; cA = nA; cB = nB; ++ui;
  }
  PG8_WAIT_V(0);
  if (wr == 0) PG8_BAR;
  PG8_BAR;
#undef PG8_SA
#undef PG8_SB
#undef PG8_STAGE
#undef PG8_LDA
#undef PG8_LDB
#undef PG8_MMA
#undef PG8_WAIT_V
#undef PG8_WAIT_L
#undef PG8_BAR
#undef PG8_SCHED
}
}

struct EpiO {
  static constexpr bool PERM = true;
  u16* C;
  DI void operator()(const f32x4 (&acc)[2][2][4][2], const pg8::Unit& u, int wr, int wc, int fr, int fq) const {
    const int row0 = u.pm * 256 + wr * 64 + fr, col0 = u.pn * 256 + wc * 32 + 8 * fq;
#pragma unroll
    for (int ai = 0; ai < 2; ++ai)
#pragma unroll
      for (int m = 0; m < 4; ++m) {
        u16* rowp = C + (unsigned)(row0 + ai * 128 + m * 16) * 1024u + (unsigned)col0;
#pragma unroll
        for (int bj = 0; bj < 2; ++bj) {
          const f32x4 v0 = acc[ai][bj][m][0], v1 = acc[ai][bj][m][1];
          u32x4 w; w.x = pg8::cvt_pk_bf16(v0[0], v0[1]); w.y = pg8::cvt_pk_bf16(v0[2], v0[3]); w.z = pg8::cvt_pk_bf16(v1[0], v1[1]); w.w = pg8::cvt_pk_bf16(v1[2], v1[3]);
          *(u32x4*)(rowp + bj * 128) = w;
        }
      }
  }
};

struct EpiGU {
  static constexpr bool PERM = true;
  u16* act;
  DI void operator()(const f32x4 (&acc)[2][2][4][2], const pg8::Unit& u, int wr, int wc, int fr, int fq) const {
    const int row0 = u.pm * 256 + wr * 64 + fr, col0 = u.pn * 128 + wc * 32 + 8 * fq;
#pragma unroll
    for (int ai = 0; ai < 2; ++ai)
#pragma unroll
      for (int m = 0; m < 4; ++m) {
        float r[8];
#pragma unroll
        for (int n = 0; n < 2; ++n)
#pragma unroll
          for (int j = 0; j < 4; ++j) {
            const float g = acc[ai][0][m][n][j], up = acc[ai][1][m][n][j];
            r[n * 4 + j] = g * __builtin_amdgcn_rcpf(1.f + __expf(-g)) * up;
          }
        u32x4 w; w.x = pg8::cvt_pk_bf16(r[0], r[1]); w.y = pg8::cvt_pk_bf16(r[2], r[3]); w.z = pg8::cvt_pk_bf16(r[4], r[5]); w.w = pg8::cvt_pk_bf16(r[6], r[7]);
        *(u32x4*)(act + (size_t)(row0 + ai * 128 + m * 16) * FF + col0) = w;
      }
  }
};

struct EpiIn {
  static constexpr bool PERM = false;
  const P* pp; int l;
  DI void operator()(const f32x4 (&acc)[2][2][4][2], const pg8::Unit& u, int wr, int wc, int fr, int fq) const {
    const P& p = *pp;
    const int c0 = u.pn * 256 + wc * 64;
    const int rb = u.pm * 256 + wr * 64 + fr;
    const bool prm = u.pm * 256 < TP;
    int region, hh;
    if (c0 < 256) { region = 0; hh = c0 >> 6; }
    else if (c0 < 512) { region = 1; hh = (c0 - 256) >> 6; }
    else if (c0 < 768) { region = 2; hh = (c0 - 512) >> 6; }
    else if (c0 < 1280) { region = 3; hh = (c0 - 768) >> 6; }
    else if (c0 < 1408) { region = 4; hh = (c0 - 1280) >> 6; }
    else if (c0 < 1536) { region = 5; hh = (c0 - 1408) >> 6; }
    else if (c0 < 1792) { region = 6; hh = (c0 - 1536) >> 6; }
    else if (c0 < 2048) { region = 7; hh = (c0 - 1792) >> 6; }
    else if (c0 < 2304) { region = 8; hh = (c0 - 2048) >> 6; }
    else { region = 9; hh = (c0 - 2304) >> 6; }
    const unsigned dl = fq * 4;
    if (region == 2 || region == 5 || region == 8 || region == 7) {
      u16* vt = region == 2 ? p.vt_na() : (region == 5 ? p.vt_gqa() : (region == 7 ? p.kt_ml() : p.vt_ml()));
      const int H = region == 5 ? 2 : 4;
      const float mul = region == 7 ? 0.125f : 1.f;
      const unsigned Tlen = prm ? 256u : 1024u;
#pragma unroll
      for (int ai = 0; ai < 2; ++ai)
#pragma unroll
        for (int m = 0; m < 4; ++m) {
          const int row = rb + ai * 128 + m * 16;
          unsigned vbase;
          if (prm) vbase = (unsigned)(((row >> 8) * H + hh) * 64) * 256u + (unsigned)(row & 255);
          else { const int r = row - TP; vbase = (unsigned)(16 * H * 64 * 256) + (unsigned)((((r >> 10) * H + hh) * 64)) * 1024u + (unsigned)(r & 1023); }
          u16* vp = vt + vbase + dl * Tlen;
#pragma unroll
          for (int bj = 0; bj < 2; ++bj)
#pragma unroll
            for (int n = 0; n < 2; ++n)
#pragma unroll
              for (int j = 0; j < 4; ++j) vp[(unsigned)(bj * 32 + n * 16 + j) * Tlen] = f2bf(acc[ai][bj][m][n][j] * mul);
        }
    }
    if (prm && (region == 1 || region == 2 || region == 5)) {
#pragma unroll
      for (int ai = 0; ai < 2; ++ai)
#pragma unroll
        for (int m = 0; m < 4; ++m) {
          const int row = rb + ai * 128 + m * 16, b = row >> 8, t = row & 255;
          unsigned base;
          if (region == 5) base = (unsigned)O_GQA + (unsigned)((((b * 4 + l) * 2 + 1) * 2 + hh) * 256 + t) * 64u;
          else base = (unsigned)O_NA + (unsigned)((((b * 4 + l) * 2 + (region == 2 ? 1 : 0)) * 4 + hh) * 256 + t) * 64u;
          float* op = p.out + base + dl;
#pragma unroll
          for (int bj = 0; bj < 2; ++bj)
#pragma unroll
            for (int n = 0; n < 2; ++n) *(f32x4*)(op + bj * 32 + n * 16) = acc[ai][bj][m][n];
        }
    }
    if (region == 2 || region == 5 || region == 8) return;
    if (region == 3 || region == 4) {
      const float* gq = p.g_qk + (l * 2 + (region == 4 ? 1 : 0)) * 64 + dl;
      f32x4 gv[2][2];
#pragma unroll
      for (int bj = 0; bj < 2; ++bj)
#pragma unroll
        for (int n = 0; n < 2; ++n) gv[bj][n] = *(const f32x4*)(gq + bj * 32 + n * 16);
#pragma unroll
      for (int ai = 0; ai < 2; ++ai)
#pragma unroll
        for (int m = 0; m < 4; ++m) {
          const int row = rb + ai * 128 + m * 16;
          f32x4 v[2][2];
          float ss = 0.f;
#pragma unroll
          for (int bj = 0; bj < 2; ++bj)
#pragma unroll
            for (int n = 0; n < 2; ++n) {
              v[bj][n] = acc[ai][bj][m][n];
#pragma unroll
              for (int j = 0; j < 4; ++j) ss += v[bj][n][j] * v[bj][n][j];
            }
          ss += __shfl_xor(ss, 16);
          ss += __shfl_xor(ss, 32);
          const float rs = rsqrtf(ss * (1.f / 64.f) + EPS);
#pragma unroll
          for (int bj = 0; bj < 2; ++bj)
#pragma unroll
            for (int n = 0; n < 2; ++n) v[bj][n] = v[bj][n] * rs * gv[bj][n];
          if (prm) {
            if (region == 4) {
              const int b = row >> 8, t = row & 255;
              float* op = p.out + (unsigned)O_GQA + (unsigned)((((b * 4 + l) * 2 + 0) * 2 + hh) * 256 + t) * 64u + dl;
#pragma unroll
              for (int bj = 0; bj < 2; ++bj)
#pragma unroll
                for (int n = 0; n < 2; ++n) *(f32x4*)(op + bj * 32 + n * 16) = v[bj][n];
            }
          } else {
            const int t = (row - TP) & 1023, pr = t >> 6, pc = t & 63;
#pragma unroll
            for (int bj = 0; bj < 2; ++bj) {
              const int pos = bj ? pc : pr;
              const f32x4 cs = *(const f32x4*)(p.rope() + pos * 16 + dl), sn = *(const f32x4*)(p.rope() + 1024 + pos * 16 + dl);
              const f32x4 x1 = v[bj][0], x2 = v[bj][1];
              v[bj][0] = x1 * cs - x2 * sn;
              v[bj][1] = x2 * cs + x1 * sn;
            }
          }
          u16* zp = p.zb() + (unsigned)row * (unsigned)ZW + (unsigned)c0 + dl;
#pragma unroll
          for (int bj = 0; bj < 2; ++bj)
#pragma unroll
            for (int n = 0; n < 2; ++n) {
              uint2 w; w.x = pg8::cvt_pk_bf16(v[bj][n][0], v[bj][n][1]); w.y = pg8::cvt_pk_bf16(v[bj][n][2], v[bj][n][3]);
              *(uint2*)(zp + bj * 32 + n * 16) = w;
            }
        }
      return;
    }
    {
      const float mul = region == 7 ? 0.125f : 1.f;
#pragma unroll
      for (int ai = 0; ai < 2; ++ai)
#pragma unroll
        for (int m = 0; m < 4; ++m) {
          const int row = rb + ai * 128 + m * 16;
          u16* zp = p.zb() + (unsigned)row * (unsigned)ZW + (unsigned)c0 + dl;
#pragma unroll
          for (int bj = 0; bj < 2; ++bj)
#pragma unroll
            for (int n = 0; n < 2; ++n) {
              const f32x4 v = acc[ai][bj][m][n] * mul;
              uint2 w; w.x = pg8::cvt_pk_bf16(v[0], v[1]); w.y = pg8::cvt_pk_bf16(v[2], v[3]);
              *(uint2*)(zp + bj * 32 + n * 16) = w;
            }
        }
    }
  }
};

DI void phase_gemm(const P& p, int which, int l, char* smem) {
  PG8_LAS unsigned char* lds = (PG8_LAS unsigned char*)smem;
  pg8::StaticOrder S;
  pg8::Gemm g;
  if (which == 0) {
    g.A = p.hn(); g.Bt = p.wt_in() + (size_t)l * ZW * 1024; g.M = TT; g.N = ZW; g.K = 1024;
    S.init(g.M, g.N, p.nblk, blockIdx.x);
    EpiIn E; E.pp = &p; E.l = l;
    pg8::gemm_phase(lds, g, S, E);
  } else if (which == 1) {
    g.A = p.mix(); g.Bt = p.wt_out() + (size_t)l * 1024 * 1024; g.M = TT; g.N = 1024; g.K = 1024;
    S.init(g.M, g.N, p.nblk, blockIdx.x);
    EpiO E; E.C = (u16*)p.obuf();
    pg8::gemm_phase(lds, g, S, E);
  } else if (which == 2) {
    g.A = p.hn(); g.Bt = p.wt_gu() + (size_t)l * 5632 * 1024; g.M = TT; g.N = 5632; g.K = 1024;
    S.init(g.M, g.N, p.nblk, blockIdx.x);
    EpiGU E; E.act = p.act();
    pg8::gemm_phase(lds, g, S, E);
  } else {
    g.A = p.act(); g.Bt = p.wt_down() + (size_t)l * 1024 * FF; g.M = TT; g.N = 1024; g.K = FF;
    S.init(g.M, g.N, p.nblk, blockIdx.x);
    EpiO E; E.C = (u16*)p.obuf();
    pg8::gemm_phase(lds, g, S, E);
  }
}

template <bool WIN>
DI void attn_seg(const u16* __restrict__ K, int ldk, const u16* __restrict__ V, int ldv, int nkeys, const bf16x8 (&qf)[4][2],
                 f32x4 (&o)[4][4], float (&m)[4], float (&lsum)[4], const float* __restrict__ bias, int rdelta, int fr, int fq) {
  const float L2E = 1.44269504f;
  for (int key0 = 0; key0 < nkeys; key0 += 32) {
    bf16x8 kf[2][2];
#pragma unroll
    for (int mt = 0; mt < 2; ++mt)
#pragma unroll
      for (int ks = 0; ks < 2; ++ks) kf[mt][ks] = ld8(K + (size_t)(key0 + mt * 16 + fr) * ldk + ks * 32 + fq * 8);
    bf16x8 va[4];
#pragma unroll
    for (int dt = 0; dt < 4; ++dt) {
      const u16* vp = V + (size_t)(dt * 16 + fr) * ldv + key0 + fq * 4;
      va[dt] = ld4x2(vp, vp + 16);
    }
    f32x4 s[2][4];
#pragma unroll
    for (int mt = 0; mt < 2; ++mt)
#pragma unroll
      for (int nt = 0; nt < 4; ++nt) {
        s[mt][nt] = zero4();
#pragma unroll
        for (int ks = 0; ks < 2; ++ks) s[mt][nt] = MFMA16(kf[mt][ks], qf[nt][ks], s[mt][nt]);
      }
    const float SC = 0.125f * L2E;
    if (WIN) {
      const int krel = key0 >> 6, ckb = key0 & 63;
      const float* brow = bias + (rdelta + krel) * 31;
#pragma unroll
      for (int nt = 0; nt < 4; ++nt) {
        const int cq = nt * 16 + fr;
        const int cw = min(max(cq - 8, 0), 48);
#pragma unroll
        for (int mt = 0; mt < 2; ++mt)
#pragma unroll
          for (int j = 0; j < 4; ++j) {
            const int ck = ckb + mt * 16 + fq * 4 + j;
            const bool valid = (ck >= cw) && (ck < cw + 16);
            const int dc = min(max(ck - cq, -15), 15) + 15;
            const float bv = brow[dc];
            s[mt][nt][j] = valid ? (s[mt][nt][j] + bv * 8.f) : -INFINITY;
          }
      }
    }
    bf16x8 pb[4];
    float tmx[4];
    bool grow = false;
#pragma unroll
    for (int nt = 0; nt < 4; ++nt) {
      float tm = fmaxf(fmaxf(fmaxf(s[0][nt][0], s[0][nt][1]), fmaxf(s[0][nt][2], s[0][nt][3])),
                       fmaxf(fmaxf(s[1][nt][0], s[1][nt][1]), fmaxf(s[1][nt][2], s[1][nt][3])));
      tm = fmaxf(tm, __shfl_xor(tm, 16));
      tm = fmaxf(tm, __shfl_xor(tm, 32));
      tm *= SC;
      tmx[nt] = tm;
      grow = grow || (tm > m[nt] + 11.5f);
    }
    if (__any(grow)) {
#pragma unroll
      for (int nt = 0; nt < 4; ++nt) {
        const float mn = fmaxf(m[nt], tmx[nt]);
        const float alpha = __builtin_amdgcn_exp2f(m[nt] - mn);
        m[nt] = mn;
        lsum[nt] *= alpha;
#pragma unroll
        for (int dt = 0; dt < 4; ++dt) o[dt][nt] *= alpha;
      }
    }
#pragma unroll
    for (int nt = 0; nt < 4; ++nt) {
      const float nm = -m[nt];
      float ps = 0.f;
#pragma unroll
      for (int mt = 0; mt < 2; ++mt)
#pragma unroll
        for (int j = 0; j < 4; ++j) { float pv = __builtin_amdgcn_exp2f(__builtin_fmaf(s[mt][nt][j], SC, nm)); s[mt][nt][j] = pv; ps += pv; }
      lsum[nt] += ps;
      pb[nt] = pack8(s[0][nt], s[1][nt]);
    }
#pragma unroll
    for (int dt = 0; dt < 4; ++dt)
#pragma unroll
      for (int nt = 0; nt < 4; ++nt) o[dt][nt] = MFMA16(va[dt], pb[nt], o[dt][nt]);
  }
}

template <bool WIN>
DI void attn_wave(const u16* Q, int ldq, const u16* K0, int ldk0, const u16* V0, int ldv0, int n0, const u16* K1, int ldk1,
                  const u16* V1, int ldv1, int n1, u16* O, int ldo, const float* bias, int rdelta, int lane) {
  const int fr = lane & 15, fq = lane >> 4;
  bf16x8 qf[4][2];
#pragma unroll
  for (int nt = 0; nt < 4; ++nt)
#pragma unroll
    for (int ks = 0; ks < 2; ++ks) qf[nt][ks] = ld8(Q + (size_t)(nt * 16 + fr) * ldq + ks * 32 + fq * 8);
  f32x4 o[4][4];
  float m[4], lsum[4];
#pragma unroll
  for (int i = 0; i < 4; ++i) {
    m[i] = -1e30f; lsum[i] = 0.f;
#pragma unroll
    for (int j = 0; j < 4; ++j) o[i][j] = zero4();
  }
  attn_seg<WIN>(K0, ldk0, V0, ldv0, n0, qf, o, m, lsum, bias, rdelta, fr, fq);
  if (n1 > 0) attn_seg<false>(K1, ldk1, V1, ldv1, n1, qf, o, m, lsum, bias, rdelta, fr, fq);
#pragma unroll
  for (int nt = 0; nt < 4; ++nt) {
    float lt = lsum[nt];
    lt += __shfl_xor(lt, 16);
    lt += __shfl_xor(lt, 32);
    const float inv = 1.f / lt;
#pragma unroll
    for (int dt = 0; dt < 4; ++dt) {
      uint2 w; w.x = pack2(o[dt][nt][0] * inv, o[dt][nt][1] * inv); w.y = pack2(o[dt][nt][2] * inv, o[dt][nt][3] * inv);
      *(uint2*)(O + (size_t)(nt * 16 + fr) * ldo + dt * 16 + fq * 4) = w;
    }
  }
}

template <bool WIN>
DI void attn_block(LAS unsigned char* lds, int tid, const u16* Q, int ldq,
                   const u16* K0, int ldk0, const u16* V0, int ldv0, int nt0,
                   const u16* K1, int ldk1, const u16* V1, int ldv1, int nt1,
                   u16* O, int ldo, const LAS float* bias, int rdelta, int wlo) {
  const int lane = tid & 63, fr = lane & 15, fq = lane >> 4;
  const int wid = __builtin_amdgcn_readfirstlane(tid >> 6);
  const float L2E = 1.44269504f, SC = 0.125f * L2E;
  bf16x8 qf[4][2];
#pragma unroll
  for (int nt = 0; nt < 4; ++nt)
#pragma unroll
    for (int ks = 0; ks < 2; ++ks) qf[nt][ks] = ld8(Q + (size_t)(nt * 16 + fr) * ldq + ks * 32 + fq * 8);
  f32x4 o[4][4];
  float m[4], lsum[4];
#pragma unroll
  for (int i = 0; i < 4; ++i) {
    m[i] = -1e30f; lsum[i] = 0.f;
#pragma unroll
    for (int j = 0; j < 4; ++j) o[i][j] = zero4();
  }
  const int ntl = nt0 + nt1;
  const int rr = tid >> 3, pp = tid & 7, part = pp ^ (rr & 7);
#define AB_ISSUE(t) do { const int _t = (t); const u16* _k; const u16* _v; \
    if (_t < nt0) { _k = K0 + (size_t)(_t * 64 + rr) * ldk0 + part * 8; _v = V0 + (size_t)rr * ldv0 + _t * 64 + part * 8; } \
    else { _k = K1 + (size_t)((_t - nt0) * 64 + rr) * ldk1 + part * 8; _v = V1 + (size_t)rr * ldv1 + (_t - nt0) * 64 + part * 8; } \
    LAS unsigned char* _s = lds + (_t & 3) * 16384 + wid * 1024; \
    __builtin_amdgcn_global_load_lds((const unsigned*)_k, (LAS unsigned*)_s, 16, 0, 0); \
    __builtin_amdgcn_global_load_lds((const unsigned*)_v, (LAS unsigned*)(_s + 8192), 16, 0, 0); } while (0)
  if (0 < ntl) AB_ISSUE(0);
  if (1 < ntl) AB_ISSUE(1);
  if (2 < ntl) AB_ISSUE(2);
  for (int t = 0; t < ntl; ++t) {
    const int rem = ntl - 1 - t;
    if (rem >= 2) asm volatile("s_waitcnt vmcnt(4)" ::: "memory");
    else if (rem == 1) asm volatile("s_waitcnt vmcnt(2)" ::: "memory");
    else asm volatile("s_waitcnt vmcnt(0)" ::: "memory");
    __builtin_amdgcn_s_barrier();
    asm volatile("" ::: "memory");
    if (t + 3 < ntl) AB_ISSUE(t + 3);
    const bool win_tile = WIN && (t < nt0);
    if (win_tile && (t < wlo || t >= wlo + 8)) continue;
    const LAS unsigned char* sk = lds + (t & 3) * 16384;
    const LAS unsigned char* sv = sk + 8192;
    f32x4 s[2][2][4];
#pragma unroll
    for (int sub = 0; sub < 2; ++sub) {
      bf16x8 kf[2][2];
#pragma unroll
      for (int mt = 0; mt < 2; ++mt)
#pragma unroll
        for (int ks = 0; ks < 2; ++ks) {
          const int key = sub * 32 + mt * 16 + fr;
          kf[mt][ks] = *(const LAS bf16x8*)(sk + key * 128 + (((ks * 4 + fq) ^ (key & 7)) << 4));
        }
#pragma unroll
      for (int mt = 0; mt < 2; ++mt)
#pragma unroll
        for (int nt = 0; nt < 4; ++nt) {
          s[sub][mt][nt] = zero4();
#pragma unroll
          for (int ks = 0; ks < 2; ++ks) s[sub][mt][nt] = MFMA16(kf[mt][ks], qf[nt][ks], s[sub][mt][nt]);
        }
    }
    if (win_tile) {
      const LAS float* brow = bias + (rdelta + (t - wlo)) * 31;
#pragma unroll
      for (int sub = 0; sub < 2; ++sub)
#pragma unroll
        for (int nt = 0; nt < 4; ++nt) {
          const int cq = nt * 16 + fr;
          const int cw = min(max(cq - 8, 0), 48);
#pragma unroll
          for (int mt = 0; mt < 2; ++mt)
#pragma unroll
            for (int j = 0; j < 4; ++j) {
              const int ck = sub * 32 + mt * 16 + fq * 4 + j;
              const bool valid = (ck >= cw) && (ck < cw + 16);
              const int dc = min(max(ck - cq, -15), 15) + 15;
              const float bv = brow[dc];
              s[sub][mt][nt][j] = valid ? (s[sub][mt][nt][j] + bv * 8.f) : -INFINITY;
            }
        }
    }
    float tmx[4];
    bool grow = false;
#pragma unroll
    for (int nt = 0; nt < 4; ++nt) {
      float tm = -INFINITY;
#pragma unroll
      for (int sub = 0; sub < 2; ++sub)
#pragma unroll
        for (int mt = 0; mt < 2; ++mt)
          tm = fmaxf(tm, fmaxf(fmaxf(s[sub][mt][nt][0], s[sub][mt][nt][1]), fmaxf(s[sub][mt][nt][2], s[sub][mt][nt][3])));
      tm = fmaxf(tm, __shfl_xor(tm, 16));
      tm = fmaxf(tm, __shfl_xor(tm, 32));
      tm *= SC;
      tmx[nt] = tm;
      grow = grow || (tm > m[nt] + 11.5f);
    }
    if (__any(grow)) {
#pragma unroll
      for (int nt = 0; nt < 4; ++nt) {
        const float mn = fmaxf(m[nt], tmx[nt]);
        const float alpha = __builtin_amdgcn_exp2f(m[nt] - mn);
        m[nt] = mn;
        lsum[nt] *= alpha;
#pragma unroll
        for (int dt = 0; dt < 4; ++dt) o[dt][nt] *= alpha;
      }
    }
#pragma unroll
    for (int sub = 0; sub < 2; ++sub) {
      bf16x8 pb[4];
#pragma unroll
      for (int nt = 0; nt < 4; ++nt) {
        const float nm = -m[nt];
        float ps = 0.f;
#pragma unroll
        for (int mt = 0; mt < 2; ++mt)
#pragma unroll
          for (int j = 0; j < 4; ++j) { float pv = __builtin_amdgcn_exp2f(__builtin_fmaf(s[sub][mt][nt][j], SC, nm)); s[sub][mt][nt][j] = pv; ps += pv; }
        lsum[nt] += ps;
        pb[nt] = pack8(s[sub][0][nt], s[sub][1][nt]);
      }
      bf16x8 va[4];
#pragma unroll
      for (int dt = 0; dt < 4; ++dt) {
        const int d = dt * 16 + fr, q1 = sub * 4 + (fq >> 1);
        const u32x2 a = *(const LAS u32x2*)(sv + d * 128 + ((q1 ^ (d & 7)) << 4) + (fq & 1) * 8);
        const u32x2 b = *(const LAS u32x2*)(sv + d * 128 + (((q1 + 2) ^ (d & 7)) << 4) + (fq & 1) * 8);
        u32x4 r4; r4.x = a.x; r4.y = a.y; r4.z = b.x; r4.w = b.y;
        va[dt] = __builtin_bit_cast(bf16x8, r4);
      }
#pragma unroll
      for (int dt = 0; dt < 4; ++dt)
#pragma unroll
        for (int nt = 0; nt < 4; ++nt) o[dt][nt] = MFMA16(va[dt], pb[nt], o[dt][nt]);
    }
  }
#undef AB_ISSUE
#pragma unroll
  for (int nt = 0; nt < 4; ++nt) {
    float lt = lsum[nt];
    lt += __shfl_xor(lt, 16);
    lt += __shfl_xor(lt, 32);
    const float inv = 1.f / lt;
#pragma unroll
    for (int dt = 0; dt < 4; ++dt) {
      uint2 w; w.x = pack2(o[dt][nt][0] * inv, o[dt][nt][1] * inv); w.y = pack2(o[dt][nt][2] * inv, o[dt][nt][3] * inv);
      *(uint2*)(O + (size_t)(nt * 16 + fr) * ldo + dt * 16 + fq * 4) = w;
    }
  }
}

DI float logsig(float x) { return fminf(x, 0.f) - __logf(1.f + __expf(-fabsf(x))); }

DI void mlstm_item(const P& p, int l, int u, char* smem, int tid, int stages, int cdbase, int ugrp) {
  const int wid = tid >> 6;
  const bool samp = u < 32;
  int b, h, NC, rowbase, ldT, cs0;
  size_t tb;
  if (samp) { b = u >> 2; h = u & 3; NC = 16; rowbase = TP + b * 1024; ldT = 1024; tb = 1048576 + (size_t)((b * 4 + h) * 64) * 1024; cs0 = u * 32; }
  else { int v = u - 32; b = v >> 2; h = v & 3; NC = 4; rowbase = b * 256; ldT = 256; tb = (size_t)((b * 4 + h) * 64) * 256; cs0 = 1024 + v * 8; }
  float* fl = (float*)smem + wid * 768;
  float* W = fl;
  float* U = fl + 64;
  float* MX = fl + 192;
  float* DEC = fl + 320;
  float* EN = fl + 448;
  float* NQ = fl + 576;

  if (stages & 1)
  for (int cd = cdbase + wid; cd < NC * 2 && cd < cdbase + 8; cd += 8) {
    int lane = tid & 63;
    asm volatile("" : "+v"(lane));
    const int fr = lane & 15, fq = lane >> 4;
    const int j = cd >> 1, dir = cd & 1;
    const int cs = cs0 + dir * NC + j;
    const int row = rowbase + j * 64 + lane;
    const float gi = p.gates()[(size_t)row * 16 + dir * 8 + h], gf = p.gates()[(size_t)row * 16 + dir * 8 + 4 + h];
    float bb = logsig(gf);
    if (dir == 0) {
#pragma unroll
      for (int off = 1; off < 64; off <<= 1) { float t = __shfl_up(bb, off); if (lane >= off) bb += t; }
    } else {
#pragma unroll
      for (int off = 1; off < 64; off <<= 1) { float t = __shfl_down(bb, off); if (lane + off < 64) bb += t; }
    }
    const float bend = __shfl(bb, dir ? 0 : 63);
    const float lw = bend - bb + gi;
    const float a = wave_max(lw);
    W[lane] = __expf(lw - a);
    wave_sync();
    f32x4 acc[4][4];
#pragma unroll
    for (int i = 0; i < 4; ++i)
#pragma unroll
      for (int jj = 0; jj < 4; ++jj) acc[i][jj] = zero4();
    const u16* vt = p.vt_ml() + tb + j * 64;
    const u16* kt = p.kt_ml() + tb + j * 64;
#pragma unroll 1
    for (int ks = 0; ks < 2; ++ks) {
      const float4 w0 = *(const float4*)(W + ks * 32 + fq * 8), w1 = *(const float4*)(W + ks * 32 + fq * 8 + 4);
      bf16x8 af[4], bfr[4];
#pragma unroll
      for (int mt = 0; mt < 4; ++mt) {
        bf16x8 raw = ld8(vt + (size_t)(mt * 16 + fr) * ldT + ks * 32 + fq * 8);
        f32x4 lo, hi;
        lo[0] = bf2f((u16)raw[0]) * w0.x; lo[1] = bf2f((u16)raw[1]) * w0.y; lo[2] = bf2f((u16)raw[2]) * w0.z; lo[3] = bf2f((u16)raw[3]) * w0.w;
        hi[0] = bf2f((u16)raw[4]) * w1.x; hi[1] = bf2f((u16)raw[5]) * w1.y; hi[2] = bf2f((u16)raw[6]) * w1.z; hi[3] = bf2f((u16)raw[7]) * w1.w;
        af[mt] = pack8(lo, hi);
      }
#pragma unroll
      for (int nt = 0; nt < 4; ++nt) bfr[nt] = ld8(kt + (size_t)(nt * 16 + fr) * ldT + ks * 32 + fq * 8);
#pragma unroll
      for (int mt = 0; mt < 4; ++mt)
#pragma unroll
        for (int nt = 0; nt < 4; ++nt) acc[mt][nt] = MFMA16(af[mt], bfr[nt], acc[mt][nt]);
    }
    float* ch = p.ml_chat() + (size_t)cs * 4096;
#pragma unroll
    for (int mt = 0; mt < 4; ++mt)
#pragma unroll
      for (int nt = 0; nt < 4; ++nt)
#pragma unroll
        for (int jj = 0; jj < 4; ++jj) ch[(mt * 16 + fq * 4 + jj) * 64 + nt * 16 + fr] = acc[mt][nt][jj];
    float nh = 0.f;
    const u16* kr = kt + (size_t)lane * ldT;
#pragma unroll 1
    for (int c8 = 0; c8 < 8; ++c8) {
      bf16x8 kk = ld8(kr + c8 * 8);
      const float4 wa = *(const float4*)(W + c8 * 8), wb = *(const float4*)(W + c8 * 8 + 4);
      nh += bf2f((u16)kk[0]) * wa.x + bf2f((u16)kk[1]) * wa.y + bf2f((u16)kk[2]) * wa.z + bf2f((u16)kk[3]) * wa.w;
      nh += bf2f((u16)kk[4]) * wb.x + bf2f((u16)kk[5]) * wb.y + bf2f((u16)kk[6]) * wb.z + bf2f((u16)kk[7]) * wb.w;
    }
    p.ml_nhat()[(size_t)cs * 64 + lane] = nh;
    if (lane == 0) { p.ml_ab()[cs * 2] = a; p.ml_ab()[cs * 2 + 1] = bend; }
    wave_sync();
  }
  __syncthreads();

  if (stages & 2) {
    const int dir = tid >> 8, tt = tid & 255, e0 = tt * 16;
    float C[16];
    float n = 0.f, m = 0.f;
    const int sidx = ((b * 4 + l) * 2 + dir) * 4 + h;
    if (samp) {
#pragma unroll
      for (int i = 0; i < 4; ++i) {
        float4 v = *(const float4*)(p.stC + (size_t)sidx * 4096 + e0 + i * 4);
        C[i * 4] = v.x; C[i * 4 + 1] = v.y; C[i * 4 + 2] = v.z; C[i * 4 + 3] = v.w;
      }
      if (tt < 64) n = p.stn[sidx * 64 + tt];
      m = p.stm[sidx];
    } else {
#pragma unroll
      for (int i = 0; i < 16; ++i) { float z = 0.f; asm volatile("" : "+v"(z)); C[i] = z; }
    }
    for (int c4 = 0; c4 < NC; c4 += 4) {
      float4 chv[4][4];
      float av[4], bev[4], nhv[4];
#pragma unroll
      for (int q = 0; q < 4; ++q) {
        const int c = c4 + q, j = dir ? NC - 1 - c : c, cs = cs0 + dir * NC + j;
        av[q] = p.ml_ab()[cs * 2]; bev[q] = p.ml_ab()[cs * 2 + 1];
        nhv[q] = tt < 64 ? p.ml_nhat()[(size_t)cs * 64 + tt] : 0.f;
        const float* ch = p.ml_chat() + (size_t)cs * 4096 + e0;
#pragma unroll
        for (int i = 0; i < 4; ++i) chv[q][i] = *(const float4*)(ch + i * 4);
      }
#pragma unroll
      for (int q = 0; q < 4; ++q) {
        const int c = c4 + q, j = dir ? NC - 1 - c : c, cs = cs0 + dir * NC + j;
        uint4 w0, w1;
        w0.x = pack2(C[0], C[1]); w0.y = pack2(C[2], C[3]); w0.z = pack2(C[4], C[5]); w0.w = pack2(C[6], C[7]);
        w1.x = pack2(C[8], C[9]); w1.y = pack2(C[10], C[11]); w1.z = pack2(C[12], C[13]); w1.w = pack2(C[14], C[15]);
        *(uint4*)(p.ml_cst() + (size_t)cs * 4096 + e0) = w0;
        *(uint4*)(p.ml_cst() + (size_t)cs * 4096 + e0 + 8) = w1;
        if (tt < 64) p.ml_nst()[(size_t)cs * 64 + tt] = n;
        if (tt == 0) p.ml_mst()[cs] = m;
        const float mn = fmaxf(bev[q] + m, av[q]);
        const float carry = __expf(bev[q] + m - mn), beta = __expf(av[q] - mn);
#pragma unroll
        for (int i = 0; i < 4; ++i) {
          C[i * 4] = carry * C[i * 4] + beta * chv[q][i].x; C[i * 4 + 1] = carry * C[i * 4 + 1] + beta * chv[q][i].y;
          C[i * 4 + 2] = carry * C[i * 4 + 2] + beta * chv[q][i].z; C[i * 4 + 3] = carry * C[i * 4 + 3] + beta * chv[q][i].w;
        }
        n = carry * n + beta * nhv[q];
        m = mn;
      }
    }
    if (!samp) {
      float* oc = p.out + O_C + (size_t)sidx * 4096 + e0;
#pragma unroll
      for (int i = 0; i < 4; ++i) { float4 v; v.x = C[i * 4]; v.y = C[i * 4 + 1]; v.z = C[i * 4 + 2]; v.w = C[i * 4 + 3]; *(float4*)(oc + i * 4) = v; }
      if (tt < 64) p.out[O_N + (size_t)sidx * 64 + tt] = n;
      if (tt == 0) p.out[O_M + sidx] = m;
    }
  }
  __syncthreads();

  if (stages & 4)
  for (int uu = ugrp * 8 + wid; uu < NC * 2 && uu < ugrp * 8 + 8; uu += 8) {
    const int j = uu >> 1, half0 = uu & 1;
    int lane = tid & 63;
    asm volatile("" : "+v"(lane));
    const int fr = lane & 15, fq = lane >> 4;
    const int row = rowbase + j * 64 + lane;
    for (int dir = 0; dir < 2; ++dir) {
      const int cs = cs0 + dir * NC + j;
      const float m0 = p.ml_mst()[cs];
      const float gi = p.gates()[(size_t)row * 16 + dir * 8 + h], gf = p.gates()[(size_t)row * 16 + dir * 8 + 4 + h];
      float bb = logsig(gf);
      if (dir == 0) {
#pragma unroll
        for (int off = 1; off < 64; off <<= 1) { float t = __shfl_up(bb, off); if (lane >= off) bb += t; }
      } else {
#pragma unroll
        for (int off = 1; off < 64; off <<= 1) { float t = __shfl_down(bb, off); if (lane + off < 64) bb += t; }
      }
      const float uu = gi - bb;
      float cm = uu;
      if (dir == 0) {
#pragma unroll
        for (int off = 1; off < 64; off <<= 1) { float t = __shfl_up(cm, off); if (lane >= off) cm = fmaxf(cm, t); }
      } else {
#pragma unroll
        for (int off = 1; off < 64; off <<= 1) { float t = __shfl_down(cm, off); if (lane + off < 64) cm = fmaxf(cm, t); }
      }
      const float M = fmaxf(cm, m0);
      U[dir * 64 + lane] = uu;
      MX[dir * 64 + lane] = M;
      DEC[dir * 64 + lane] = __expf(m0 - M);
      EN[dir * 64 + lane] = __expf(-(bb + M));
      const u16* qr = p.zb() + (size_t)row * ZW + 1536 + h * 64;
      const float* ns = p.ml_nst() + (size_t)cs * 64;
      float nq = 0.f;
#pragma unroll
      for (int c8 = 0; c8 < 8; ++c8) {
        bf16x8 qq = ld8(qr + c8 * 8);
#pragma unroll
        for (int jj = 0; jj < 8; ++jj) nq += bf2f((u16)qq[jj]) * ns[c8 * 8 + jj];
      }
      NQ[dir * 64 + lane] = nq;
    }
    wave_sync();
#pragma unroll 1
    for (int half = half0; half < half0 + 1; ++half) {
      int lane_h = lane;
      asm volatile("" : "+v"(lane_h));
      const int fr = lane_h & 15, fq = lane_h >> 4;
      bf16x8 qf[2][2];
#pragma unroll
      for (int nt = 0; nt < 2; ++nt)
#pragma unroll
        for (int ks = 0; ks < 2; ++ks)
          qf[nt][ks] = ld8(p.zb() + (size_t)(rowbase + j * 64 + half * 32 + nt * 16 + fr) * ZW + 1536 + h * 64 + ks * 32 + fq * 8);
      f32x4 hs[4][2];
#pragma unroll
      for (int i = 0; i < 4; ++i) { hs[i][0] = zero4(); hs[i][1] = zero4(); }
#pragma unroll 1
      for (int dir = 0; dir < 2; ++dir) {
        const int cs = cs0 + dir * NC + j;
        f32x4 acc[4][2];
#pragma unroll
        for (int i = 0; i < 4; ++i) { acc[i][0] = zero4(); acc[i][1] = zero4(); }
        const u16* cst = p.ml_cst() + (size_t)cs * 4096;
#pragma unroll
        for (int ks = 0; ks < 2; ++ks)
#pragma unroll
          for (int dt = 0; dt < 4; ++dt) {
            bf16x8 cf = ld8(cst + (dt * 16 + fr) * 64 + ks * 32 + fq * 8);
#pragma unroll
            for (int nt = 0; nt < 2; ++nt) acc[dt][nt] = MFMA16(cf, qf[nt][ks], acc[dt][nt]);
          }
        float dec[2], Mt[2], dsum[2];
#pragma unroll
        for (int nt = 0; nt < 2; ++nt) {
          const int t = half * 32 + nt * 16 + fr;
          dec[nt] = DEC[dir * 64 + t]; Mt[nt] = MX[dir * 64 + t]; dsum[nt] = 0.f;
#pragma unroll
          for (int dt = 0; dt < 4; ++dt) acc[dt][nt] *= dec[nt];
        }
#pragma unroll 1
        for (int sk = 0; sk < 2; ++sk) {
          bf16x8 kf[2][2];
#pragma unroll
          for (int mt = 0; mt < 2; ++mt)
#pragma unroll
            for (int ks = 0; ks < 2; ++ks)
              kf[mt][ks] = ld8(p.zb() + (size_t)(rowbase + j * 64 + sk * 32 + mt * 16 + fr) * ZW + 1792 + h * 64 + ks * 32 + fq * 8);
          f32x4 s[2][2];
#pragma unroll
          for (int mt = 0; mt < 2; ++mt)
#pragma unroll
            for (int nt = 0; nt < 2; ++nt) {
              s[mt][nt] = zero4();
#pragma unroll
              for (int ks = 0; ks < 2; ++ks) s[mt][nt] = MFMA16(kf[mt][ks], qf[nt][ks], s[mt][nt]);
            }
#pragma unroll
          for (int mt = 0; mt < 2; ++mt) {
            const float4 u4 = *(const float4*)(U + dir * 64 + sk * 32 + mt * 16 + fq * 4);
            const float uv[4] = {u4.x, u4.y, u4.z, u4.w};
#pragma unroll
            for (int jj = 0; jj < 4; ++jj) {
              const int stok = sk * 32 + mt * 16 + fq * 4 + jj;
#pragma unroll
              for (int nt = 0; nt < 2; ++nt) {
                const int t = half * 32 + nt * 16 + fr;
                const bool valid = dir ? (stok >= t) : (stok <= t);
                const float w = valid ? __expf(uv[jj] - Mt[nt]) : 0.f;
                const float pv = s[mt][nt][jj] * w;
                s[mt][nt][jj] = pv;
                dsum[nt] += pv;
              }
            }
          }
          bf16x8 pb[2];
#pragma unroll
          for (int nt = 0; nt < 2; ++nt) pb[nt] = pack8(s[0][nt], s[1][nt]);
#pragma unroll
          for (int dt = 0; dt < 4; ++dt) {
            const u16* vp = p.vt_ml() + tb + (size_t)(dt * 16 + fr) * ldT + j * 64 + sk * 32 + fq * 4;
            bf16x8 va = ld4x2(vp, vp + 16);
#pragma unroll
            for (int nt = 0; nt < 2; ++nt) acc[dt][nt] = MFMA16(va, pb[nt], acc[dt][nt]);
          }
        }
#pragma unroll
        for (int nt = 0; nt < 2; ++nt) {
          const int t = half * 32 + nt * 16 + fr;
          float ds = dsum[nt];
          ds += __shfl_xor(ds, 16);
          ds += __shfl_xor(ds, 32);
          const float den = ds + dec[nt] * NQ[dir * 64 + t];
          const float dv = 1.f / fmaxf(fabsf(den), EN[dir * 64 + t]);
#pragma unroll
          for (int dt = 0; dt < 4; ++dt) hs[dt][nt] += acc[dt][nt] * dv;
        }
      }
#pragma unroll
      for (int nt = 0; nt < 2; ++nt) {
        float ss = 0.f;
#pragma unroll
        for (int dt = 0; dt < 4; ++dt)
#pragma unroll
          for (int jj = 0; jj < 4; ++jj) ss += hs[dt][nt][jj] * hs[dt][nt][jj];
        ss += __shfl_xor(ss, 16);
        ss += __shfl_xor(ss, 32);
        const float rs = rsqrtf(ss * (1.f / 64.f) + EPS);
        const int orow = rowbase + j * 64 + half * 32 + nt * 16 + fr;
#pragma unroll
        for (int dt = 0; dt < 4; ++dt) {
          const int v0 = dt * 16 + fq * 4;
          const float4 gn = *(const float4*)(p.g_ml + l * 256 + h * 64 + v0);
          const uint2 mo = *(const uint2*)(p.zb() + (size_t)orow * ZW + 2304 + h * 64 + v0);
          const float o0 = bf2f((u16)(mo.x & 0xffff)), o1 = bf2f((u16)(mo.x >> 16)), o2 = bf2f((u16)(mo.y & 0xffff)), o3 = bf2f((u16)(mo.y >> 16));
          const float r0 = hs[dt][nt][0] * rs * gn.x / (1.f + __expf(-o0));
          const float r1 = hs[dt][nt][1] * rs * gn.y / (1.f + __expf(-o1));
          const float r2 = hs[dt][nt][2] * rs * gn.z / (1.f + __expf(-o2));
          const float r3 = hs[dt][nt][3] * rs * gn.w / (1.f + __expf(-o3));
          uint2 w; w.x = pack2(r0, r1); w.y = pack2(r2, r3);
          *(uint2*)(p.mix() + (size_t)orow * 1024 + 768 + h * 64 + v0) = w;
        }
      }
    }
    wave_sync();
  }
  __syncthreads();
}

#define QCTR_BASE XCD_BAR_WORDS
#define BAR_TOTAL_WORDS (XCD_BAR_WORDS + 4 * 64)
DI void phase_mix(const P& p, int l, char* smem, int tid0) {
  volatile LAS int* sit = (volatile LAS int*)((LAS char*)smem + STAGE_LDS + 64);
  for (;;) {
    __syncthreads();
    if (tid0 == 0) *sit = (int)atomicAdd(&p.bar()[QCTR_BASE + l * 64], 1u);
    __syncthreads();
    const int it = *sit;
    if (it >= 480) break;
    int tv = tid0;
    asm volatile("" : "+v"(tv));
    const int wid = tv >> 6, lane = tv & 63;
    if (it >= 192 && it < 320) {
      mlstm_item(p, l, (it - 192) >> 2, smem, tv, 6, 0, (it - 192) & 3);
    } else if (it < 128) {
      const int x = it, b = x >> 4, kvh = (x >> 3) & 1, qt = (x & 7) * 2 + (wid >> 2), head = kvh * 4 + (wid & 3);
      const int rowbase = TP + b * 1024;
      const int ci = (b * 4 + l) * 2 + kvh;
      attn_block<false>((LAS unsigned char*)smem, tv, p.zb() + (size_t)(rowbase + qt * 64) * ZW + 768 + head * 64, ZW,
                        p.zb() + (size_t)rowbase * ZW + 1280 + kvh * 64, ZW, p.vt_gqa() + 524288 + (size_t)((b * 2 + kvh) * 64) * 1024, 1024, 16,
                        p.kc_gqa() + (size_t)ci * 16384, 64, p.vct_gqa() + (size_t)ci * 16384, 256, 4,
                        p.mix() + (size_t)(rowbase + qt * 64) * 1024 + 256 + head * 64, 1024, nullptr, 0, 0);
    } else if (it < 192) {
      const int x = it - 128, b = x >> 3, h = (x >> 1) & 3, rg = x & 1, r = rg * 8 + wid;
      const int rowbase = TP + b * 1024;
      const int r0 = min(max(r - 4, 0), 8);
      const int ulo = rg ? 4 : 0, nt0 = rg ? 12 : 11;
      const int ci = (b * 4 + l) * 4 + h;
      LAS float* btab = (LAS float*)((LAS char*)smem + 65536);
      for (int i = tv; i < 15 * 31; i += NTHR) btab[i] = p.na_bias[(size_t)(l * 4 + h) * 15 * 31 + i];
      __syncthreads();
      attn_block<true>((LAS unsigned char*)smem, tv, p.zb() + (size_t)(rowbase + r * 64) * ZW + h * 64, ZW,
                       p.zb() + (size_t)(rowbase + ulo * 64) * ZW + 256 + h * 64, ZW, p.vt_na() + 1048576 + (size_t)((b * 4 + h) * 64) * 1024 + ulo * 64, 1024, nt0,
                       p.kc_na() + (size_t)ci * 16384, 64, p.vct_na() + (size_t)ci * 16384, 256, 4,
                       p.mix() + (size_t)(rowbase + r * 64) * 1024 + h * 64, 1024, btab, r0 - r + 7, r0 - ulo);
    } else if (it < 384) {
      mlstm_item(p, l, 32 + (it - 320), smem, tv, 6, 0, 0);
    } else if (it < 448) {
      const int x = it - 384, b = x >> 2, kvh = (x >> 1) & 1, qt = (x & 1) * 2 + (wid >> 2), head = kvh * 4 + (wid & 3);
      const int rowbase = b * 256;
      attn_block<false>((LAS unsigned char*)smem, tv, p.zb() + (size_t)(rowbase + qt * 64) * ZW + 768 + head * 64, ZW,
                        p.zb() + (size_t)rowbase * ZW + 1280 + kvh * 64, ZW, p.vt_gqa() + (size_t)((b * 2 + kvh) * 64) * 256, 256, 4,
                        nullptr, 0, nullptr, 0, 0,
                        p.mix() + (size_t)(rowbase + qt * 64) * 1024 + 256 + head * 64, 1024, nullptr, 0, 0);
    } else {
      const int x = it - 448, b = x >> 1, h = (x & 1) * 2 + (wid >> 2), qt = wid & 3;
      const int rowbase = b * 256;
      attn_wave<false>(p.zb() + (size_t)(rowbase + qt * 64) * ZW + h * 64, ZW,
                       p.zb() + (size_t)rowbase * ZW + 256 + h * 64, ZW, p.vt_na() + (size_t)((b * 4 + h) * 64) * 256, 256, 256,
                       nullptr, 0, nullptr, 0, 0,
                       p.mix() + (size_t)(rowbase + qt * 64) * 1024 + h * 64, 1024, nullptr, 0, lane);
    }
  }
}

DI void phase_ml1(const P& p, int l, char* smem, int tid0) {
  for (int bi = blockIdx.x; bi < 192; bi += p.nblk) {
    int tv = tid0;
    asm volatile("" : "+v"(tv));
    if (bi < 128) mlstm_item(p, l, bi >> 2, smem, tv, 1, (bi & 3) * 8, 0);
    else mlstm_item(p, l, 32 + (bi - 128), smem, tv, 1, 0, 0);
  }
}

DI void run_phase(const P& p, int ph, int l, char* smem) {
  int tid = threadIdx.x;
  asm volatile("" : "+v"(tid));
  switch (ph) {
    case 0: phase_init(p, smem, tid); break;
    case 1: phase_row(p, 0, 0, smem, tid); break;
    case 2: phase_gemm(p, 0, l, smem); break;
    case 3: phase_ml1(p, l, smem, tid); break;
    case 4: phase_mix(p, l, smem, tid); break;
    case 5: phase_gemm(p, 1, l, smem); break;
    case 6: phase_row(p, 1, l, smem, tid); break;
    case 7: phase_gemm(p, 2, l, smem); break;
    case 8: phase_gemm(p, 3, l, smem); break;
    default: phase_row(p, 2, l, smem, tid); break;
  }
}

#if !ONE_LAUNCH
__global__ void __launch_bounds__(512, 2) k_phase(P p, int ph, int l) {
  extern __shared__ __attribute__((aligned(16))) char smem[];
  run_phase(p, ph, l, smem);
}
#else
__global__ void __launch_bounds__(512, 2) k_mega(P p) {
  extern __shared__ __attribute__((aligned(16))) char smem[];
  uint4* xbw = (uint4*)(smem + STAGE_LDS);
  if (threadIdx.x == 0) *xbw = make_uint4(0u, 0u, 0u, 0u);
  __syncthreads();
  XcdBarrier xb = xcd_barrier_post(p.bar(), (volatile LAS unsigned*)xbw, (unsigned)p.nblk);
#if TPROBE
  unsigned long long* ts = (unsigned long long*)(p.bar() + BAR_TOTAL_WORDS);
  const bool rec = blockIdx.x == 0 && threadIdx.x == 0;
  if (rec) ts[0] = __builtin_amdgcn_s_memrealtime();
#endif
  run_phase(p, 0, 0, smem);
  xcd_barrier(xb);
#if TPROBE
  if (rec) ts[1] = __builtin_amdgcn_s_memrealtime();
#endif
  run_phase(p, 1, 0, smem);
#if TPROBE
#define TSREC(ph) if (rec) ts[2 + l * 8 + ((ph) - 2)] = __builtin_amdgcn_s_memrealtime();
#else
#define TSREC(ph)
#endif
#pragma unroll 1
  for (int l = 0; l < 4; ++l) {
    xcd_barrier(xb); TSREC(2) run_phase(p, 2, l, smem);
    xcd_barrier(xb); TSREC(3) run_phase(p, 3, l, smem);
    xcd_barrier(xb); TSREC(4) run_phase(p, 4, l, smem);
    xcd_barrier(xb); TSREC(5) run_phase(p, 5, l, smem);
    xcd_barrier(xb); TSREC(6) run_phase(p, 6, l, smem);
    xcd_barrier(xb); TSREC(7) run_phase(p, 7, l, smem);
    xcd_barrier(xb); TSREC(8) run_phase(p, 8, l, smem);
    xcd_barrier(xb); TSREC(9) run_phase(p, 9, l, smem);
  }
#if TPROBE
  xcd_barrier(xb);
  if (rec) {
    ts[34] = __builtin_amdgcn_s_memrealtime();
    unsigned long long sum = 0;
    for (int i = 0; i < 34; ++i) {
      int ph = i < 2 ? i : 2 + (i - 2) % 8;
      if ((TPROBE >> ph) & 1) sum += ts[i + 1] - ts[i];
    }
    p.out[0] += TQ * floorf((float)sum * 0.01f * (1.f / TQ));
  }
#endif
}
#endif

extern "C" void kernel_launch(void* const* d_in, const int* in_sizes, int n_in, void* d_out, int out_size, void* d_ws,
                              size_t ws_size, hipStream_t stream) {
  P p{};
  p.x_prompt = (const float*)d_in[0]; p.x_sample = (const float*)d_in[1]; p.cache_na = (const float*)d_in[2];
  p.cache_gqa = (const float*)d_in[3]; p.stC = (const float*)d_in[4]; p.stn = (const float*)d_in[5]; p.stm = (const float*)d_in[6];
  p.c = (const float*)d_in[7]; p.c_ctx = (const float*)d_in[8]; p.w_in = (const float*)d_in[9]; p.b_gates = (const float*)d_in[10];
  p.w_out = (const float*)d_in[11]; p.g_norm = (const float*)d_in[12]; p.g_qk = (const float*)d_in[13]; p.g_ml = (const float*)d_in[14];
  p.na_bias = (const float*)d_in[15]; p.w_ada = (const float*)d_in[16]; p.b_ada = (const float*)d_in[17]; p.w_gu = (const float*)d_in[18];
  p.w_down = (const float*)d_in[19];
  p.out = (float*)d_out;
  p.ws = (char*)d_ws;
  if (WS_TOTAL_X > ws_size) { fprintf(stderr, "workspace too small: need %zu have %zu\n", (size_t)WS_TOTAL, ws_size); return; }

  static int grid_blocks = 0;
  if (!grid_blocks) {
    int dev = 0, cus = 0, per_cu = 0;
    (void)hipGetDevice(&dev);
    (void)hipDeviceGetAttribute(&cus, hipDeviceAttributeMultiprocessorCount, dev);
#if ONE_LAUNCH
    (void)hipFuncSetAttribute((const void*)k_mega, hipFuncAttributeMaxDynamicSharedMemorySize, DYN_LDS);
    (void)hipOccupancyMaxActiveBlocksPerMultiprocessor(&per_cu, k_mega, NTHR, DYN_LDS);
#else
    (void)hipFuncSetAttribute((const void*)k_phase, hipFuncAttributeMaxDynamicSharedMemorySize, DYN_LDS);
    (void)hipOccupancyMaxActiveBlocksPerMultiprocessor(&per_cu, k_phase, NTHR, DYN_LDS);
#endif
    if (per_cu < 1) { fprintf(stderr, "occupancy query returned %d\n", per_cu); per_cu = 1; }
    if (per_cu > 1) per_cu = 1;
    grid_blocks = cus * per_cu;
  }
  p.nblk = grid_blocks;
  (void)hipMemsetAsync(p.bar(), 0, (size_t)BAR_TOTAL_WORDS * 4, stream);
#if ONE_LAUNCH
  void* args[] = {&p};
  hipError_t e = hipLaunchCooperativeKernel((void*)k_mega, dim3(grid_blocks), dim3(NTHR), args, DYN_LDS, stream);
  if (e != hipSuccess) fprintf(stderr, "cooperative launch failed: %s (grid %d)\n", hipGetErrorString(e), grid_blocks);
#else
  k_phase<<<grid_blocks, NTHR, DYN_LDS, stream>>>(p, 0, 0);
  k_phase<<<grid_blocks, NTHR, DYN_LDS, stream>>>(p, 1, 0);
  for (int l = 0; l < 4; ++l)
    for (int ph = 2; ph <= 9; ++ph) k_phase<<<grid_blocks, NTHR, DYN_LDS, stream>>>(p, ph, l);
#endif
}
```

```cpp
#include <hip/hip_runtime.h>
#include <stdint.h>
#include <stdio.h>

#ifndef ONE_LAUNCH
#define ONE_LAUNCH 1
#endif
#ifndef TPROBE
#define TPROBE 0
#endif
#ifndef TQ
#define TQ 200.f
#endif
constexpr int NTHR = 512, NWAVE = 8;
constexpr int STAGE_LDS = 131072, DYN_LDS = STAGE_LDS + 256;

#define DI __device__ __forceinline__
typedef unsigned short u16;
typedef __attribute__((ext_vector_type(8))) short bf16x8;
typedef __attribute__((ext_vector_type(4))) float f32x4;

constexpr int TP = 4096, TS = 8192, TT = 12288, ZW = 2560, NIN = 2688, FF = 2816;
constexpr float EPS = 1e-6f;
constexpr size_t O_YP = 0, O_NA = 12582912, O_GQA = 20971520, O_C = 25165824, O_N = 27262976, O_M = 27295744;
constexpr int SMEM_BYTES = 73728;

struct P {
  const float *x_prompt, *x_sample, *cache_na, *cache_gqa, *stC, *stn, *stm, *c, *c_ctx, *w_in, *b_gates, *w_out,
      *g_norm, *g_qk, *g_ml, *na_bias, *w_ada, *b_ada, *w_gu, *w_down;
  float* out;
  char* ws;
  int nblk, pad_;
  __host__ __device__ __forceinline__ u16* wt_in() const { return (u16*)(ws + 0ull); }
  __host__ __device__ __forceinline__ u16* wt_out() const { return (u16*)(ws + 20971520ull); }
  __host__ __device__ __forceinline__ u16* wt_gu() const { return (u16*)(ws + 29360128ull); }
  __host__ __device__ __forceinline__ u16* wt_down() const { return (u16*)(ws + 75497472ull); }
  __host__ __device__ __forceinline__ float* mods() const { return (float*)(ws + 98566144ull); }
  __host__ __device__ __forceinline__ float* rope() const { return (float*)(ws + 99450880ull); }
  __host__ __device__ __forceinline__ u16* kc_na() const { return (u16*)(ws + 99459072ull); }
  __host__ __device__ __forceinline__ u16* vct_na() const { return (u16*)(ws + 103653376ull); }
  __host__ __device__ __forceinline__ u16* kc_gqa() const { return (u16*)(ws + 107847680ull); }
  __host__ __device__ __forceinline__ u16* vct_gqa() const { return (u16*)(ws + 109944832ull); }
  __host__ __device__ __forceinline__ u16* hn() const { return (u16*)(ws + 112041984ull); }
  __host__ __device__ __forceinline__ u16* zb() const { return (u16*)(ws + 137207808ull); }
  __host__ __device__ __forceinline__ u16* act() const { return (u16*)(ws + 137207808ull); }
  __host__ __device__ __forceinline__ u16* vt_na() const { return (u16*)(ws + 206413824ull); }
  __host__ __device__ __forceinline__ u16* vt_gqa() const { return (u16*)(ws + 212705280ull); }
  __host__ __device__ __forceinline__ u16* kt_ml() const { return (u16*)(ws + 215851008ull); }
  __host__ __device__ __forceinline__ u16* vt_ml() const { return (u16*)(ws + 222142464ull); }
  __host__ __device__ __forceinline__ u16* mix() const { return (u16*)(ws + 228433920ull); }
  __host__ __device__ __forceinline__ float* gates() const { return (float*)(ws + 253599744ull); }
  __host__ __device__ __forceinline__ float* obuf() const { return (float*)(ws + 254386176ull); }
  __host__ __device__ __forceinline__ float* ml_chat() const { return (float*)(ws + 304717824ull); }
  __host__ __device__ __forceinline__ float* ml_nhat() const { return (float*)(ws + 329883648ull); }
  __host__ __device__ __forceinline__ float* ml_ab() const { return (float*)(ws + 330276864ull); }
  __host__ __device__ __forceinline__ float* ml_nst() const { return (float*)(ws + 330289152ull); }
  __host__ __device__ __forceinline__ float* ml_mst() const { return (float*)(ws + 330682368ull); }
  __host__ __device__ __forceinline__ u16* ml_cst() const { return (u16*)(ws + 330688512ull); }
  __host__ __device__ __forceinline__ unsigned* bar() const { return (unsigned*)(ws + 343271424ull); }
};
constexpr size_t X16_OFF = 343351808ull;
constexpr size_t WS_TOTAL_X = X16_OFF + (size_t)12288 * 1024 * 2;
constexpr size_t WS_TOTAL = 343286272ull;

DI u16 f2bf(float x) { unsigned u = __float_as_uint(x); u += 0x7fffu + ((u >> 16) & 1u); return (u16)(u >> 16); }
DI float bf2f(u16 h) { return __uint_as_float(((unsigned)h) << 16); }
DI unsigned pack2(float a, float b) { unsigned r; asm volatile("v_cvt_pk_bf16_f32 %0, %1, %2" : "=v"(r) : "v"(a), "v"(b)); return r; }
#define DPP_F(v, ctrl, rmask) __int_as_float(__builtin_amdgcn_update_dpp(0, __float_as_int(v), (ctrl), (rmask), 0xF, false))
DI float wave_sum(float v) {
  v += DPP_F(v, 0xB1, 0xF);
  v += DPP_F(v, 0x4E, 0xF);
  v += DPP_F(v, 0x141, 0xF);
  v += DPP_F(v, 0x140, 0xF);
  v += DPP_F(v, 0x142, 0xA);
  v += DPP_F(v, 0x143, 0xC);
  return __int_as_float(__builtin_amdgcn_readlane(__float_as_int(v), 63));
}
DI float wave_max(float v) { for (int o = 32; o >= 1; o >>= 1) v = fmaxf(v, __shfl_xor(v, o)); return v; }
DI void wave_sync() { __builtin_amdgcn_fence(__ATOMIC_RELEASE, "wavefront"); __builtin_amdgcn_wave_barrier(); __builtin_amdgcn_fence(__ATOMIC_ACQUIRE, "wavefront"); }
#define MFMA16(a, b, c) __builtin_amdgcn_mfma_f32_16x16x32_bf16((a), (b), (c), 0, 0, 0)
DI bf16x8 ld8(const u16* p) { return *(const bf16x8*)p; }
DI bf16x8 ld4x2(const u16* p0, const u16* p1) {
  uint2 a = *(const uint2*)p0, b = *(const uint2*)p1;
  uint4 r; r.x = a.x; r.y = a.y; r.z = b.x; r.w = b.y;
  return __builtin_bit_cast(bf16x8, r);
}
DI bf16x8 pack8(const f32x4& a, const f32x4& b) {
  uint4 r; r.x = pack2(a[0], a[1]); r.y = pack2(a[2], a[3]); r.z = pack2(b[0], b[1]); r.w = pack2(b[2], b[3]);
  return __builtin_bit_cast(bf16x8, r);
}
DI f32x4 zero4() { f32x4 z = {0.f, 0.f, 0.f, 0.f}; return z; }

DI size_t vt_index(int row, int H, int h, int d) {
  if (row < TP) { int b = row >> 8, t = row & 255; return ((size_t)((b * H + h) * 64 + d)) * 256 + t; }
  int r = row - TP; int b = r >> 10, t = r & 1023;
  return (size_t)16 * H * 64 * 256 + ((size_t)((b * H + h) * 64 + d)) * 1024 + t;
}


#define XB_TMO      128
#define XB_XCNT(j)  (256  + 64 * (j))
#define XB_XSUB(j)  (1280 + 64 * (j))
#define XB_XGEN(j)  (2304 + 64 * (j))
#define XB_TOP      3328
#define XB_TOPGEN   3392
#define XCD_BAR_WORDS 3456
#define XB_SPIN_CAP (1u << 20)
#define LAS __attribute__((address_space(3)))
DI unsigned xb_ld(unsigned* p) { return __hip_atomic_load(p, __ATOMIC_RELAXED, __HIP_MEMORY_SCOPE_AGENT); }
DI unsigned xb_add(unsigned* p, unsigned v) { return __hip_atomic_fetch_add(p, v, __ATOMIC_RELAXED, __HIP_MEMORY_SCOPE_AGENT); }
DI unsigned xb_xcc_id() { return (unsigned)__builtin_amdgcn_s_getreg((3 << 11) | 20) & 0xFu; }
#define XB_SPIN(cond, bar) do { unsigned _sp = 0; while (cond) { __builtin_amdgcn_s_sleep(1); \
    if ((++_sp & 255u) == 0u) { if (xb_ld(&(bar)[XB_TMO])) break; if (_sp > XB_SPIN_CAP) { atomicAdd(&(bar)[XB_TMO], 1u); break; } } } } while (0)
struct XcdBarrier { unsigned* bar; unsigned x; unsigned G; volatile LAS unsigned* st; };
DI XcdBarrier xcd_barrier_post(unsigned* bar, volatile LAS unsigned* st, unsigned G) {
  XcdBarrier b; b.bar = bar; b.x = xb_xcc_id(); b.st = st; b.G = G;
  if (threadIdx.x == 0) (void)xb_add(&bar[XB_XCNT(b.x)], 1u);
  return b;
}
DI void xcd_barrier_complete(unsigned* bar, unsigned x, unsigned& nloc, unsigned& nx, unsigned G) {
  unsigned sum, cnt, mine, sp = 0u;
  for (;;) {
    sum = 0u; cnt = 0u; mine = 0u;
#pragma unroll
    for (unsigned j = 0; j < 16; ++j) { const unsigned c = xb_ld(&bar[XB_XCNT(j)]); sum += c; cnt += (c > 0u) ? 1u : 0u; mine = (j == x) ? c : mine; }
    if (sum == G) break;
    __builtin_amdgcn_s_sleep(1);
    if ((++sp & 255u) == 0u) { if (xb_ld(&bar[XB_TMO])) break; if (sp > XB_SPIN_CAP) { atomicAdd(&bar[XB_TMO], 1u); break; } }
  }
  nloc = mine > 0u ? mine : 1u; nx = cnt > 0u ? cnt : 1u;
}
DI void xcd_barrier(const XcdBarrier& b) {
  asm volatile("s_waitcnt vmcnt(0)" ::: "memory");
  __syncthreads();
  if (threadIdx.x == 0) {
    unsigned* bar = b.bar;
    __builtin_amdgcn_s_waitcnt(0);
    unsigned nloc = b.st[0], nx = b.st[1];
    if (nloc == 0u) { xcd_barrier_complete(bar, b.x, nloc, nx, b.G); b.st[0] = nloc; b.st[1] = nx; }
    const unsigned old = xb_add(&bar[XB_XSUB(b.x)], 1u);
    const unsigned gen = old / nloc;
    if (old + 1u == (gen + 1u) * nloc) {
      __builtin_amdgcn_fence(__ATOMIC_RELEASE, "agent");
      asm volatile("s_waitcnt vmcnt(0)" ::: "memory");
      const unsigned og = xb_add(&bar[XB_TOP], 1u);
      const unsigned tg = og / nx;
      if (og + 1u == (tg + 1u) * nx) xb_add(&bar[XB_TOPGEN], 1u);
      else XB_SPIN(xb_ld(&bar[XB_TOPGEN]) == tg, bar);
      __builtin_amdgcn_fence(__ATOMIC_ACQUIRE, "agent");
      xb_add(&bar[XB_XGEN(b.x)], 1u);
      asm volatile("s_waitcnt vmcnt(0)" ::: "memory");
    } else {
      XB_SPIN(xb_ld(&bar[XB_XGEN(b.x)]) == gen, bar);
      __builtin_amdgcn_fence(__ATOMIC_ACQUIRE, "agent");
      asm volatile("s_waitcnt vmcnt(0)" ::: "memory");
    }
  }
  __syncthreads();
}

DI void transpose_tile(const float* __restrict__ src, int ldsrc, int k0, int n0, int mode, int nvalid,
                       u16* __restrict__ dst, int ldd, float* tile, int tid) {
  const int nn = tid & 63, kq = tid >> 6;
  int rr = n0 + nn, col;
  if (mode == 1) {
    int tl = rr >> 8, c = rr & 255, bj = c >> 7, wc = (c >> 5) & 3, w = c & 31;
    col = tl * 128 + wc * 32 + w + bj * FF;
  } else if (mode == 2) {
    int tl = rr >> 8, c = rr & 255, bj = c >> 7, wc = (c >> 5) & 3, w = c & 31;
    col = tl * 256 + wc * 64 + bj * 32 + w;
  } else col = rr < nvalid ? rr : -1;
#pragma unroll
  for (int i = 0; i < 8; ++i) {
    int kk = i * 8 + kq;
    tile[kk * 65 + nn] = col >= 0 ? src[(size_t)(k0 + kk) * ldsrc + col] : 0.f;
  }
  __syncthreads();
  const int k2 = (tid & 31) * 2, nq = tid >> 5;
#pragma unroll
  for (int i = 0; i < 4; ++i) {
    int n = i * 16 + nq;
    *(unsigned*)(dst + (size_t)(n0 + n) * ldd + k0 + k2) = pack2(tile[k2 * 65 + n], tile[(k2 + 1) * 65 + n]);
  }
  __syncthreads();
}

DI void phase_init(const P& p, char* smem, int tid) {
  float* tile = (float*)smem;
  const int NTR = 12032, NCV = 768, NADA = 384;
  const int total = NTR + NCV + NADA + 1;
  for (int it = blockIdx.x; it < total; it += p.nblk) {
    if (it < NTR) {
      int l = it / 3008, r = it % 3008;
      if (r < 640) {
        int kt = r / 40, nt = r % 40;
        transpose_tile(p.w_in + (size_t)l * 1024 * 2576, 2576, kt * 64, nt * 64, 2, 2560, p.wt_in() + (size_t)l * ZW * 1024, 1024, tile, tid);
      } else if (r < 896) {
        int x = r - 640, kt = x / 16, nt = x % 16;
        transpose_tile(p.w_out + (size_t)l * 1024 * 1024, 1024, kt * 64, nt * 64, 0, 1024, p.wt_out() + (size_t)l * 1024 * 1024, 1024, tile, tid);
      } else if (r < 2304) {
        int x = r - 896, kt = x / 88, nt = x % 88;
        transpose_tile(p.w_gu + (size_t)l * 1024 * 5632, 5632, kt * 64, nt * 64, 1, 5632, p.wt_gu() + (size_t)l * 5632 * 1024, 1024, tile, tid);
      } else {
        int x = r - 2304, kt = x / 16, nt = x % 16;
        transpose_tile(p.w_down + (size_t)l * FF * 1024, 1024, kt * 64, nt * 64, 0, 1024, p.wt_down() + (size_t)l * 1024 * FF, FF, tile, tid);
      }
    } else if (it < NTR + NCV) {
      int it2 = it - NTR;
      if (it2 < 512) {
        int idx = it2 >> 2, tt = it2 & 3, bl = idx >> 2, h = idx & 3;
        transpose_tile(p.cache_na + (size_t)((bl * 2 + 1) * 4 + h) * 16384, 64, tt * 64, 0, 0, 64, p.vct_na() + (size_t)idx * 16384, 256, tile, tid);
      } else {
        int it3 = it2 - 512;
        int idx = it3 >> 2, tt = it3 & 3, bl = idx >> 1, h = idx & 1;
        transpose_tile(p.cache_gqa + (size_t)((bl * 2 + 1) * 2 + h) * 16384, 64, tt * 64, 0, 0, 64, p.vct_gqa() + (size_t)idx * 16384, 256, tile, tid);
      }
    } else if (it < NTR + NCV + NADA) {
      int ia = it - NTR - NCV;
      int l = ia / 96, colbase = (ia % 96) * 64;
      float* sl = (float*)smem;
      for (int i = tid; i < 9 * 1024; i += NTHR) {
        int n = i >> 10, d = i & 1023;
        float cv = n == 0 ? p.c_ctx[d] : p.c[(n - 1) * 1024 + d];
        sl[i] = cv / (1.f + __expf(-cv));
      }
      __syncthreads();
      const int col = tid & 63, kg = tid >> 6;
      float acc[9];
#pragma unroll
      for (int n = 0; n < 9; ++n) acc[n] = 0.f;
      const float* w = p.w_ada + ((size_t)l * 1024 + kg * 128) * 6144 + colbase + col;
#pragma unroll 4
      for (int k = 0; k < 128; ++k) {
        float wv = w[(size_t)k * 6144];
#pragma unroll
        for (int n = 0; n < 9; ++n) acc[n] += sl[n * 1024 + kg * 128 + k] * wv;
      }
      float* red = sl + 9216;
#pragma unroll
      for (int n = 0; n < 9; ++n) red[(kg * 9 + n) * 64 + col] = acc[n];
      __syncthreads();
      for (int i = tid; i < 576; i += NTHR) {
        int n = i >> 6, cc = i & 63;
        float s = 0.f;
#pragma unroll
        for (int g = 0; g < 8; ++g) s += red[(g * 9 + n) * 64 + cc];
        p.mods()[(size_t)(l * 9 + n) * 6144 + colbase + cc] = s + p.b_ada[l * 6144 + colbase + cc];
      }
      __syncthreads();
    } else {
      for (int i = tid; i < 1024; i += NTHR) {
        int pos = i >> 4, fi = i & 15;
        float inv = __builtin_amdgcn_exp2f(-(float)fi * 0.8304820237f);
        float ang = (float)pos * inv;
        p.rope()[i] = __cosf(ang);
        p.rope()[1024 + i] = __sinf(ang);
      }
    }
  }
  const int gtid = blockIdx.x * NTHR + tid, gsz = p.nblk * NTHR;
  for (int i = gtid; i < 128 * 4096; i += gsz) {
    int idx = i >> 12, e = (i & 4095) * 4, bl = idx >> 2, h = idx & 3;
    float4 v = *(const float4*)(p.cache_na + (size_t)((bl * 2 + 0) * 4 + h) * 16384 + e);
    uint2 o; o.x = pack2(v.x, v.y); o.y = pack2(v.z, v.w);
    *(uint2*)(p.kc_na() + (size_t)idx * 16384 + e) = o;
  }
  for (int i = gtid; i < 64 * 4096; i += gsz) {
    int idx = i >> 12, e = (i & 4095) * 4, bl = idx >> 1, h = idx & 1;
    float4 v = *(const float4*)(p.cache_gqa + (size_t)((bl * 2 + 0) * 2 + h) * 16384 + e);
    uint2 o; o.x = pack2(v.x, v.y); o.y = pack2(v.z, v.w);
    *(uint2*)(p.kc_gqa() + (size_t)idx * 16384 + e) = o;
  }
}

DI void phase_row(const P& p, int mode, int l, char* smem, int tid) {
  const int lane = tid & 63, wid = tid >> 6;
  const bool last = (mode == 2 && l == 3);
  const int ln = mode == 1 ? l : (mode == 0 ? 0 : l + 1);
  const bool do_gates = (mode != 1) && !last;
  u16* x16 = (u16*)(p.ws + X16_OFF);
  float* Wg = (float*)smem;
  if (do_gates) {
    for (int idx = tid; idx < 16384; idx += NTHR) {
      int k = idx >> 4, g = idx & 15;
      Wg[g * 1024 + k] = p.w_in[((size_t)ln * 1024 + k) * 2576 + 2560 + g];
    }
    __syncthreads();
  }
  const int rpw = (TT + p.nblk * NWAVE - 1) / (p.nblk * NWAVE);
  const int rbeg = (blockIdx.x * NWAVE + wid) * rpw;
  const int rend = min(TT, rbeg + rpw);
  const int gi = mode == 1 ? 2 : 0, shi = mode == 1 ? 3 : 0;
  float4 g2v[4], shv[4], scv[4], gav[4], gv[4];
  {
    const float* g2 = p.g_norm + (size_t)((last ? l : ln) * 4 + gi) * 1024;
    const float* g = p.g_norm + (size_t)(l * 4 + (mode == 1 ? 1 : 3)) * 1024;
#pragma unroll
    for (int i = 0; i < 4; ++i) {
      const int cidx = i * 256 + lane * 4;
      g2v[i] = *(const float4*)(g2 + cidx);
      gv[i] = mode != 0 ? *(const float4*)(g + cidx) : g2v[i];
    }
  }
  int cur_nidx = -1;
  uint2 obn[4], xbn[4];
  if (mode != 0 && rbeg < rend) {
#pragma unroll
    for (int i = 0; i < 4; ++i) { obn[i] = *(const uint2*)((const u16*)p.obuf() + (size_t)rbeg * 1024 + i * 256 + lane * 4); xbn[i] = *(const uint2*)(x16 + (size_t)rbeg * 1024 + i * 256 + lane * 4); }
  }
  for (int row_ = rbeg; row_ < rend; ++row_) {
    int row = row_;
    asm volatile("" : "+v"(row));
    const int nidx = row < TP ? 0 : 1 + ((row - TP) >> 10);
    float4 x[4];
    if (nidx != cur_nidx) {
      cur_nidx = nidx;
      const float* sh = p.mods() + ((size_t)((last ? l : ln) * 9 + nidx) * 6 + shi) * 1024;
      const float* sc = sh + 1024;
      const float* ga = p.mods() + ((size_t)(l * 9 + nidx) * 6 + (mode == 1 ? 2 : 5)) * 1024;
#pragma unroll
      for (int i = 0; i < 4; ++i) {
        const int cidx = i * 256 + lane * 4;
        shv[i] = *(const float4*)(sh + cidx); scv[i] = *(const float4*)(sc + cidx);
        gav[i] = mode != 0 ? *(const float4*)(ga + cidx) : shv[i];
      }
    }
    if (mode == 0) {
      const float* src = row < TP ? p.x_prompt + (size_t)row * 1024 : p.x_sample + (size_t)(row - TP) * 1024;
#pragma unroll
      for (int i = 0; i < 4; ++i) x[i] = *(const float4*)(src + i * 256 + lane * 4);
    } else {
      uint2 ob[4], xb[4];
#pragma unroll
      for (int i = 0; i < 4; ++i) { ob[i] = obn[i]; xb[i] = xbn[i]; }
      {
        const int rnx = row_ + 1;
        if (rnx < rend) {
#pragma unroll
          for (int i = 0; i < 4; ++i) { obn[i] = *(const uint2*)((const u16*)p.obuf() + (size_t)rnx * 1024 + i * 256 + lane * 4); xbn[i] = *(const uint2*)(x16 + (size_t)rnx * 1024 + i * 256 + lane * 4); }
        }
      }
      float4 o[4];
      float ss = 0.f;
#pragma unroll
      for (int i = 0; i < 4; ++i) {
        o[i].x = __uint_as_float(ob[i].x << 16); o[i].y = __uint_as_float(ob[i].x & 0xffff0000u);
        o[i].z = __uint_as_float(ob[i].y << 16); o[i].w = __uint_as_float(ob[i].y & 0xffff0000u);
        x[i].x = __uint_as_float(xb[i].x << 16); x[i].y = __uint_as_float(xb[i].x & 0xffff0000u);
        x[i].z = __uint_as_float(xb[i].y << 16); x[i].w = __uint_as_float(xb[i].y & 0xffff0000u);
        ss += o[i].x * o[i].x + o[i].y * o[i].y + o[i].z * o[i].z + o[i].w * o[i].w;
      }
      ss = wave_sum(ss);
      const float rs = rsqrtf(ss * (1.f / 1024.f) + EPS);
#pragma unroll
      for (int i = 0; i < 4; ++i) {
        x[i].x += gav[i].x * (o[i].x * rs * gv[i].x); x[i].y += gav[i].y * (o[i].y * rs * gv[i].y);
        x[i].z += gav[i].z * (o[i].z * rs * gv[i].z); x[i].w += gav[i].w * (o[i].w * rs * gv[i].w);
      }
    }
    if (last) {
#pragma unroll
      for (int i = 0; i < 4; ++i) *(float4*)(p.out + (size_t)row * 1024 + i * 256 + lane * 4) = x[i];
      continue;
    }
#pragma unroll
    for (int i = 0; i < 4; ++i) {
      uint2 w; w.x = pack2(x[i].x, x[i].y); w.y = pack2(x[i].z, x[i].w);
      *(uint2*)(x16 + (size_t)row * 1024 + i * 256 + lane * 4) = w;
      x[i].x = __uint_as_float(w.x << 16); x[i].y = __uint_as_float(w.x & 0xffff0000u);
      x[i].z = __uint_as_float(w.y << 16); x[i].w = __uint_as_float(w.y & 0xffff0000u);
    }
    float ss2 = 0.f;
#pragma unroll
    for (int i = 0; i < 4; ++i) ss2 += x[i].x * x[i].x + x[i].y * x[i].y + x[i].z * x[i].z + x[i].w * x[i].w;
    ss2 = wave_sum(ss2);
    const float rs2 = rsqrtf(ss2 * (1.f / 1024.f) + EPS);
#pragma unroll
    for (int i = 0; i < 4; ++i) {
      const int cidx = i * 256 + lane * 4;
      x[i].x = x[i].x * rs2 * g2v[i].x * (1.f + scv[i].x) + shv[i].x;
      x[i].y = x[i].y * rs2 * g2v[i].y * (1.f + scv[i].y) + shv[i].y;
      x[i].z = x[i].z * rs2 * g2v[i].z * (1.f + scv[i].z) + shv[i].z;
      x[i].w = x[i].w * rs2 * g2v[i].w * (1.f + scv[i].w) + shv[i].w;
      uint2 o2; o2.x = pack2(x[i].x, x[i].y); o2.y = pack2(x[i].z, x[i].w);
      *(uint2*)(p.hn() + (size_t)row * 1024 + cidx) = o2;
    }
    if (do_gates) {
      float part[16];
#pragma unroll 2
      for (int g16 = 0; g16 < 16; ++g16) {
        float a = 0.f;
#pragma unroll
        for (int i = 0; i < 4; ++i) {
          const float4 wv = *(const float4*)(Wg + g16 * 1024 + i * 256 + lane * 4);
          a += x[i].x * wv.x + x[i].y * wv.y + x[i].z * wv.z + x[i].w * wv.w;
        }
        part[g16] = a;
      }
      const bool b5 = (lane & 32) != 0, b4 = (lane & 16) != 0, b3 = (lane & 8) != 0, b2 = (lane & 4) != 0;
      float w8[8], w4[4], w2[2];
#pragma unroll
      for (int k = 0; k < 8; ++k) { const float send = b5 ? part[k] : part[k + 8], keep = b5 ? part[k + 8] : part[k]; w8[k] = keep + __shfl_xor(send, 32); }
#pragma unroll
      for (int k = 0; k < 4; ++k) { const float send = b4 ? w8[k] : w8[k + 4], keep = b4 ? w8[k + 4] : w8[k]; w4[k] = keep + __shfl_xor(send, 16); }
#pragma unroll
      for (int k = 0; k < 2; ++k) { const float send = b3 ? w4[k] : w4[k + 2], keep = b3 ? w4[k + 2] : w4[k]; w2[k] = keep + __shfl_xor(send, 8); }
      float w1;
      { const float send = b2 ? w2[0] : w2[1], keep = b2 ? w2[1] : w2[0]; w1 = keep + __shfl_xor(send, 4); }
      w1 += __shfl_xor(w1, 2);
      w1 += __shfl_xor(w1, 1);
      const int gidx = (b5 ? 8 : 0) + (b4 ? 4 : 0) + (b3 ? 2 : 0) + (b2 ? 1 : 0);
      if ((lane & 3) == 0) p.gates()[(size_t)row * 16 + gidx] = w1 + p.b_gates[ln * 16 + gidx];
    }
  }
  if (do_gates) __syncthreads();
}

#define PG8_LAS __attribute__((address_space(3)))
typedef unsigned u32x4 __attribute__((ext_vector_type(4)));
typedef unsigned u32x2 __attribute__((ext_vector_type(2)));
namespace pg8 {
constexpr int BM = 256, BK = 64, HALF = 128, HTB = HALF * BK * 2, NXCD = 8, WGM = 8;
DI int lds_byte(int r, int c) { const int st = (r >> 4) * 2 + (c >> 5), rr = r & 15, cc = c & 31, ob = rr * 64 + cc * 2; return st * 1024 + (ob ^ (((ob >> 9) & 1) << 5)); }
DI void stage_rc(int b, int& R, int& C) { const int st = b / 1024, sb = b % 1024, swz = sb ^ (((sb >> 9) & 1) << 5); R = (st >> 1) * 16 + swz / 64; C = (st & 1) * 32 + (swz % 64) / 2; }
DI int perm32(int rho) { const int n = rho >> 4, i = rho & 15; return 8 * (i >> 2) + 4 * n + (i & 3); }
struct Unit { int pm, pn; };
struct Gemm { const u16* A; const u16* Bt; int M, N, K; };
struct StaticOrder {
  int nM, nN, nwg, G, c;
  DI void init(int M, int N, int G_, int c_) { nM = M / BM; nN = N / BM; nwg = nM * nN; G = G_; c = c_; }
  DI bool next(int i, Unit& u) const {
    const long L = (long)i * G + c; if (L >= nwg) return false;
    int wgid = (int)L; { const int q = nwg / NXCD, r = nwg % NXCD, xcd = wgid % NXCD, off = wgid / NXCD; wgid = (xcd < r ? xcd * (q + 1) : r * (q + 1) + (xcd - r) * q) + off; }
    const int nig = WGM * nN, gid = wgid / nig, fm = gid * WGM, gsz = (nM - fm) < WGM ? (nM - fm) : WGM;
    u.pm = fm + ((wgid % nig) % gsz); u.pn = (wgid % nig) / gsz; return true;
  }
};
DI unsigned cvt_pk_bf16(float lo, float hi) { unsigned r; asm volatile("v_cvt_pk_bf16_f32 %0, %1, %2" : "=v"(r) : "v"(lo), "v"(hi)); return r; }

template <class Epi>
DI void gemm_phase(PG8_LAS unsigned char* lds, const Gemm g, const StaticOrder& S, const Epi& E) {
  int tid = threadIdx.x;
  asm volatile("" : "+v"(tid));
  const int wid = __builtin_amdgcn_readfirstlane(tid >> 6), lane = tid & 63, wr = wid >> 2, wc = wid & 3, fr = lane & 15, fq = lane >> 4;
  const int K = g.K, nt = K / BK;
  unsigned voffA[2], voffB[2];
#pragma unroll
  for (int i = 0; i < 2; ++i) { int R, C; stage_rc(tid * 16 + i * 8192, R, C); const int Rb = Epi::PERM ? ((R & ~31) + perm32(R & 31)) : R;
    voffA[i] = (unsigned)(R * K + C) * 2u; voffB[i] = (unsigned)(Rb * K + C) * 2u; }
  const size_t kstep = (size_t)(BK * 2);
  const size_t hstep = (size_t)HALF * K * 2;
  const size_t tstep = 2 * hstep;
  const unsigned ldsw = (unsigned)wid * 1024u;
  const int aoff = lds_byte(wr * 64 + fr, fq * 8), boff = lds_byte(wc * 32 + fr, fq * 8);
#define PG8_SA(b, h) (((b) * 2 + (h)) * HTB)
#define PG8_SB(b, h) ((4 + (b) * 2 + (h)) * HTB)
#define PG8_STAGE(bufoff, gbase, voff) do { _Pragma("unroll") for (int _i = 0; _i < 2; ++_i) \
    __builtin_amdgcn_global_load_lds((const unsigned*)((const char*)(gbase) + (voff)[_i]), (PG8_LAS unsigned*)(lds + (bufoff) + ldsw + _i * 8192), 16, 0, 0); } while (0)
#define PG8_LDA(dst, b, h) do { _Pragma("unroll") for (int m = 0; m < 4; ++m) _Pragma("unroll") for (int k = 0; k < 2; ++k) dst[m][k] = *(const PG8_LAS bf16x8*)(lds + PG8_SA(b, h) + aoff + m * 2048 + k * 1024); } while (0)
#define PG8_LDB(dst, b, h) do { _Pragma("unroll") for (int n = 0; n < 2; ++n) _Pragma("unroll") for (int k = 0; k < 2; ++k) dst[n][k] = *(const PG8_LAS bf16x8*)(lds + PG8_SB(b, h) + boff + n * 2048 + k * 1024); } while (0)
#define PG8_MMA(ai, bj, At, Bt) do { __builtin_amdgcn_s_setprio(1); _Pragma("unroll") for (int m = 0; m < 4; ++m) _Pragma("unroll") for (int n = 0; n < 2; ++n) _Pragma("unroll") for (int k = 0; k < 2; ++k) \
    acc[ai][bj][m][n] = __builtin_amdgcn_mfma_f32_16x16x32_bf16(Bt[n][k], At[m][k], acc[ai][bj][m][n], 0, 0, 0); __builtin_amdgcn_s_setprio(0); } while (0)
#define PG8_WAIT_V(n) asm volatile("s_waitcnt vmcnt(" #n ")" ::: "memory")
#define PG8_WAIT_L(n) asm volatile("s_waitcnt lgkmcnt(" #n ")" ::: "memory")
#define PG8_BAR __builtin_amdgcn_s_barrier()
#define PG8_SCHED __builtin_amdgcn_sched_barrier(0)
  Unit cur, nxt; int ui = 0;
  if (!S.next(0, cur)) return;
  f32x4 acc[2][2][4][2];
#pragma unroll
  for (int a = 0; a < 2; ++a)
#pragma unroll
    for (int b = 0; b < 2; ++b)
#pragma unroll
      for (int m = 0; m < 4; ++m)
#pragma unroll
        for (int n = 0; n < 2; ++n) acc[a][b][m][n] = (f32x4){0.f, 0.f, 0.f, 0.f};
  bf16x8 At[4][2], B0[2][2], B1[2][2];
  const char* cA = (const char*)g.A + (size_t)cur.pm * tstep; const char* cB = (const char*)g.Bt + (size_t)cur.pn * tstep;
  PG8_STAGE(PG8_SB(0, 0), cB, voffB); PG8_STAGE(PG8_SA(0, 0), cA, voffA); PG8_STAGE(PG8_SB(0, 1), cB + hstep, voffB); PG8_STAGE(PG8_SA(0, 1), cA + hstep, voffA);
  if (wr == 1) PG8_BAR;
  PG8_WAIT_V(4); PG8_BAR;
  PG8_STAGE(PG8_SB(1, 0), cB + kstep, voffB); PG8_STAGE(PG8_SA(1, 0), cA + kstep, voffA); PG8_STAGE(PG8_SB(1, 1), cB + hstep + kstep, voffB);
  PG8_WAIT_V(6); PG8_BAR;
  for (;;) {
    const bool has_next = S.next(ui + 1, nxt);
    const char* nA = has_next ? (const char*)g.A + (size_t)nxt.pm * tstep : cA; const char* nB = has_next ? (const char*)g.Bt + (size_t)nxt.pn * tstep : cB;
    for (int t = 0; t < nt; t += 2) {
      const bool last = (t == nt - 2);
      const char* a1 = cA + (size_t)(t + 1) * kstep;
      const char* a2 = last ? nA : cA + (size_t)(t + 2) * kstep; const char* b2 = last ? nB : cB + (size_t)(t + 2) * kstep;
      const char* a3 = a2 + kstep; const char* b3 = b2 + kstep;
      PG8_LDB(B0, 0, 0); PG8_SCHED; PG8_LDA(At, 0, 0); PG8_STAGE(PG8_SA(1, 1), a1 + hstep, voffA);
      PG8_WAIT_L(8); PG8_BAR; PG8_WAIT_L(0); PG8_MMA(0, 0, At, B0); PG8_BAR; PG8_SCHED;
      PG8_LDB(B1, 0, 1); PG8_STAGE(PG8_SB(0, 0), b2, voffB);
      PG8_BAR; PG8_WAIT_L(0); PG8_MMA(0, 1, At, B1); PG8_BAR;
      PG8_LDA(At, 0, 1); PG8_STAGE(PG8_SA(0, 0), a2, voffA);
      PG8_BAR; PG8_WAIT_L(0); PG8_MMA(1, 0, At, B0); PG8_BAR; PG8_SCHED;
      PG8_STAGE(PG8_SB(0, 1), b2 + hstep, voffB);
      PG8_WAIT_V(6); PG8_BAR; PG8_MMA(1, 1, At, B1); PG8_BAR;
      PG8_LDB(B0, 1, 0); PG8_SCHED; PG8_LDA(At, 1, 0); PG8_STAGE(PG8_SA(0, 1), a2 + hstep, voffA);
      PG8_WAIT_L(8); PG8_BAR; PG8_WAIT_L(0); PG8_MMA(0, 0, At, B0); PG8_BAR; PG8_SCHED;
      PG8_LDB(B1, 1, 1); PG8_STAGE(PG8_SB(1, 0), b3, voffB);
      PG8_BAR; PG8_WAIT_L(0); PG8_MMA(0, 1, At, B1); PG8_BAR;
      PG8_LDA(At, 1, 1); PG8_STAGE(PG8_SA(1, 0), a3, voffA);
      PG8_BAR; PG8_WAIT_L(0); PG8_MMA(1, 0, At, B0); PG8_BAR; PG8_SCHED;
      PG8_STAGE(PG8_SB(1, 1), b3 + hstep, voffB);
      PG8_WAIT_V(6); PG8_BAR; PG8_MMA(1, 1, At, B1); PG8_BAR;
    }
    E(acc, cur, wr, wc, fr, fq);
    if (!has_next) break;
#pragma unroll
    for (int a = 0; a < 2; ++a)
#pragma unroll
      for (int b = 0; b < 2; ++b)
#pragma unroll
        for (int m = 0; m < 4; ++m)
#pragma unroll
          for (int n = 0; n < 2; ++n) acc[a][b][m][n] = (f32x4){0.f, 0.f, 0.f, 0.f};
    cur = nxt; cA = nA; cB = nB; ++ui;
  }
  PG8_WAIT_V(0);
  if (wr == 0) PG8_BAR;
  PG8_BAR;
#undef PG8_SA
#undef PG8_SB
#undef PG8_STAGE
#undef PG8_LDA
#undef PG8_LDB
#undef PG8_MMA
#undef PG8_WAIT_V
#undef PG8_WAIT_L
#undef PG8_BAR
#undef PG8_SCHED
}
}

struct EpiO {
  static constexpr bool PERM = true;
  u16* C;
  DI void operator()(const f32x4 (&acc)[2][2][4][2], const pg8::Unit& u, int wr, int wc, int fr, int fq) const {
    const int row0 = u.pm * 256 + wr * 64 + fr, col0 = u.pn * 256 + wc * 32 + 8 * fq;
#pragma unroll
    for (int ai = 0; ai < 2; ++ai)
#pragma unroll
      for (int m = 0; m < 4; ++m) {
        u16* rowp = C + (unsigned)(row0 + ai * 128 + m * 16) * 1024u + (unsigned)col0;
#pragma unroll
        for (int bj = 0; bj < 2; ++bj) {
          const f32x4 v0 = acc[ai][bj][m][0], v1 = acc[ai][bj][m][1];
          u32x4 w; w.x = pg8::cvt_pk_bf16(v0[0], v0[1]); w.y = pg8::cvt_pk_bf16(v0[2], v0[3]); w.z = pg8::cvt_pk_bf16(v1[0], v1[1]); w.w = pg8::cvt_pk_bf16(v1[2], v1[3]);
          *(u32x4*)(rowp + bj * 128) = w;
        }
      }
  }
};

struct EpiGU {
  static constexpr bool PERM = true;
  u16* act;
  DI void operator()(const f32x4 (&acc)[2][2][4][2], const pg8::Unit& u, int wr, int wc, int fr, int fq) const {
    const int row0 = u.pm * 256 + wr * 64 + fr, col0 = u.pn * 128 + wc * 32 + 8 * fq;
#pragma unroll
    for (int ai = 0; ai < 2; ++ai)
#pragma unroll
      for (int m = 0; m < 4; ++m) {
        float r[8];
#pragma unroll
        for (int n = 0; n < 2; ++n)
#pragma unroll
          for (int j = 0; j < 4; ++j) {
            const float g = acc[ai][0][m][n][j], up = acc[ai][1][m][n][j];
            r[n * 4 + j] = g * __builtin_amdgcn_rcpf(1.f + __expf(-g)) * up;
          }
        u32x4 w; w.x = pg8::cvt_pk_bf16(r[0], r[1]); w.y = pg8::cvt_pk_bf16(r[2], r[3]); w.z = pg8::cvt_pk_bf16(r[4], r[5]); w.w = pg8::cvt_pk_bf16(r[6], r[7]);
        *(u32x4*)(act + (size_t)(row0 + ai * 128 + m * 16) * FF + col0) = w;
      }
  }
};

struct EpiIn {
  static constexpr bool PERM = false;
  const P* pp; int l;
  DI void operator()(const f32x4 (&acc)[2][2][4][2], const pg8::Unit& u, int wr, int wc, int fr, int fq) const {
    const P& p = *pp;
    const int c0 = u.pn * 256 + wc * 64;
    const int rb = u.pm * 256 + wr * 64 + fr;
    const bool prm = u.pm * 256 < TP;
    int region, hh;
    if (c0 < 256) { region = 0; hh = c0 >> 6; }
    else if (c0 < 512) { region = 1; hh = (c0 - 256) >> 6; }
    else if (c0 < 768) { region = 2; hh = (c0 - 512) >> 6; }
    else if (c0 < 1280) { region = 3; hh = (c0 - 768) >> 6; }
    else if (c0 < 1408) { region = 4; hh = (c0 - 1280) >> 6; }
    else if (c0 < 1536) { region = 5; hh = (c0 - 1408) >> 6; }
    else if (c0 < 1792) { region = 6; hh = (c0 - 1536) >> 6; }
    else if (c0 < 2048) { region = 7; hh = (c0 - 1792) >> 6; }
    else if (c0 < 2304) { region = 8; hh = (c0 - 2048) >> 6; }
    else { region = 9; hh = (c0 - 2304) >> 6; }
    const unsigned dl = fq * 4;
    if (region == 2 || region == 5 || region == 8 || region == 7) {
      u16* vt = region == 2 ? p.vt_na() : (region == 5 ? p.vt_gqa() : (region == 7 ? p.kt_ml() : p.vt_ml()));
      const int H = region == 5 ? 2 : 4;
      const float mul = region == 7 ? 0.125f : 1.f;
      const unsigned Tlen = prm ? 256u : 1024u;
#pragma unroll
      for (int ai = 0; ai < 2; ++ai)
#pragma unroll
        for (int m = 0; m < 4; ++m) {
          const int row = rb + ai * 128 + m * 16;
          unsigned vbase;
          if (prm) vbase = (unsigned)(((row >> 8) * H + hh) * 64) * 256u + (unsigned)(row & 255);
          else { const int r = row - TP; vbase = (unsigned)(16 * H * 64 * 256) + (unsigned)((((r >> 10) * H + hh) * 64)) * 1024u + (unsigned)(r & 1023); }
          u16* vp = vt + vbase + dl * Tlen;
#pragma unroll
          for (int bj = 0; bj < 2; ++bj)
#pragma unroll
            for (int n = 0; n < 2; ++n)
#pragma unroll
              for (int j = 0; j < 4; ++j) vp[(unsigned)(bj * 32 + n * 16 + j) * Tlen] = f2bf(acc[ai][bj][m][n][j] * mul);
        }
    }
    if (prm && (region == 1 || region == 2 || region == 5)) {
#pragma unroll
      for (int ai = 0; ai < 2; ++ai)
#pragma unroll
        for (int m = 0; m < 4; ++m) {
          const int row = rb + ai * 128 + m * 16, b = row >> 8, t = row & 255;
          unsigned base;
          if (region == 5) base = (unsigned)O_GQA + (unsigned)((((b * 4 + l) * 2 + 1) * 2 + hh) * 256 + t) * 64u;
          else base = (unsigned)O_NA + (unsigned)((((b * 4 + l) * 2 + (region == 2 ? 1 : 0)) * 4 + hh) * 256 + t) * 64u;
          float* op = p.out + base + dl;
#pragma unroll
          for (int bj = 0; bj < 2; ++bj)
#pragma unroll
            for (int n = 0; n < 2; ++n) *(f32x4*)(op + bj * 32 + n * 16) = acc[ai][bj][m][n];
        }
    }
    if (region == 2 || region == 5 || region == 8) return;
    if (region == 3 || region == 4) {
      const float* gq = p.g_qk + (l * 2 + (region == 4 ? 1 : 0)) * 64 + dl;
      f32x4 gv[2][2];
#pragma unroll
      for (int bj = 0; bj < 2; ++bj)
#pragma unroll
        for (int n = 0; n < 2; ++n) gv[bj][n] = *(const f32x4*)(gq + bj * 32 + n * 16);
#pragma unroll
      for (int ai = 0; ai < 2; ++ai)
#pragma unroll
        for (int m = 0; m < 4; ++m) {
          const int row = rb + ai * 128 + m * 16;
          f32x4 v[2][2];
          float ss = 0.f;
#pragma unroll
          for (int bj = 0; bj < 2; ++bj)
#pragma unroll
            for (int n = 0; n < 2; ++n) {
              v[bj][n] = acc[ai][bj][m][n];
#pragma unroll
              for (int j = 0; j < 4; ++j) ss += v[bj][n][j] * v[bj][n][j];
            }
          ss += __shfl_xor(ss, 16);
          ss += __shfl_xor(ss, 32);
          const float rs = rsqrtf(ss * (1.f / 64.f) + EPS);
#pragma unroll
          for (int bj = 0; bj < 2; ++bj)
#pragma unroll
            for (int n = 0; n < 2; ++n) v[bj][n] = v[bj][n] * rs * gv[bj][n];
          if (prm) {
            if (region == 4) {
              const int b = row >> 8, t = row & 255;
              float* op = p.out + (unsigned)O_GQA + (unsigned)((((b * 4 + l) * 2 + 0) * 2 + hh) * 256 + t) * 64u + dl;
#pragma unroll
              for (int bj = 0; bj < 2; ++bj)
#pragma unroll
                for (int n = 0; n < 2; ++n) *(f32x4*)(op + bj * 32 + n * 16) = v[bj][n];
            }
          } else {
            const int t = (row - TP) & 1023, pr = t >> 6, pc = t & 63;
#pragma unroll
            for (int bj = 0; bj < 2; ++bj) {
              const int pos = bj ? pc : pr;
              const f32x4 cs = *(const f32x4*)(p.rope() + pos * 16 + dl), sn = *(const f32x4*)(p.rope() + 1024 + pos * 16 + dl);
              const f32x4 x1 = v[bj][0], x2 = v[bj][1];
              v[bj][0] = x1 * cs - x2 * sn;
              v[bj][1] = x2 * cs + x1 * sn;
            }
          }
          u16* zp = p.zb() + (unsigned)row * (unsigned)ZW + (unsigned)c0 + dl;
#pragma unroll
          for (int bj = 0; bj < 2; ++bj)
#pragma unroll
            for (int n = 0; n < 2; ++n) {
              uint2 w; w.x = pg8::cvt_pk_bf16(v[bj][n][0], v[bj][n][1]); w.y = pg8::cvt_pk_bf16(v[bj][n][2], v[bj][n][3]);
              *(uint2*)(zp + bj * 32 + n * 16) = w;
            }
        }
      return;
    }
    {
      const float mul = region == 7 ? 0.125f : 1.f;
#pragma unroll
      for (int ai = 0; ai < 2; ++ai)
#pragma unroll
        for (int m = 0; m < 4; ++m) {
          const int row = rb + ai * 128 + m * 16;
          u16* zp = p.zb() + (unsigned)row * (unsigned)ZW + (unsigned)c0 + dl;
#pragma unroll
          for (int bj = 0; bj < 2; ++bj)
#pragma unroll
            for (int n = 0; n < 2; ++n) {
              const f32x4 v = acc[ai][bj][m][n] * mul;
              uint2 w; w.x = pg8::cvt_pk_bf16(v[0], v[1]); w.y = pg8::cvt_pk_bf16(v[2], v[3]);
              *(uint2*)(zp + bj * 32 + n * 16) = w;
            }
        }
    }
  }
};

DI void phase_gemm(const P& p, int which, int l, char* smem) {
  PG8_LAS unsigned char* lds = (PG8_LAS unsigned char*)smem;
  pg8::StaticOrder S;
  pg8::Gemm g;
  if (which == 0) {
    g.A = p.hn(); g.Bt = p.wt_in() + (size_t)l * ZW * 1024; g.M = TT; g.N = ZW; g.K = 1024;
    S.init(g.M, g.N, p.nblk, blockIdx.x);
    EpiIn E; E.pp = &p; E.l = l;
    pg8::gemm_phase(lds, g, S, E);
  } else if (which == 1) {
    g.A = p.mix(); g.Bt = p.wt_out() + (size_t)l * 1024 * 1024; g.M = TT; g.N = 1024; g.K = 1024;
    S.init(g.M, g.N, p.nblk, blockIdx.x);
    EpiO E; E.C = (u16*)p.obuf();
    pg8::gemm_phase(lds, g, S, E);
  } else if (which == 2) {
    g.A = p.hn(); g.Bt = p.wt_gu() + (size_t)l * 5632 * 1024; g.M = TT; g.N = 5632; g.K = 1024;
    S.init(g.M, g.N, p.nblk, blockIdx.x);
    EpiGU E; E.act = p.act();
    pg8::gemm_phase(lds, g, S, E);
  } else {
    g.A = p.act(); g.Bt = p.wt_down() + (size_t)l * 1024 * FF; g.M = TT; g.N = 1024; g.K = FF;
    S.init(g.M, g.N, p.nblk, blockIdx.x);
    EpiO E; E.C = (u16*)p.obuf();
    pg8::gemm_phase(lds, g, S, E);
  }
}

template <bool WIN>
DI void attn_seg(const u16* __restrict__ K, int ldk, const u16* __restrict__ V, int ldv, int nkeys, const bf16x8 (&qf)[4][2],
                 f32x4 (&o)[4][4], float (&m)[4], float (&lsum)[4], const float* __restrict__ bias, int rdelta, int fr, int fq) {
  const float L2E = 1.44269504f;
  for (int key0 = 0; key0 < nkeys; key0 += 32) {
    bf16x8 kf[2][2];
#pragma unroll
    for (int mt = 0; mt < 2; ++mt)
#pragma unroll
      for (int ks = 0; ks < 2; ++ks) kf[mt][ks] = ld8(K + (size_t)(key0 + mt * 16 + fr) * ldk + ks * 32 + fq * 8);
    bf16x8 va[4];
#pragma unroll
    for (int dt = 0; dt < 4; ++dt) {
      const u16* vp = V + (size_t)(dt * 16 + fr) * ldv + key0 + fq * 4;
      va[dt] = ld4x2(vp, vp + 16);
    }
    f32x4 s[2][4];
#pragma unroll
    for (int mt = 0; mt < 2; ++mt)
#pragma unroll
      for (int nt = 0; nt < 4; ++nt) {
        s[mt][nt] = zero4();
#pragma unroll
        for (int ks = 0; ks < 2; ++ks) s[mt][nt] = MFMA16(kf[mt][ks], qf[nt][ks], s[mt][nt]);
      }
    const float SC = 0.125f * L2E;
    if (WIN) {
      const int krel = key0 >> 6, ckb = key0 & 63;
      const float* brow = bias + (rdelta + krel) * 31;
#pragma unroll
      for (int nt = 0; nt < 4; ++nt) {
        const int cq = nt * 16 + fr;
        const int cw = min(max(cq - 8, 0), 48);
#pragma unroll
        for (int mt = 0; mt < 2; ++mt)
#pragma unroll
          for (int j = 0; j < 4; ++j) {
            const int ck = ckb + mt * 16 + fq * 4 + j;
            const bool valid = (ck >= cw) && (ck < cw + 16);
            const int dc = min(max(ck - cq, -15), 15) + 15;
            const float bv = brow[dc];
            s[mt][nt][j] = valid ? (s[mt][nt][j] + bv * 8.f) : -INFINITY;
          }
      }
    }
    bf16x8 pb[4];
    float tmx[4];
    bool grow = false;
#pragma unroll
    for (int nt = 0; nt < 4; ++nt) {
      float tm = fmaxf(fmaxf(fmaxf(s[0][nt][0], s[0][nt][1]), fmaxf(s[0][nt][2], s[0][nt][3])),
                       fmaxf(fmaxf(s[1][nt][0], s[1][nt][1]), fmaxf(s[1][nt][2], s[1][nt][3])));
      tm = fmaxf(tm, __shfl_xor(tm, 16));
      tm = fmaxf(tm, __shfl_xor(tm, 32));
      tm *= SC;
      tmx[nt] = tm;
      grow = grow || (tm > m[nt] + 11.5f);
    }
    if (__any(grow)) {
#pragma unroll
      for (int nt = 0; nt < 4; ++nt) {
        const float mn = fmaxf(m[nt], tmx[nt]);
        const float alpha = __builtin_amdgcn_exp2f(m[nt] - mn);
        m[nt] = mn;
        lsum[nt] *= alpha;
#pragma unroll
        for (int dt = 0; dt < 4; ++dt) o[dt][nt] *= alpha;
      }
    }
#pragma unroll
    for (int nt = 0; nt < 4; ++nt) {
      const float nm = -m[nt];
      float ps = 0.f;
#pragma unroll
      for (int mt = 0; mt < 2; ++mt)
#pragma unroll
        for (int j = 0; j < 4; ++j) { float pv = __builtin_amdgcn_exp2f(__builtin_fmaf(s[mt][nt][j], SC, nm)); s[mt][nt][j] = pv; ps += pv; }
      lsum[nt] += ps;
      pb[nt] = pack8(s[0][nt], s[1][nt]);
    }
#pragma unroll
    for (int dt = 0; dt < 4; ++dt)
#pragma unroll
      for (int nt = 0; nt < 4; ++nt) o[dt][nt] = MFMA16(va[dt], pb[nt], o[dt][nt]);
  }
}

template <bool WIN>
DI void attn_wave(const u16* Q, int ldq, const u16* K0, int ldk0, const u16* V0, int ldv0, int n0, const u16* K1, int ldk1,
                  const u16* V1, int ldv1, int n1, u16* O, int ldo, const float* bias, int rdelta, int lane) {
  const int fr = lane & 15, fq = lane >> 4;
  bf16x8 qf[4][2];
#pragma unroll
  for (int nt = 0; nt < 4; ++nt)
#pragma unroll
    for (int ks = 0; ks < 2; ++ks) qf[nt][ks] = ld8(Q + (size_t)(nt * 16 + fr) * ldq + ks * 32 + fq * 8);
  f32x4 o[4][4];
  float m[4], lsum[4];
#pragma unroll
  for (int i = 0; i < 4; ++i) {
    m[i] = -1e30f; lsum[i] = 0.f;
#pragma unroll
    for (int j = 0; j < 4; ++j) o[i][j] = zero4();
  }
  attn_seg<WIN>(K0, ldk0, V0, ldv0, n0, qf, o, m, lsum, bias, rdelta, fr, fq);
  if (n1 > 0) attn_seg<false>(K1, ldk1, V1, ldv1, n1, qf, o, m, lsum, bias, rdelta, fr, fq);
#pragma unroll
  for (int nt = 0; nt < 4; ++nt) {
    float lt = lsum[nt];
    lt += __shfl_xor(lt, 16);
    lt += __shfl_xor(lt, 32);
    const float inv = 1.f / lt;
#pragma unroll
    for (int dt = 0; dt < 4; ++dt) {
      uint2 w; w.x = pack2(o[dt][nt][0] * inv, o[dt][nt][1] * inv); w.y = pack2(o[dt][nt][2] * inv, o[dt][nt][3] * inv);
      *(uint2*)(O + (size_t)(nt * 16 + fr) * ldo + dt * 16 + fq * 4) = w;
    }
  }
}

template <bool WIN>
DI void attn_block(LAS unsigned char* lds, int tid, const u16* Q, int ldq,
                   const u16* K0, int ldk0, const u16* V0, int ldv0, int nt0,
                   const u16* K1, int ldk1, const u16* V1, int ldv1, int nt1,
                   u16* O, int ldo, const LAS float* bias, int rdelta, int wlo) {
  const int lane = tid & 63, fr = lane & 15, fq = lane >> 4;
  const int wid = __builtin_amdgcn_readfirstlane(tid >> 6);
  const float L2E = 1.44269504f, SC = 0.125f * L2E;
  bf16x8 qf[4][2];
#pragma unroll
  for (int nt = 0; nt < 4; ++nt)
#pragma unroll
    for (int ks = 0; ks < 2; ++ks) qf[nt][ks] = ld8(Q + (size_t)(nt * 16 + fr) * ldq + ks * 32 + fq * 8);
  f32x4 o[4][4];
  float m[4], lsum[4];
#pragma unroll
  for (int i = 0; i < 4; ++i) {
    m[i] = -1e30f; lsum[i] = 0.f;
#pragma unroll
    for (int j = 0; j < 4; ++j) o[i][j] = zero4();
  }
  const int ntl = nt0 + nt1;
  const int rr = tid >> 3, pp = tid & 7, part = pp ^ (rr & 7);
#define AB_ISSUE(t) do { const int _t = (t); const u16* _k; const u16* _v; \
    if (_t < nt0) { _k = K0 + (size_t)(_t * 64 + rr) * ldk0 + part * 8; _v = V0 + (size_t)rr * ldv0 + _t * 64 + part * 8; } \
    else { _k = K1 + (size_t)((_t - nt0) * 64 + rr) * ldk1 + part * 8; _v = V1 + (size_t)rr * ldv1 + (_t - nt0) * 64 + part * 8; } \
    LAS unsigned char* _s = lds + (_t & 3) * 16384 + wid * 1024; \
    __builtin_amdgcn_global_load_lds((const unsigned*)_k, (LAS unsigned*)_s, 16, 0, 0); \
    __builtin_amdgcn_global_load_lds((const unsigned*)_v, (LAS unsigned*)(_s + 8192), 16, 0, 0); } while (0)
  if (0 < ntl) AB_ISSUE(0);
  if (1 < ntl) AB_ISSUE(1);
  if (2 < ntl) AB_ISSUE(2);
  for (int t = 0; t < ntl; ++t) {
    const int rem = ntl - 1 - t;
    if (rem >= 2) asm volatile("s_waitcnt vmcnt(4)" ::: "memory");
    else if (rem == 1) asm volatile("s_waitcnt vmcnt(2)" ::: "memory");
    else asm volatile("s_waitcnt vmcnt(0)" ::: "memory");
    __builtin_amdgcn_s_barrier();
    asm volatile("" ::: "memory");
    if (t + 3 < ntl) AB_ISSUE(t + 3);
    const bool win_tile = WIN && (t < nt0);
    if (win_tile && (t < wlo || t >= wlo + 8)) continue;
    const LAS unsigned char* sk = lds + (t & 3) * 16384;
    const LAS unsigned char* sv = sk + 8192;
    f32x4 s[2][2][4];
#pragma unroll
    for (int sub = 0; sub < 2; ++sub) {
      bf16x8 kf[2][2];
#pragma unroll
      for (int mt = 0; mt < 2; ++mt)
#pragma unroll
        for (int ks = 0; ks < 2; ++ks) {
          const int key = sub * 32 + mt * 16 + fr;
          kf[mt][ks] = *(const LAS bf16x8*)(sk + key * 128 + (((ks * 4 + fq) ^ (key & 7)) << 4));
        }
#pragma unroll
      for (int mt = 0; mt < 2; ++mt)
#pragma unroll
        for (int nt = 0; nt < 4; ++nt) {
          s[sub][mt][nt] = zero4();
#pragma unroll
          for (int ks = 0; ks < 2; ++ks) s[sub][mt][nt] = MFMA16(kf[mt][ks], qf[nt][ks], s[sub][mt][nt]);
        }
    }
    if (win_tile) {
      const LAS float* brow = bias + (rdelta + (t - wlo)) * 31;
#pragma unroll
      for (int sub = 0; sub < 2; ++sub)
#pragma unroll
        for (int nt = 0; nt < 4; ++nt) {
          const int cq = nt * 16 + fr;
          const int cw = min(max(cq - 8, 0), 48);
#pragma unroll
          for (int mt = 0; mt < 2; ++mt)
#pragma unroll
            for (int j = 0; j < 4; ++j) {
              const int ck = sub * 32 + mt * 16 + fq * 4 + j;
              const bool valid = (ck >= cw) && (ck < cw + 16);
              const int dc = min(max(ck - cq, -15), 15) + 15;
              const float bv = brow[dc];
              s[sub][mt][nt][j] = valid ? (s[sub][mt][nt][j] + bv * 8.f) : -INFINITY;
            }
        }
    }
    float tmx[4];
    bool grow = false;
#pragma unroll
    for (int nt = 0; nt < 4; ++nt) {
      float tm = -INFINITY;
#pragma unroll
      for (int sub = 0; sub < 2; ++sub)
#pragma unroll
        for (int mt = 0; mt < 2; ++mt)
          tm = fmaxf(tm, fmaxf(fmaxf(s[sub][mt][nt][0], s[sub][mt][nt][1]), fmaxf(s[sub][mt][nt][2], s[sub][mt][nt][3])));
      tm = fmaxf(tm, __shfl_xor(tm, 16));
      tm = fmaxf(tm, __shfl_xor(tm, 32));
      tm *= SC;
      tmx[nt] = tm;
      grow = grow || (tm > m[nt] + 11.5f);
    }
    if (__any(grow)) {
#pragma unroll
      for (int nt = 0; nt < 4; ++nt) {
        const float mn = fmaxf(m[nt], tmx[nt]);
        const float alpha = __builtin_amdgcn_exp2f(m[nt] - mn);
        m[nt] = mn;
        lsum[nt] *= alpha;
#pragma unroll
        for (int dt = 0; dt < 4; ++dt) o[dt][nt] *= alpha;
      }
    }
#pragma unroll
    for (int sub = 0; sub < 2; ++sub) {
      bf16x8 pb[4];
#pragma unroll
      for (int nt = 0; nt < 4; ++nt) {
        const float nm = -m[nt];
        float ps = 0.f;
#pragma unroll
        for (int mt = 0; mt < 2; ++mt)
#pragma unroll
          for (int j = 0; j < 4; ++j) { float pv = __builtin_amdgcn_exp2f(__builtin_fmaf(s[sub][mt][nt][j], SC, nm)); s[sub][mt][nt][j] = pv; ps += pv; }
        lsum[nt] += ps;
        pb[nt] = pack8(s[sub][0][nt], s[sub][1][nt]);
      }
      bf16x8 va[4];
#pragma unroll
      for (int dt = 0; dt < 4; ++dt) {
        const int d = dt * 16 + fr, q1 = sub * 4 + (fq >> 1);
        const u32x2 a = *(const LAS u32x2*)(sv + d * 128 + ((q1 ^ (d & 7)) << 4) + (fq & 1) * 8);
        const u32x2 b = *(const LAS u32x2*)(sv + d * 128 + (((q1 + 2) ^ (d & 7)) << 4) + (fq & 1) * 8);
        u32x4 r4; r4.x = a.x; r4.y = a.y; r4.z = b.x; r4.w = b.y;
        va[dt] = __builtin_bit_cast(bf16x8, r4);
      }
#pragma unroll
      for (int dt = 0; dt < 4; ++dt)
#pragma unroll
        for (int nt = 0; nt < 4; ++nt) o[dt][nt] = MFMA16(va[dt], pb[nt], o[dt][nt]);
    }
  }
#undef AB_ISSUE
#pragma unroll
  for (int nt = 0; nt < 4; ++nt) {
    float lt = lsum[nt];
    lt += __shfl_xor(lt, 16);
    lt += __shfl_xor(lt, 32);
    const float inv = 1.f / lt;
#pragma unroll
    for (int dt = 0; dt < 4; ++dt) {
      uint2 w; w.x = pack2(o[dt][nt][0] * inv, o[dt][nt][1] * inv); w.y = pack2(o[dt][nt][2] * inv, o[dt][nt][3] * inv);
      *(uint2*)(O + (size_t)(nt * 16 + fr) * ldo + dt * 16 + fq * 4) = w;
    }
  }
}

DI float logsig(float x) { return fminf(x, 0.f) - __logf(1.f + __expf(-fabsf(x))); }

DI void mlstm_item(const P& p, int l, int u, char* smem, int tid, int stages, int cdbase, int ugrp) {
  const int wid = tid >> 6;
  const bool samp = u < 32;
  int b, h, NC, rowbase, ldT, cs0;
  size_t tb;
  if (samp) { b = u >> 2; h = u & 3; NC = 16; rowbase = TP + b * 1024; ldT = 1024; tb = 1048576 + (size_t)((b * 4 + h) * 64) * 1024; cs0 = u * 32; }
  else { int v = u - 32; b = v >> 2; h = v & 3; NC = 4; rowbase = b * 256; ldT = 256; tb = (size_t)((b * 4 + h) * 64) * 256; cs0 = 1024 + v * 8; }
  float* fl = (float*)smem + wid * 768;
  float* W = fl;
  float* U = fl + 64;
  float* MX = fl + 192;
  float* DEC = fl + 320;
  float* EN = fl + 448;
  float* NQ = fl + 576;

  if (stages & 1)
  for (int cd = cdbase + wid; cd < NC * 2 && cd < cdbase + 8; cd += 8) {
    int lane = tid & 63;
    asm volatile("" : "+v"(lane));
    const int fr = lane & 15, fq = lane >> 4;
    const int j = cd >> 1, dir = cd & 1;
    const int cs = cs0 + dir * NC + j;
    const int row = rowbase + j * 64 + lane;
    const float gi = p.gates()[(size_t)row * 16 + dir * 8 + h], gf = p.gates()[(size_t)row * 16 + dir * 8 + 4 + h];
    float bb = logsig(gf);
    if (dir == 0) {
#pragma unroll
      for (int off = 1; off < 64; off <<= 1) { float t = __shfl_up(bb, off); if (lane >= off) bb += t; }
    } else {
#pragma unroll
      for (int off = 1; off < 64; off <<= 1) { float t = __shfl_down(bb, off); if (lane + off < 64) bb += t; }
    }
    const float bend = __shfl(bb, dir ? 0 : 63);
    const float lw = bend - bb + gi;
    const float a = wave_max(lw);
    W[lane] = __expf(lw - a);
    wave_sync();
    f32x4 acc[4][4];
#pragma unroll
    for (int i = 0; i < 4; ++i)
#pragma unroll
      for (int jj = 0; jj < 4; ++jj) acc[i][jj] = zero4();
    const u16* vt = p.vt_ml() + tb + j * 64;
    const u16* kt = p.kt_ml() + tb + j * 64;
#pragma unroll 1
    for (int ks = 0; ks < 2; ++ks) {
      const float4 w0 = *(const float4*)(W + ks * 32 + fq * 8), w1 = *(const float4*)(W + ks * 32 + fq * 8 + 4);
      bf16x8 af[4], bfr[4];
#pragma unroll
      for (int mt = 0; mt < 4; ++mt) {
        bf16x8 raw = ld8(vt + (size_t)(mt * 16 + fr) * ldT + ks * 32 + fq * 8);
        f32x4 lo, hi;
        lo[0] = bf2f((u16)raw[0]) * w0.x; lo[1] = bf2f((u16)raw[1]) * w0.y; lo[2] = bf2f((u16)raw[2]) * w0.z; lo[3] = bf2f((u16)raw[3]) * w0.w;
        hi[0] = bf2f((u16)raw[4]) * w1.x; hi[1] = bf2f((u16)raw[5]) * w1.y; hi[2] = bf2f((u16)raw[6]) * w1.z; hi[3] = bf2f((u16)raw[7]) * w1.w;
        af[mt] = pack8(lo, hi);
      }
#pragma unroll
      for (int nt = 0; nt < 4; ++nt) bfr[nt] = ld8(kt + (size_t)(nt * 16 + fr) * ldT + ks * 32 + fq * 8);
#pragma unroll
      for (int mt = 0; mt < 4; ++mt)
#pragma unroll
        for (int nt = 0; nt < 4; ++nt) acc[mt][nt] = MFMA16(af[mt], bfr[nt], acc[mt][nt]);
    }
    float* ch = p.ml_chat() + (size_t)cs * 4096;
#pragma unroll
    for (int mt = 0; mt < 4; ++mt)
#pragma unroll
      for (int nt = 0; nt < 4; ++nt)
#pragma unroll
        for (int jj = 0; jj < 4; ++jj) ch[(mt * 16 + fq * 4 + jj) * 64 + nt * 16 + fr] = acc[mt][nt][jj];
    float nh = 0.f;
    const u16* kr = kt + (size_t)lane * ldT;
#pragma unroll 1
    for (int c8 = 0; c8 < 8; ++c8) {
      bf16x8 kk = ld8(kr + c8 * 8);
      const float4 wa = *(const float4*)(W + c8 * 8), wb = *(const float4*)(W + c8 * 8 + 4);
      nh += bf2f((u16)kk[0]) * wa.x + bf2f((u16)kk[1]) * wa.y + bf2f((u16)kk[2]) * wa.z + bf2f((u16)kk[3]) * wa.w;
      nh += bf2f((u16)kk[4]) * wb.x + bf2f((u16)kk[5]) * wb.y + bf2f((u16)kk[6]) * wb.z + bf2f((u16)kk[7]) * wb.w;
    }
    p.ml_nhat()[(size_t)cs * 64 + lane] = nh;
    if (lane == 0) { p.ml_ab()[cs * 2] = a; p.ml_ab()[cs * 2 + 1] = bend; }
    wave_sync();
  }
  __syncthreads();

  if (stages & 2) {
    const int dir = tid >> 8, tt = tid & 255, e0 = tt * 16;
    float C[16];
    float n = 0.f, m = 0.f;
    const int sidx = ((b * 4 + l) * 2 + dir) * 4 + h;
    if (samp) {
#pragma unroll
      for (int i = 0; i < 4; ++i) {
        float4 v = *(const float4*)(p.stC + (size_t)sidx * 4096 + e0 + i * 4);
        C[i * 4] = v.x; C[i * 4 + 1] = v.y; C[i * 4 + 2] = v.z; C[i * 4 + 3] = v.w;
      }
      if (tt < 64) n = p.stn[sidx * 64 + tt];
      m = p.stm[sidx];
    } else {
#pragma unroll
      for (int i = 0; i < 16; ++i) { float z = 0.f; asm volatile("" : "+v"(z)); C[i] = z; }
    }
    for (int c4 = 0; c4 < NC; c4 += 4) {
      float4 chv[4][4];
      float av[4], bev[4], nhv[4];
#pragma unroll
      for (int q = 0; q < 4; ++q) {
        const int c = c4 + q, j = dir ? NC - 1 - c : c, cs = cs0 + dir * NC + j;
        av[q] = p.ml_ab()[cs * 2]; bev[q] = p.ml_ab()[cs * 2 + 1];
        nhv[q] = tt < 64 ? p.ml_nhat()[(size_t)cs * 64 + tt] : 0.f;
        const float* ch = p.ml_chat() + (size_t)cs * 4096 + e0;
#pragma unroll
        for (int i = 0; i < 4; ++i) chv[q][i] = *(const float4*)(ch + i * 4);
      }
#pragma unroll
      for (int q = 0; q < 4; ++q) {
        const int c = c4 + q, j = dir ? NC - 1 - c : c, cs = cs0 + dir * NC + j;
        uint4 w0, w1;
        w0.x = pack2(C[0], C[1]); w0.y = pack2(C[2], C[3]); w0.z = pack2(C[4], C[5]); w0.w = pack2(C[6], C[7]);
        w1.x = pack2(C[8], C[9]); w1.y = pack2(C[10], C[11]); w1.z = pack2(C[12], C[13]); w1.w = pack2(C[14], C[15]);
        *(uint4*)(p.ml_cst() + (size_t)cs * 4096 + e0) = w0;
        *(uint4*)(p.ml_cst() + (size_t)cs * 4096 + e0 + 8) = w1;
        if (tt < 64) p.ml_nst()[(size_t)cs * 64 + tt] = n;
        if (tt == 0) p.ml_mst()[cs] = m;
        const float mn = fmaxf(bev[q] + m, av[q]);
        const float carry = __expf(bev[q] + m - mn), beta = __expf(av[q] - mn);
#pragma unroll
        for (int i = 0; i < 4; ++i) {
          C[i * 4] = carry * C[i * 4] + beta * chv[q][i].x; C[i * 4 + 1] = carry * C[i * 4 + 1] + beta * chv[q][i].y;
          C[i * 4 + 2] = carry * C[i * 4 + 2] + beta * chv[q][i].z; C[i * 4 + 3] = carry * C[i * 4 + 3] + beta * chv[q][i].w;
        }
        n = carry * n + beta * nhv[q];
        m = mn;
      }
    }
    if (!samp) {
      float* oc = p.out + O_C + (size_t)sidx * 4096 + e0;
#pragma unroll
      for (int i = 0; i < 4; ++i) { float4 v; v.x = C[i * 4]; v.y = C[i * 4 + 1]; v.z = C[i * 4 + 2]; v.w = C[i * 4 + 3]; *(float4*)(oc + i * 4) = v; }
      if (tt < 64) p.out[O_N + (size_t)sidx * 64 + tt] = n;
      if (tt == 0) p.out[O_M + sidx] = m;
    }
  }
  __syncthreads();

  if (stages & 4)
  for (int uu = ugrp * 8 + wid; uu < NC * 2 && uu < ugrp * 8 + 8; uu += 8) {
    const int j = uu >> 1, half0 = uu & 1;
    int lane = tid & 63;
    asm volatile("" : "+v"(lane));
    const int fr = lane & 15, fq = lane >> 4;
    const int row = rowbase + j * 64 + lane;
    for (int dir = 0; dir < 2; ++dir) {
      const int cs = cs0 + dir * NC + j;
      const float m0 = p.ml_mst()[cs];
      const float gi = p.gates()[(size_t)row * 16 + dir * 8 + h], gf = p.gates()[(size_t)row * 16 + dir * 8 + 4 + h];
      float bb = logsig(gf);
      if (dir == 0) {
#pragma unroll
        for (int off = 1; off < 64; off <<= 1) { float t = __shfl_up(bb, off); if (lane >= off) bb += t; }
      } else {
#pragma unroll
        for (int off = 1; off < 64; off <<= 1) { float t = __shfl_down(bb, off); if (lane + off < 64) bb += t; }
      }
      const float uu = gi - bb;
      float cm = uu;
      if (dir == 0) {
#pragma unroll
        for (int off = 1; off < 64; off <<= 1) { float t = __shfl_up(cm, off); if (lane >= off) cm = fmaxf(cm, t); }
      } else {
#pragma unroll
        for (int off = 1; off < 64; off <<= 1) { float t = __shfl_down(cm, off); if (lane + off < 64) cm = fmaxf(cm, t); }
      }
      const float M = fmaxf(cm, m0);
      U[dir * 64 + lane] = uu;
      MX[dir * 64 + lane] = M;
      DEC[dir * 64 + lane] = __expf(m0 - M);
      EN[dir * 64 + lane] = __expf(-(bb + M));
      const u16* qr = p.zb() + (size_t)row * ZW + 1536 + h * 64;
      const float* ns = p.ml_nst() + (size_t)cs * 64;
      float nq = 0.f;
#pragma unroll
      for (int c8 = 0; c8 < 8; ++c8) {
        bf16x8 qq = ld8(qr + c8 * 8);
#pragma unroll
        for (int jj = 0; jj < 8; ++jj) nq += bf2f((u16)qq[jj]) * ns[c8 * 8 + jj];
      }
      NQ[dir * 64 + lane] = nq;
    }
    wave_sync();
#pragma unroll 1
    for (int half = half0; half < half0 + 1; ++half) {
      int lane_h = lane;
      asm volatile("" : "+v"(lane_h));
      const int fr = lane_h & 15, fq = lane_h >> 4;
      bf16x8 qf[2][2];
#pragma unroll
      for (int nt = 0; nt < 2; ++nt)
#pragma unroll
        for (int ks = 0; ks < 2; ++ks)
          qf[nt][ks] = ld8(p.zb() + (size_t)(rowbase + j * 64 + half * 32 + nt * 16 + fr) * ZW + 1536 + h * 64 + ks * 32 + fq * 8);
      f32x4 hs[4][2];
#pragma unroll
      for (int i = 0; i < 4; ++i) { hs[i][0] = zero4(); hs[i][1] = zero4(); }
#pragma unroll 1
      for (int dir = 0; dir < 2; ++dir) {
        const int cs = cs0 + dir * NC + j;
        f32x4 acc[4][2];
#pragma unroll
        for (int i = 0; i < 4; ++i) { acc[i][0] = zero4(); acc[i][1] = zero4(); }
        const u16* cst = p.ml_cst() + (size_t)cs * 4096;
#pragma unroll
        for (int ks = 0; ks < 2; ++ks)
#pragma unroll
          for (int dt = 0; dt < 4; ++dt) {
            bf16x8 cf = ld8(cst + (dt * 16 + fr) * 64 + ks * 32 + fq * 8);
#pragma unroll
            for (int nt = 0; nt < 2; ++nt) acc[dt][nt] = MFMA16(cf, qf[nt][ks], acc[dt][nt]);
          }
        float dec[2], Mt[2], dsum[2];
#pragma unroll
        for (int nt = 0; nt < 2; ++nt) {
          const int t = half * 32 + nt * 16 + fr;
          dec[nt] = DEC[dir * 64 + t]; Mt[nt] = MX[dir * 64 + t]; dsum[nt] = 0.f;
#pragma unroll
          for (int dt = 0; dt < 4; ++dt) acc[dt][nt] *= dec[nt];
        }
#pragma unroll 1
        for (int sk = 0; sk < 2; ++sk) {
          bf16x8 kf[2][2];
#pragma unroll
          for (int mt = 0; mt < 2; ++mt)
#pragma unroll
            for (int ks = 0; ks < 2; ++ks)
              kf[mt][ks] = ld8(p.zb() + (size_t)(rowbase + j * 64 + sk * 32 + mt * 16 + fr) * ZW + 1792 + h * 64 + ks * 32 + fq * 8);
          f32x4 s[2][2];
#pragma unroll
          for (int mt = 0; mt < 2; ++mt)
#pragma unroll
            for (int nt = 0; nt < 2; ++nt) {
              s[mt][nt] = zero4();
#pragma unroll
              for (int ks = 0; ks < 2; ++ks) s[mt][nt] = MFMA16(kf[mt][ks], qf[nt][ks], s[mt][nt]);
            }
#pragma unroll
          for (int mt = 0; mt < 2; ++mt) {
            const float4 u4 = *(const float4*)(U + dir * 64 + sk * 32 + mt * 16 + fq * 4);
            const float uv[4] = {u4.x, u4.y, u4.z, u4.w};
#pragma unroll
            for (int jj = 0; jj < 4; ++jj) {
              const int stok = sk * 32 + mt * 16 + fq * 4 + jj;
#pragma unroll
              for (int nt = 0; nt < 2; ++nt) {
                const int t = half * 32 + nt * 16 + fr;
                const bool valid = dir ? (stok >= t) : (stok <= t);
                const float w = valid ? __expf(uv[jj] - Mt[nt]) : 0.f;
                const float pv = s[mt][nt][jj] * w;
                s[mt][nt][jj] = pv;
                dsum[nt] += pv;
              }
            }
          }
          bf16x8 pb[2];
#pragma unroll
          for (int nt = 0; nt < 2; ++nt) pb[nt] = pack8(s[0][nt], s[1][nt]);
#pragma unroll
          for (int dt = 0; dt < 4; ++dt) {
            const u16* vp = p.vt_ml() + tb + (size_t)(dt * 16 + fr) * ldT + j * 64 + sk * 32 + fq * 4;
            bf16x8 va = ld4x2(vp, vp + 16);
#pragma unroll
            for (int nt = 0; nt < 2; ++nt) acc[dt][nt] = MFMA16(va, pb[nt], acc[dt][nt]);
          }
        }
#pragma unroll
        for (int nt = 0; nt < 2; ++nt) {
          const int t = half * 32 + nt * 16 + fr;
          float ds = dsum[nt];
          ds += __shfl_xor(ds, 16);
          ds += __shfl_xor(ds, 32);
          const float den = ds + dec[nt] * NQ[dir * 64 + t];
          const float dv = 1.f / fmaxf(fabsf(den), EN[dir * 64 + t]);
#pragma unroll
          for (int dt = 0; dt < 4; ++dt) hs[dt][nt] += acc[dt][nt] * dv;
        }
      }
#pragma unroll
      for (int nt = 0; nt < 2; ++nt) {
        float ss = 0.f;
#pragma unroll
        for (int dt = 0; dt < 4; ++dt)
#pragma unroll
          for (int jj = 0; jj < 4; ++jj) ss += hs[dt][nt][jj] * hs[dt][nt][jj];
        ss += __shfl_xor(ss, 16);
        ss += __shfl_xor(ss, 32);
        const float rs = rsqrtf(ss * (1.f / 64.f) + EPS);
        const int orow = rowbase + j * 64 + half * 32 + nt * 16 + fr;
#pragma unroll
        for (int dt = 0; dt < 4; ++dt) {
          const int v0 = dt * 16 + fq * 4;
          const float4 gn = *(const float4*)(p.g_ml + l * 256 + h * 64 + v0);
          const uint2 mo = *(const uint2*)(p.zb() + (size_t)orow * ZW + 2304 + h * 64 + v0);
          const float o0 = bf2f((u16)(mo.x & 0xffff)), o1 = bf2f((u16)(mo.x >> 16)), o2 = bf2f((u16)(mo.y & 0xffff)), o3 = bf2f((u16)(mo.y >> 16));
          const float r0 = hs[dt][nt][0] * rs * gn.x / (1.f + __expf(-o0));
          const float r1 = hs[dt][nt][1] * rs * gn.y / (1.f + __expf(-o1));
          const float r2 = hs[dt][nt][2] * rs * gn.z / (1.f + __expf(-o2));
          const float r3 = hs[dt][nt][3] * rs * gn.w / (1.f + __expf(-o3));
          uint2 w; w.x = pack2(r0, r1); w.y = pack2(r2, r3);
          *(uint2*)(p.mix() + (size_t)orow * 1024 + 768 + h * 64 + v0) = w;
        }
      }
    }
    wave_sync();
  }
  __syncthreads();
}

#define QCTR_BASE XCD_BAR_WORDS
#define BAR_TOTAL_WORDS (XCD_BAR_WORDS + 4 * 64)
DI void phase_mix(const P& p, int l, char* smem, int tid0) {
  volatile LAS int* sit = (volatile LAS int*)((LAS char*)smem + STAGE_LDS + 64);
  for (;;) {
    __syncthreads();
    if (tid0 == 0) *sit = (int)atomicAdd(&p.bar()[QCTR_BASE + l * 64], 1u);
    __syncthreads();
    const int it = *sit;
    if (it >= 480) break;
    int tv = tid0;
    asm volatile("" : "+v"(tv));
    const int wid = tv >> 6, lane = tv & 63;
    if (it >= 192 && it < 320) {
      mlstm_item(p, l, (it - 192) >> 2, smem, tv, 6, 0, (it - 192) & 3);
    } else if (it < 128) {
      const int x = it, b = x >> 4, kvh = (x >> 3) & 1, qt = (x & 7) * 2 + (wid >> 2), head = kvh * 4 + (wid & 3);
      const int rowbase = TP + b * 1024;
      const int ci = (b * 4 + l) * 2 + kvh;
      attn_block<false>((LAS unsigned char*)smem, tv, p.zb() + (size_t)(rowbase + qt * 64) * ZW + 768 + head * 64, ZW,
                        p.zb() + (size_t)rowbase * ZW + 1280 + kvh * 64, ZW, p.vt_gqa() + 524288 + (size_t)((b * 2 + kvh) * 64) * 1024, 1024, 16,
                        p.kc_gqa() + (size_t)ci * 16384, 64, p.vct_gqa() + (size_t)ci * 16384, 256, 4,
                        p.mix() + (size_t)(rowbase + qt * 64) * 1024 + 256 + head * 64, 1024, nullptr, 0, 0);
    } else if (it < 192) {
      const int x = it - 128, b = x >> 3, h = (x >> 1) & 3, rg = x & 1, r = rg * 8 + wid;
      const int rowbase = TP + b * 1024;
      const int r0 = min(max(r - 4, 0), 8);
      const int ulo = rg ? 4 : 0, nt0 = rg ? 12 : 11;
      const int ci = (b * 4 + l) * 4 + h;
      LAS float* btab = (LAS float*)((LAS char*)smem + 65536);
      for (int i = tv; i < 15 * 31; i += NTHR) btab[i] = p.na_bias[(size_t)(l * 4 + h) * 15 * 31 + i];
      __syncthreads();
      attn_block<true>((LAS unsigned char*)smem, tv, p.zb() + (size_t)(rowbase + r * 64) * ZW + h * 64, ZW,
                       p.zb() + (size_t)(rowbase + ulo * 64) * ZW + 256 + h * 64, ZW, p.vt_na() + 1048576 + (size_t)((b * 4 + h) * 64) * 1024 + ulo * 64, 1024, nt0,
                       p.kc_na() + (size_t)ci * 16384, 64, p.vct_na() + (size_t)ci * 16384, 256, 4,
                       p.mix() + (size_t)(rowbase + r * 64) * 1024 + h * 64, 1024, btab, r0 - r + 7, r0 - ulo);
    } else if (it < 384) {
      mlstm_item(p, l, 32 + (it - 320), smem, tv, 6, 0, 0);
    } else if (it < 448) {
      const int x = it - 384, b = x >> 2, kvh = (x >> 1) & 1, qt = (x & 1) * 2 + (wid >> 2), head = kvh * 4 + (wid & 3);
      const int rowbase = b * 256;
      attn_block<false>((LAS unsigned char*)smem, tv, p.zb() + (size_t)(rowbase + qt * 64) * ZW + 768 + head * 64, ZW,
                        p.zb() + (size_t)rowbase * ZW + 1280 + kvh * 64, ZW, p.vt_gqa() + (size_t)((b * 2 + kvh) * 64) * 256, 256, 4,
                        nullptr, 0, nullptr, 0, 0,
                        p.mix() + (size_t)(rowbase + qt * 64) * 1024 + 256 + head * 64, 1024, nullptr, 0, 0);
    } else {
      const int x = it - 448, b = x >> 1, h = (x & 1) * 2 + (wid >> 2), qt = wid & 3;
      const int rowbase = b * 256;
      attn_wave<false>(p.zb() + (size_t)(rowbase + qt * 64) * ZW + h * 64, ZW,
                       p.zb() + (size_t)rowbase * ZW + 256 + h * 64, ZW, p.vt_na() + (size_t)((b * 4 + h) * 64) * 256, 256, 256,
                       nullptr, 0, nullptr, 0, 0,
                       p.mix() + (size_t)(rowbase + qt * 64) * 1024 + h * 64, 1024, nullptr, 0, lane);
    }
  }
}

DI void phase_ml1(const P& p, int l, char* smem, int tid0) {
  for (int bi = blockIdx.x; bi < 192; bi += p.nblk) {
    int tv = tid0;
    asm volatile("" : "+v"(tv));
    if (bi < 128) mlstm_item(p, l, bi >> 2, smem, tv, 1, (bi & 3) * 8, 0);
    else mlstm_item(p, l, 32 + (bi - 128), smem, tv, 1, 0, 0);
  }
}

DI void run_phase(const P& p, int ph, int l, char* smem) {
  int tid = threadIdx.x;
  asm volatile("" : "+v"(tid));
  switch (ph) {
    case 0: phase_init(p, smem, tid); break;
    case 1: phase_row(p, 0, 0, smem, tid); break;
    case 2: phase_gemm(p, 0, l, smem); break;
    case 3: phase_ml1(p, l, smem, tid); break;
    case 4: phase_mix(p, l, smem, tid); break;
    case 5: phase_gemm(p, 1, l, smem); break;
    case 6: phase_row(p, 1, l, smem, tid); break;
    case 7: phase_gemm(p, 2, l, smem); break;
    case 8: phase_gemm(p, 3, l, smem); break;
    default: phase_row(p, 2, l, smem, tid); break;
  }
}

#if !ONE_LAUNCH
__global__ void __launch_bounds__(512, 2) k_phase(P p, int ph, int l) {
  extern __shared__ __attribute__((aligned(16))) char smem[];
  run_phase(p, ph, l, smem);
}
#else
__global__ void __launch_bounds__(512, 2) k_mega(P p) {
  extern __shared__ __attribute__((aligned(16))) char smem[];
  uint4* xbw = (uint4*)(smem + STAGE_LDS);
  if (threadIdx.x == 0) *xbw = make_uint4(0u, 0u, 0u, 0u);
  __syncthreads();
  XcdBarrier xb = xcd_barrier_post(p.bar(), (volatile LAS unsigned*)xbw, (unsigned)p.nblk);
#if TPROBE
  unsigned long long* ts = (unsigned long long*)(p.bar() + BAR_TOTAL_WORDS);
  const bool rec = blockIdx.x == 0 && threadIdx.x == 0;
  if (rec) ts[0] = __builtin_amdgcn_s_memrealtime();
#endif
  run_phase(p, 0, 0, smem);
  xcd_barrier(xb);
#if TPROBE
  if (rec) ts[1] = __builtin_amdgcn_s_memrealtime();
#endif
  run_phase(p, 1, 0, smem);
#if TPROBE
#define TSREC(ph) if (rec) ts[2 + l * 8 + ((ph) - 2)] = __builtin_amdgcn_s_memrealtime();
#else
#define TSREC(ph)
#endif
#pragma unroll 1
  for (int l = 0; l < 4; ++l) {
    xcd_barrier(xb); TSREC(2) run_phase(p, 2, l, smem);
    xcd_barrier(xb); TSREC(3) run_phase(p, 3, l, smem);
    xcd_barrier(xb); TSREC(4) run_phase(p, 4, l, smem);
    xcd_barrier(xb); TSREC(5) run_phase(p, 5, l, smem);
    xcd_barrier(xb); TSREC(6) run_phase(p, 6, l, smem);
    xcd_barrier(xb); TSREC(7) run_phase(p, 7, l, smem);
    xcd_barrier(xb); TSREC(8) run_phase(p, 8, l, smem);
    xcd_barrier(xb); TSREC(9) run_phase(p, 9, l, smem);
  }
#if TPROBE
  xcd_barrier(xb);
  if (rec) {
    ts[34] = __builtin_amdgcn_s_memrealtime();
    unsigned long long sum = 0;
    for (int i = 0; i < 34; ++i) {
      int ph = i < 2 ? i : 2 + (i - 2) % 8;
      if ((TPROBE >> ph) & 1) sum += ts[i + 1] - ts[i];
    }
    p.out[0] += TQ * floorf((float)sum * 0.01f * (1.f / TQ));
  }
#endif
}
#endif

extern "C" void kernel_launch(void* const* d_in, const int* in_sizes, int n_in, void* d_out, int out_size, void* d_ws,
                              size_t ws_size, hipStream_t stream) {
  P p{};
  p.x_prompt = (const float*)d_in[0]; p.x_sample = (const float*)d_in[1]; p.cache_na = (const float*)d_in[2];
  p.cache_gqa = (const float*)d_in[3]; p.stC = (const float*)d_in[4]; p.stn = (const float*)d_in[5]; p.stm = (const float*)d_in[6];
  p.c = (const float*)d_in[7]; p.c_ctx = (const float*)d_in[8]; p.w_in = (const float*)d_in[9]; p.b_gates = (const float*)d_in[10];
  p.w_out = (const float*)d_in[11]; p.g_norm = (const float*)d_in[12]; p.g_qk = (const float*)d_in[13]; p.g_ml = (const float*)d_in[14];
  p.na_bias = (const float*)d_in[15]; p.w_ada = (const float*)d_in[16]; p.b_ada = (const float*)d_in[17]; p.w_gu = (const float*)d_in[18];
  p.w_down = (const float*)d_in[19];
  p.out = (float*)d_out;
  p.ws = (char*)d_ws;
  if (WS_TOTAL_X > ws_size) { fprintf(stderr, "workspace too small: need %zu have %zu\n", (size_t)WS_TOTAL, ws_size); return; }

  static int grid_blocks = 0;
  if (!grid_blocks) {
    int dev = 0, cus = 0, per_cu = 0;
    (void)hipGetDevice(&dev);
    (void)hipDeviceGetAttribute(&cus, hipDeviceAttributeMultiprocessorCount, dev);
#if ONE_LAUNCH
    (void)hipFuncSetAttribute((const void*)k_mega, hipFuncAttributeMaxDynamicSharedMemorySize, DYN_LDS);
    (void)hipOccupancyMaxActiveBlocksPerMultiprocessor(&per_cu, k_mega, NTHR, DYN_LDS);
#else
    (void)hipFuncSetAttribute((const void*)k_phase, hipFuncAttributeMaxDynamicSharedMemorySize, DYN_LDS);
    (void)hipOccupancyMaxActiveBlocksPerMultiprocessor(&per_cu, k_phase, NTHR, DYN_LDS);
#endif
    if (per_cu < 1) { fprintf(stderr, "occupancy query returned %d\n", per_cu); per_cu = 1; }
    if (per_cu > 1) per_cu = 1;
    grid_blocks = cus * per_cu;
  }
  p.nblk = grid_blocks;
  (void)hipMemsetAsync(p.bar(), 0, (size_t)BAR_TOTAL_WORDS * 4, stream);
#if ONE_LAUNCH
  void* args[] = {&p};
  hipError_t e = hipLaunchCooperativeKernel((void*)k_mega, dim3(grid_blocks), dim3(NTHR), args, DYN_LDS, stream);
  if (e != hipSuccess) fprintf(stderr, "cooperative launch failed: %s (grid %d)\n", hipGetErrorString(e), grid_blocks);
#else
  k_phase<<<grid_blocks, NTHR, DYN_LDS, stream>>>(p, 0, 0);
  k_phase<<<grid_blocks, NTHR, DYN_LDS, stream>>>(p, 1, 0);
  for (int l = 0; l < 4; ++l)
    for (int ph = 2; ph <= 9; ++ph) k_phase<<<grid_blocks, NTHR, DYN_LDS, stream>>>(p, ph, l);
#endif
}
```

```cpp
#include <hip/hip_runtime.h>
#include <stdint.h>
#include <stdio.h>

#ifndef ONE_LAUNCH
#define ONE_LAUNCH 1
#endif
#ifndef TPROBE
#define TPROBE 0
#endif
#ifndef TQ
#define TQ 200.f
#endif
constexpr int NTHR = 512, NWAVE = 8;
constexpr int STAGE_LDS = 131072, DYN_LDS = STAGE_LDS + 256;

#define DI __device__ __forceinline__
typedef unsigned short u16;
typedef __attribute__((ext_vector_type(8))) short bf16x8;
typedef __attribute__((ext_vector_type(4))) float f32x4;

constexpr int TP = 4096, TS = 8192, TT = 12288, ZW = 2560, NIN = 2688, FF = 2816;
constexpr float EPS = 1e-6f;
constexpr size_t O_YP = 0, O_NA = 12582912, O_GQA = 20971520, O_C = 25165824, O_N = 27262976, O_M = 27295744;
constexpr int SMEM_BYTES = 73728;

struct P {
  const float *x_prompt, *x_sample, *cache_na, *cache_gqa, *stC, *stn, *stm, *c, *c_ctx, *w_in, *b_gates, *w_out,
      *g_norm, *g_qk, *g_ml, *na_bias, *w_ada, *b_ada, *w_gu, *w_down;
  float* out;
  char* ws;
  int nblk, pad_;
  __host__ __device__ __forceinline__ u16* wt_in() const { return (u16*)(ws + 0ull); }
  __host__ __device__ __forceinline__ u16* wt_out() const { return (u16*)(ws + 20971520ull); }
  __host__ __device__ __forceinline__ u16* wt_gu() const { return (u16*)(ws + 29360128ull); }
  __host__ __device__ __forceinline__ u16* wt_down() const { return (u16*)(ws + 75497472ull); }
  __host__ __device__ __forceinline__ float* mods() const { return (float*)(ws + 98566144ull); }
  __host__ __device__ __forceinline__ float* rope() const { return (float*)(ws + 99450880ull); }
  __host__ __device__ __forceinline__ u16* kc_na() const { return (u16*)(ws + 99459072ull); }
  __host__ __device__ __forceinline__ u16* vct_na() const { return (u16*)(ws + 103653376ull); }
  __host__ __device__ __forceinline__ u16* kc_gqa() const { return (u16*)(ws + 107847680ull); }
  __host__ __device__ __forceinline__ u16* vct_gqa() const { return (u16*)(ws + 109944832ull); }
  __host__ __device__ __forceinline__ u16* hn() const { return (u16*)(ws + 112041984ull); }
  __host__ __device__ __forceinline__ u16* zb() const { return (u16*)(ws + 137207808ull); }
  __host__ __device__ __forceinline__ u16* act() const { return (u16*)(ws + 137207808ull); }
  __host__ __device__ __forceinline__ u16* vt_na() const { return (u16*)(ws + 206413824ull); }
  __host__ __device__ __forceinline__ u16* vt_gqa() const { return (u16*)(ws + 212705280ull); }
  __host__ __device__ __forceinline__ u16* kt_ml() const { return (u16*)(ws + 215851008ull); }
  __host__ __device__ __forceinline__ u16* vt_ml() const { return (u16*)(ws + 222142464ull); }
  __host__ __device__ __forceinline__ u16* mix() const { return (u16*)(ws + 228433920ull); }
  __host__ __device__ __forceinline__ float* gates() const { return (float*)(ws + 253599744ull); }
  __host__ __device__ __forceinline__ float* obuf() const { return (float*)(ws + 254386176ull); }
  __host__ __device__ __forceinline__ float* ml_chat() const { return (float*)(ws + 304717824ull); }
  __host__ __device__ __forceinline__ float* ml_nhat() const { return (float*)(ws + 329883648ull); }
  __host__ __device__ __forceinline__ float* ml_ab() const { return (float*)(ws + 330276864ull); }
  __host__ __device__ __forceinline__ float* ml_nst() const { return (float*)(ws + 330289152ull); }
  __host__ __device__ __forceinline__ float* ml_mst() const { return (float*)(ws + 330682368ull); }
  __host__ __device__ __forceinline__ u16* ml_cst() const { return (u16*)(ws + 330688512ull); }
  __host__ __device__ __forceinline__ unsigned* bar() const { return (unsigned*)(ws + 343271424ull); }
};
constexpr size_t X16_OFF = 343351808ull;
constexpr size_t WS_TOTAL_X = X16_OFF + (size_t)12288 * 1024 * 2;
constexpr size_t WS_TOTAL = 343286272ull;

DI u16 f2bf(float x) { unsigned u = __float_as_uint(x); u += 0x7fffu + ((u >> 16) & 1u); return (u16)(u >> 16); }
DI float bf2f(u16 h) { return __uint_as_float(((unsigned)h) << 16); }
DI unsigned pack2(float a, float b) { unsigned r; asm volatile("v_cvt_pk_bf16_f32 %0, %1, %2" : "=v"(r) : "v"(a), "v"(b)); return r; }
#define DPP_F(v, ctrl, rmask) __int_as_float(__builtin_amdgcn_update_dpp(0, __float_as_int(v), (ctrl), (rmask), 0xF, false))
DI float wave_sum(float v) {
  v += DPP_F(v, 0xB1, 0xF);
  v += DPP_F(v, 0x4E, 0xF);
  v += DPP_F(v, 0x141, 0xF);
  v += DPP_F(v, 0x140, 0xF);
  v += DPP_F(v, 0x142, 0xA);
  v += DPP_F(v, 0x143, 0xC);
  return __int_as_float(__builtin_amdgcn_readlane(__float_as_int(v), 63));
}
DI float wave_max(float v) { for (int o = 32; o >= 1; o >>= 1) v = fmaxf(v, __shfl_xor(v, o)); return v; }
DI void wave_sync() { __builtin_amdgcn_fence(__ATOMIC_RELEASE, "wavefront"); __builtin_amdgcn_wave_barrier(); __builtin_amdgcn_fence(__ATOMIC_ACQUIRE, "wavefront"); }
#define MFMA16(a, b, c) __builtin_amdgcn_mfma_f32_16x16x32_bf16((a), (b), (c), 0, 0, 0)
DI bf16x8 ld8(const u16* p) { return *(const bf16x8*)p; }
DI bf16x8 ld4x2(const u16* p0, const u16* p1) {
  uint2 a = *(const uint2*)p0, b = *(const uint2*)p1;
  uint4 r; r.x = a.x; r.y = a.y; r.z = b.x; r.w = b.y;
  return __builtin_bit_cast(bf16x8, r);
}
DI bf16x8 pack8(const f32x4& a, const f32x4& b) {
  uint4 r; r.x = pack2(a[0], a[1]); r.y = pack2(a[2], a[3]); r.z = pack2(b[0], b[1]); r.w = pack2(b[2], b[3]);
  return __builtin_bit_cast(bf16x8, r);
}
DI f32x4 zero4() { f32x4 z = {0.f, 0.f, 0.f, 0.f}; return z; }

DI size_t vt_index(int row, int H, int h, int d) {
  if (row < TP) { int b = row >> 8, t = row & 255; return ((size_t)((b * H + h) * 64 + d)) * 256 + t; }
  int r = row - TP; int b = r >> 10, t = r & 1023;
  return (size_t)16 * H * 64 * 256 + ((size_t)((b * H + h) * 64 + d)) * 1024 + t;
}


#define XB_TMO      128
#define XB_XCNT(j)  (256  + 64 * (j))
#define XB_XSUB(j)  (1280 + 64 * (j))
#define XB_XGEN(j)  (2304 + 64 * (j))
#define XB_TOP      3328
#define XB_TOPGEN   3392
#define XCD_BAR_WORDS 3456
#define XB_SPIN_CAP (1u << 20)
#define LAS __attribute__((address_space(3)))
DI unsigned xb_ld(unsigned* p) { return __hip_atomic_load(p, __ATOMIC_RELAXED, __HIP_MEMORY_SCOPE_AGENT); }
DI unsigned xb_add(unsigned* p, unsigned v) { return __hip_atomic_fetch_add(p, v, __ATOMIC_RELAXED, __HIP_MEMORY_SCOPE_AGENT); }
DI unsigned xb_xcc_id() { return (unsigned)__builtin_amdgcn_s_getreg((3 << 11) | 20) & 0xFu; }
#define XB_SPIN(cond, bar) do { unsigned _sp = 0; while (cond) { __builtin_amdgcn_s_sleep(1); \
    if ((++_sp & 255u) == 0u) { if (xb_ld(&(bar)[XB_TMO])) break; if (_sp > XB_SPIN_CAP) { atomicAdd(&(bar)[XB_TMO], 1u); break; } } } } while (0)
struct XcdBarrier { unsigned* bar; unsigned x; unsigned G; volatile LAS unsigned* st; };
DI XcdBarrier xcd_barrier_post(unsigned* bar, volatile LAS unsigned* st, unsigned G) {
  XcdBarrier b; b.bar = bar; b.x = xb_xcc_id(); b.st = st; b.G = G;
  if (threadIdx.x == 0) (void)xb_add(&bar[XB_XCNT(b.x)], 1u);
  return b;
}
DI void xcd_barrier_complete(unsigned* bar, unsigned x, unsigned& nloc, unsigned& nx, unsigned G) {
  unsigned sum, cnt, mine, sp = 0u;
  for (;;) {
    sum = 0u; cnt = 0u; mine = 0u;
#pragma unroll
    for (unsigned j = 0; j < 16; ++j) { const unsigned c = xb_ld(&bar[XB_XCNT(j)]); sum += c; cnt += (c > 0u) ? 1u : 0u; mine = (j == x) ? c : mine; }
    if (sum == G) break;
    __builtin_amdgcn_s_sleep(1);
    if ((++sp & 255u) == 0u) { if (xb_ld(&bar[XB_TMO])) break; if (sp > XB_SPIN_CAP) { atomicAdd(&bar[XB_TMO], 1u); break; } }
  }
  nloc = mine > 0u ? mine : 1u; nx = cnt > 0u ? cnt : 1u;
}
DI void xcd_barrier(const XcdBarrier& b) {
  asm volatile("s_waitcnt vmcnt(0)" ::: "memory");
  __syncthreads();
  if (threadIdx.x == 0) {
    unsigned* bar = b.bar;
    __builtin_amdgcn_s_waitcnt(0);
    unsigned nloc = b.st[0], nx = b.st[1];
    if (nloc == 0u) { xcd_barrier_complete(bar, b.x, nloc, nx, b.G); b.st[0] = nloc; b.st[1] = nx; }
    const unsigned old = xb_add(&bar[XB_XSUB(b.x)], 1u);
    const unsigned gen = old / nloc;
    if (old + 1u == (gen + 1u) * nloc) {
      __builtin_amdgcn_fence(__ATOMIC_RELEASE, "agent");
      asm volatile("s_waitcnt vmcnt(0)" ::: "memory");
      const unsigned og = xb_add(&bar[XB_TOP], 1u);
      const unsigned tg = og / nx;
      if (og + 1u == (tg + 1u) * nx) xb_add(&bar[XB_TOPGEN], 1u);
      else XB_SPIN(xb_ld(&bar[XB_TOPGEN]) == tg, bar);
      __builtin_amdgcn_fence(__ATOMIC_ACQUIRE, "agent");
      xb_add(&bar[XB_XGEN(b.x)], 1u);
      asm volatile("s_waitcnt vmcnt(0)" ::: "memory");
    } else {
      XB_SPIN(xb_ld(&bar[XB_XGEN(b.x)]) == gen, bar);
      __builtin_amdgcn_fence(__ATOMIC_ACQUIRE, "agent");
      asm volatile("s_waitcnt vmcnt(0)" ::: "memory");
    }
  }
  __syncthreads();
}

DI void transpose_tile(const float* __restrict__ src, int ldsrc, int k0, int n0, int mode, int nvalid,
                       u16* __restrict__ dst, int ldd, float* tile, int tid) {
  const int nn = tid & 63, kq = tid >> 6;
  int rr = n0 + nn, col;
  if (mode == 1) {
    int tl = rr >> 8, c = rr & 255, bj = c >> 7, wc = (c >> 5) & 3, w = c & 31;
    col = tl * 128 + wc * 32 + w + bj * FF;
  } else if (mode == 2) {
    int tl = rr >> 8, c = rr & 255, bj = c >> 7, wc = (c >> 5) & 3, w = c & 31;
    col = tl * 256 + wc * 64 + bj * 32 + w;
  } else col = rr < nvalid ? rr : -1;
#pragma unroll
  for (int i = 0; i < 8; ++i) {
    int kk = i * 8 + kq;
    tile[kk * 65 + nn] = col >= 0 ? src[(size_t)(k0 + kk) * ldsrc + col] : 0.f;
  }
  __syncthreads();
  const int k2 = (tid & 31) * 2, nq = tid >> 5;
#pragma unroll
  for (int i = 0; i < 4; ++i) {
    int n = i * 16 + nq;
    *(unsigned*)(dst + (size_t)(n0 + n) * ldd + k0 + k2) = pack2(tile[k2 * 65 + n], tile[(k2 + 1) * 65 + n]);
  }
  __syncthreads();
}

DI void phase_init(const P& p, char* smem, int tid) {
  float* tile = (float*)smem;
  const int NTR = 12032, NCV = 768, NADA = 384;
  const int total = NTR + NCV + NADA + 1;
  for (int it = blockIdx.x; it < total; it += p.nblk) {
    if (it < NTR) {
      int l = it / 3008, r = it % 3008;
      if (r < 640) {
        int kt = r / 40, nt = r % 40;
        transpose_tile(p.w_in + (size_t)l * 1024 * 2576, 2576, kt * 64, nt * 64, 2, 2560, p.wt_in() + (size_t)l * ZW * 1024, 1024, tile, tid);
      } else if (r < 896) {
        int x = r - 640, kt = x / 16, nt = x % 16;
        transpose_tile(p.w_out + (size_t)l * 1024 * 1024, 1024, kt * 64, nt * 64, 0, 1024, p.wt_out() + (size_t)l * 1024 * 1024, 1024, tile, tid);
      } else if (r < 2304) {
        int x = r - 896, kt = x / 88, nt = x % 88;
        transpose_tile(p.w_gu + (size_t)l * 1024 * 5632, 5632, kt * 64, nt * 64, 1, 5632, p.wt_gu() + (size_t)l * 5632 * 1024, 1024, tile, tid);
      } else {
        int x = r - 2304, kt = x / 16, nt = x % 16;
        transpose_tile(p.w_down + (size_t)l * FF * 1024, 1024, kt * 64, nt * 64, 0, 1024, p.wt_down() + (size_t)l * 1024 * FF, FF, tile, tid);
      }
    } else if (it < NTR + NCV) {
      int it2 = it - NTR;
      if (it2 < 512) {
        int idx = it2 >> 2, tt = it2 & 3, bl = idx >> 2, h = idx & 3;
        transpose_tile(p.cache_na + (size_t)((bl * 2 + 1) * 4 + h) * 16384, 64, tt * 64, 0, 0, 64, p.vct_na() + (size_t)idx * 16384, 256, tile, tid);
      } else {
        int it3 = it2 - 512;
        int idx = it3 >> 2, tt = it3 & 3, bl = idx >> 1, h = idx & 1;
        transpose_tile(p.cache_gqa + (size_t)((bl * 2 + 1) * 2 + h) * 16384, 64, tt * 64, 0, 0, 64, p.vct_gqa() + (size_t)idx * 16384, 256, tile, tid);
      }
    } else if (it < NTR + NCV + NADA) {
      int ia = it - NTR - NCV;
      int l = ia / 96, colbase = (ia % 96) * 64;
      float* sl = (float*)smem;
      for (int i = tid; i < 9 * 1024; i += NTHR) {
        int n = i >> 10, d = i & 1023;
        float cv = n == 0 ? p.c_ctx[d] : p.c[(n - 1) * 1024 + d];
        sl[i] = cv / (1.f + __expf(-cv));
      }
      __syncthreads();
      const int col = tid & 63, kg = tid >> 6;
      float acc[9];
#pragma unroll
      for (int n = 0; n < 9; ++n) acc[n] = 0.f;
      const float* w = p.w_ada + ((size_t)l * 1024 + kg * 128) * 6144 + colbase + col;
#pragma unroll 4
      for (int k = 0; k < 128; ++k) {
        float wv = w[(size_t)k * 6144];
#pragma unroll
        for (int n = 0; n < 9; ++n) acc[n] += sl[n * 1024 + kg * 128 + k] * wv;
      }
      float* red = sl + 9216;
#pragma unroll
      for (int n = 0; n < 9; ++n) red[(kg * 9 + n) * 64 + col] = acc[n];
      __syncthreads();
      for (int i = tid; i < 576; i += NTHR) {
        int n = i >> 6, cc = i & 63;
        float s = 0.f;
#pragma unroll
        for (int g = 0; g < 8; ++g) s += red[(g * 9 + n) * 64 + cc];
        p.mods()[(size_t)(l * 9 + n) * 6144 + colbase + cc] = s + p.b_ada[l * 6144 + colbase + cc];
      }
      __syncthreads();
    } else {
      for (int i = tid; i < 1024; i += NTHR) {
        int pos = i >> 4, fi = i & 15;
        float inv = __builtin_amdgcn_exp2f(-(float)fi * 0.8304820237f);
        float ang = (float)pos * inv;
        p.rope()[i] = __cosf(ang);
        p.rope()[1024 + i] = __sinf(ang);
      }
    }
  }
  const int gtid = blockIdx.x * NTHR + tid, gsz = p.nblk * NTHR;
  for (int i = gtid; i < 128 * 4096; i += gsz) {
    int idx = i >> 12, e = (i & 4095) * 4, bl = idx >> 2, h = idx & 3;
    float4 v = *(const float4*)(p.cache_na + (size_t)((bl * 2 + 0) * 4 + h) * 16384 + e);
    uint2 o; o.x = pack2(v.x, v.y); o.y = pack2(v.z, v.w);
    *(uint2*)(p.kc_na() + (size_t)idx * 16384 + e) = o;
  }
  for (int i = gtid; i < 64 * 4096; i += gsz) {
    int idx = i >> 12, e = (i & 4095) * 4, bl = idx >> 1, h = idx & 1;
    float4 v = *(const float4*)(p.cache_gqa + (size_t)((bl * 2 + 0) * 2 + h) * 16384 + e);
    uint2 o; o.x = pack2(v.x, v.y); o.y = pack2(v.z, v.w);
    *(uint2*)(p.kc_gqa() + (size_t)idx * 16384 + e) = o;
  }
}

DI void phase_row(const P& p, int mode, int l, char* smem, int tid) {
  const int lane = tid & 63, wid = tid >> 6;
  const bool last = (mode == 2 && l == 3);
  const int ln = mode == 1 ? l : (mode == 0 ? 0 : l + 1);
  const bool do_gates = (mode != 1) && !last;
  u16* x16 = (u16*)(p.ws + X16_OFF);
  u16* Wgb = (u16*)smem;
  u16* Hs = (u16*)smem + 16 * 1024 + wid * (6 * 1024);
  if (do_gates) {
    for (int idx = tid; idx < 16384; idx += NTHR) {
      const int k = idx >> 4, g = idx & 15;
      const int c = k >> 3, cs = (c & ~7) | ((c & 7) ^ (g & 7));
      Wgb[g * 1024 + cs * 8 + (k & 7)] = f2bf(p.w_in[((size_t)ln * 1024 + k) * 2576 + 2560 + g]);
    }
    __syncthreads();
  }
  const int rpw = (TT + p.nblk * NWAVE - 1) / (p.nblk * NWAVE);
  const int rbeg = (blockIdx.x * NWAVE + wid) * rpw;
  const int rend = min(TT, rbeg + rpw);
  const int gi = mode == 1 ? 2 : 0, shi = mode == 1 ? 3 : 0;
  float4 g2v[4], shv[4], scv[4], gav[4], gv[4];
  {
    const float* g2 = p.g_norm + (size_t)((last ? l : ln) * 4 + gi) * 1024;
    const float* g = p.g_norm + (size_t)(l * 4 + (mode == 1 ? 1 : 3)) * 1024;
#pragma unroll
    for (int i = 0; i < 4; ++i) {
      const int cidx = i * 256 + lane * 4;
      g2v[i] = *(const float4*)(g2 + cidx);
      gv[i] = mode != 0 ? *(const float4*)(g + cidx) : g2v[i];
    }
  }
  int cur_nidx = -1;
  uint2 obn[4], xbn[4];
  if (mode != 0 && rbeg < rend) {
#pragma unroll
    for (int i = 0; i < 4; ++i) { obn[i] = *(const uint2*)((const u16*)p.obuf() + (size_t)rbeg * 1024 + i * 256 + lane * 4); xbn[i] = *(const uint2*)(x16 + (size_t)rbeg * 1024 + i * 256 + lane * 4); }
  }
  for (int row_ = rbeg; row_ < rend; ++row_) {
    int row = row_;
    asm volatile("" : "+v"(row));
    const int nidx = row < TP ? 0 : 1 + ((row - TP) >> 10);
    float4 x[4];
    if (nidx != cur_nidx) {
      cur_nidx = nidx;
      const float* sh = p.mods() + ((size_t)((last ? l : ln) * 9 + nidx) * 6 + shi) * 1024;
      const float* sc = sh + 1024;
      const float* ga = p.mods() + ((size_t)(l * 9 + nidx) * 6 + (mode == 1 ? 2 : 5)) * 1024;
#pragma unroll
      for (int i = 0; i < 4; ++i) {
        const int cidx = i * 256 + lane * 4;
        shv[i] = *(const float4*)(sh + cidx); scv[i] = *(const float4*)(sc + cidx);
        gav[i] = mode != 0 ? *(const float4*)(ga + cidx) : shv[i];
      }
    }
    if (mode == 0) {
      const float* src = row < TP ? p.x_prompt + (size_t)row * 1024 : p.x_sample + (size_t)(row - TP) * 1024;
#pragma unroll
      for (int i = 0; i < 4; ++i) x[i] = *(const float4*)(src + i * 256 + lane * 4);
    } else {
      uint2 ob[4], xb[4];
#pragma unroll
      for (int i = 0; i < 4; ++i) { ob[i] = obn[i]; xb[i] = xbn[i]; }
      {
        const int rnx = row_ + 1;
        if (rnx < rend) {
#pragma unroll
          for (int i = 0; i < 4; ++i) { obn[i] = *(const uint2*)((const u16*)p.obuf() + (size_t)rnx * 1024 + i * 256 + lane * 4); xbn[i] = *(const uint2*)(x16 + (size_t)rnx * 1024 + i * 256 + lane * 4); }
        }
      }
      float4 o[4];
      float ss = 0.f;
#pragma unroll
      for (int i = 0; i < 4; ++i) {
        o[i].x = __uint_as_float(ob[i].x << 16); o[i].y = __uint_as_float(ob[i].x & 0xffff0000u);
        o[i].z = __uint_as_float(ob[i].y << 16); o[i].w = __uint_as_float(ob[i].y & 0xffff0000u);
        x[i].x = __uint_as_float(xb[i].x << 16); x[i].y = __uint_as_float(xb[i].x & 0xffff0000u);
        x[i].z = __uint_as_float(xb[i].y << 16); x[i].w = __uint_as_float(xb[i].y & 0xffff0000u);
        ss += o[i].x * o[i].x + o[i].y * o[i].y + o[i].z * o[i].z + o[i].w * o[i].w;
      }
      ss = wave_sum(ss);
      const float rs = rsqrtf(ss * (1.f / 1024.f) + EPS);
#pragma unroll
      for (int i = 0; i < 4; ++i) {
        x[i].x += gav[i].x * (o[i].x * rs * gv[i].x); x[i].y += gav[i].y * (o[i].y * rs * gv[i].y);
        x[i].z += gav[i].z * (o[i].z * rs * gv[i].z); x[i].w += gav[i].w * (o[i].w * rs * gv[i].w);
      }
    }
    if (last) {
#pragma unroll
      for (int i = 0; i < 4; ++i) *(float4*)(p.out + (size_t)row * 1024 + i * 256 + lane * 4) = x[i];
      continue;
    }
#pragma unroll
    for (int i = 0; i < 4; ++i) {
      uint2 w; w.x = pack2(x[i].x, x[i].y); w.y = pack2(x[i].z, x[i].w);
      *(uint2*)(x16 + (size_t)row * 1024 + i * 256 + lane * 4) = w;
      x[i].x = __uint_as_float(w.x << 16); x[i].y = __uint_as_float(w.x & 0xffff0000u);
      x[i].z = __uint_as_float(w.y << 16); x[i].w = __uint_as_float(w.y & 0xffff0000u);
    }
    float ss2 = 0.f;
#pragma unroll
    for (int i = 0; i < 4; ++i) ss2 += x[i].x * x[i].x + x[i].y * x[i].y + x[i].z * x[i].z + x[i].w * x[i].w;
    ss2 = wave_sum(ss2);
    const float rs2 = rsqrtf(ss2 * (1.f / 1024.f) + EPS);
#pragma unroll
    for (int i = 0; i < 4; ++i) {
      const int cidx = i * 256 + lane * 4;
      x[i].x = x[i].x * rs2 * g2v[i].x * (1.f + scv[i].x) + shv[i].x;
      x[i].y = x[i].y * rs2 * g2v[i].y * (1.f + scv[i].y) + shv[i].y;
      x[i].z = x[i].z * rs2 * g2v[i].z * (1.f + scv[i].z) + shv[i].z;
      x[i].w = x[i].w * rs2 * g2v[i].w * (1.f + scv[i].w) + shv[i].w;
      uint2 o2; o2.x = pack2(x[i].x, x[i].y); o2.y = pack2(x[i].z, x[i].w);
      *(uint2*)(p.hn() + (size_t)row * 1024 + cidx) = o2;
      if (do_gates) {
        const int rs_ = row_ - rbeg, c = i * 32 + (lane >> 1), cs = (c & ~7) | ((c & 7) ^ (rs_ & 7));
        *(uint2*)(Hs + rs_ * 1024 + cs * 8 + (lane & 1) * 4) = o2;
      }
    }
  }
  if (do_gates && rbeg < rend) {
    wave_sync();
    const int nrows = rend - rbeg, fr = lane & 15, fq = lane >> 4;
    const int ar = fr < nrows ? fr : 0;
    f32x4 acc = zero4();
#pragma unroll 8
    for (int ks = 0; ks < 32; ++ks) {
      const int c = ks * 4 + fq;
      const bf16x8 a = *(const bf16x8*)(Hs + ar * 1024 + (((c & ~7) | ((c & 7) ^ (ar & 7))) * 8));
      const bf16x8 b = *(const bf16x8*)(Wgb + fr * 1024 + (((c & ~7) | ((c & 7) ^ (fr & 7))) * 8));
      acc = MFMA16(a, b, acc);
    }
    const float bg = p.b_gates[ln * 16 + fr];
#pragma unroll
    for (int jj = 0; jj < 4; ++jj) {
      const int r = fq * 4 + jj;
      if (r < nrows) p.gates()[(size_t)(rbeg + r) * 16 + fr] = acc[jj] + bg;
    }
  }
  if (do_gates) __syncthreads();
}

#define PG8_LAS __attribute__((address_space(3)))
typedef unsigned u32x4 __attribute__((ext_vector_type(4)));
typedef unsigned u32x2 __attribute__((ext_vector_type(2)));
namespace pg8 {
constexpr int BM = 256, BK = 64, HALF = 128, HTB = HALF * BK * 2, NXCD = 8, WGM = 8;
DI int lds_byte(int r, int c) { const int st = (r >> 4) * 2 + (c >> 5), rr = r & 15, cc = c & 31, ob = rr * 64 + cc * 2; return st * 1024 + (ob ^ (((ob >> 9) & 1) << 5)); }
DI void stage_rc(int b, int& R, int& C) { const int st = b / 1024, sb = b % 1024, swz = sb ^ (((sb >> 9) & 1) << 5); R = (st >> 1) * 16 + swz / 64; C = (st & 1) * 32 + (swz % 64) / 2; }
DI int perm32(int rho) { const int n = rho >> 4, i = rho & 15; return 8 * (i >> 2) + 4 * n + (i & 3); }
struct Unit { int pm, pn; };
struct Gemm { const u16* A; const u16* Bt; int M, N, K; };
struct StaticOrder {
  int nM, nN, nwg, G, c;
  DI void init(int M, int N, int G_, int c_) { nM = M / BM; nN = N / BM; nwg = nM * nN; G = G_; c = c_; }
  DI bool next(int i, Unit& u) const {
    const long L = (long)i * G + c; if (L >= nwg) return false;
    int wgid = (int)L; { const int q = nwg / NXCD, r = nwg % NXCD, xcd = wgid % NXCD, off = wgid / NXCD; wgid = (xcd < r ? xcd * (q + 1) : r * (q + 1) + (xcd - r) * q) + off; }
    const int nig = WGM * nN, gid = wgid / nig, fm = gid * WGM, gsz = (nM - fm) < WGM ? (nM - fm) : WGM;
    u.pm = fm + ((wgid % nig) % gsz); u.pn = (wgid % nig) / gsz; return true;
  }
};
DI unsigned cvt_pk_bf16(float lo, float hi) { unsigned r; asm volatile("v_cvt_pk_bf16_f32 %0, %1, %2" : "=v"(r) : "v"(lo), "v"(hi)); return r; }

template <class Epi>
DI void gemm_phase(PG8_LAS unsigned char* lds, const Gemm g, const StaticOrder& S, const Epi& E) {
  int tid = threadIdx.x;
  asm volatile("" : "+v"(tid));
  const int wid = __builtin_amdgcn_readfirstlane(tid >> 6), lane = tid & 63, wr = wid >> 2, wc = wid & 3, fr = lane & 15, fq = lane >> 4;
  const int K = g.K, nt = K / BK;
  unsigned voffA[2], voffB[2];
#pragma unroll
  for (int i = 0; i < 2; ++i) { int R, C; stage_rc(tid * 16 + i * 8192, R, C); const int Rb = Epi::PERM ? ((R & ~31) + perm32(R & 31)) : R;
    voffA[i] = (unsigned)(R * K + C) * 2u; voffB[i] = (unsigned)(Rb * K + C) * 2u; }
  const size_t kstep = (size_t)(BK * 2);
  const size_t hstep = (size_t)HALF * K * 2;
  const size_t tstep = 2 * hstep;
  const unsigned ldsw = (unsigned)wid * 1024u;
  const int aoff = lds_byte(wr * 64 + fr, fq * 8), boff = lds_byte(wc * 32 + fr, fq * 8);
#define PG8_SA(b, h) (((b) * 2 + (h)) * HTB)
#define PG8_SB(b, h) ((4 + (b) * 2 + (h)) * HTB)
#define PG8_STAGE(bufoff, gbase, voff) do { _Pragma("unroll") for (int _i = 0; _i < 2; ++_i) \
    __builtin_amdgcn_global_load_lds((const unsigned*)((const char*)(gbase) + (voff)[_i]), (PG8_LAS unsigned*)(lds + (bufoff) + ldsw + _i * 8192), 16, 0, 0); } while (0)
#define PG8_LDA(dst, b, h) do { _Pragma("unroll") for (int m = 0; m < 4; ++m) _Pragma("unroll") for (int k = 0; k < 2; ++k) dst[m][k] = *(const PG8_LAS bf16x8*)(lds + PG8_SA(b, h) + aoff + m * 2048 + k * 1024); } while (0)
#define PG8_LDB(dst, b, h) do { _Pragma("unroll") for (int n = 0; n < 2; ++n) _Pragma("unroll") for (int k = 0; k < 2; ++k) dst[n][k] = *(const PG8_LAS bf16x8*)(lds + PG8_SB(b, h) + boff + n * 2048 + k * 1024); } while (0)
#define PG8_MMA(ai, bj, At, Bt) do { __builtin_amdgcn_s_setprio(1); _Pragma("unroll") for (int m = 0; m < 4; ++m) _Pragma("unroll") for (int n = 0; n < 2; ++n) _Pragma("unroll") for (int k = 0; k < 2; ++k) \
    acc[ai][bj][m][n] = __builtin_amdgcn_mfma_f32_16x16x32_bf16(Bt[n][k], At[m][k], acc[ai][bj][m][n], 0, 0, 0); __builtin_amdgcn_s_setprio(0); } while (0)
#define PG8_WAIT_V(n) asm volatile("s_waitcnt vmcnt(" #n ")" ::: "memory")
#define PG8_WAIT_L(n) asm volatile("s_waitcnt lgkmcnt(" #n ")" ::: "memory")
#define PG8_BAR __builtin_amdgcn_s_barrier()
#define PG8_SCHED __builtin_amdgcn_sched_barrier(0)
  Unit cur, nxt; int ui = 0;
  if (!S.next(0, cur)) return;
  f32x4 acc[2][2][4][2];
#pragma unroll
  for (int a = 0; a < 2; ++a)
#pragma unroll
    for (int b = 0; b < 2; ++b)
#pragma unroll
      for (int m = 0; m < 4; ++m)
#pragma unroll
        for (int n = 0; n < 2; ++n) acc[a][b][m][n] = (f32x4){0.f, 0.f, 0.f, 0.f};
  bf16x8 At[4][2], B0[2][2], B1[2][2];
  const char* cA = (const char*)g.A + (size_t)cur.pm * tstep; const char* cB = (const char*)g.Bt + (size_t)cur.pn * tstep;
  PG8_STAGE(PG8_SB(0, 0), cB, voffB); PG8_STAGE(PG8_SA(0, 0), cA, voffA); PG8_STAGE(PG8_SB(0, 1), cB + hstep, voffB); PG8_STAGE(PG8_SA(0, 1), cA + hstep, voffA);
  if (wr == 1) PG8_BAR;
  PG8_WAIT_V(4); PG8_BAR;
  PG8_STAGE(PG8_SB(1, 0), cB + kstep, voffB); PG8_STAGE(PG8_SA(1, 0), cA + kstep, voffA); PG8_STAGE(PG8_SB(1, 1), cB + hstep + kstep, voffB);
  PG8_WAIT_V(6); PG8_BAR;
  for (;;) {
    const bool has_next = S.next(ui + 1, nxt);
    const char* nA = has_next ? (const char*)g.A + (size_t)nxt.pm * tstep : cA; const char* nB = has_next ? (const char*)g.Bt + (size_t)nxt.pn * tstep : cB;
    for (int t = 0; t < nt; t += 2) {
      const bool last = (t == nt - 2);
      const char* a1 = cA + (size_t)(t + 1) * kstep;
      const char* a2 = last ? nA : cA + (size_t)(t + 2) * kstep; const char* b2 = last ? nB : cB + (size_t)(t + 2) * kstep;
      const char* a3 = a2 + kstep; const char* b3 = b2 + kstep;
      PG8_LDB(B0, 0, 0); PG8_SCHED; PG8_LDA(At, 0, 0); PG8_STAGE(PG8_SA(1, 1), a1 + hstep, voffA);
      PG8_WAIT_L(8); PG8_BAR; PG8_WAIT_L(0); PG8_MMA(0, 0, At, B0); PG8_BAR; PG8_SCHED;
      PG8_LDB(B1, 0, 1); PG8_STAGE(PG8_SB(0, 0), b2, voffB);
      PG8_BAR; PG8_WAIT_L(0); PG8_MMA(0, 1, At, B1); PG8_BAR;
      PG8_LDA(At, 0, 1); PG8_STAGE(PG8_SA(0, 0), a2, voffA);
      PG8_BAR; PG8_WAIT_L(0); PG8_MMA(1, 0, At, B0); PG8_BAR; PG8_SCHED;
      PG8_STAGE(PG8_SB(0, 1), b2 + hstep, voffB);
      PG8_WAIT_V(6); PG8_BAR; PG8_MMA(1, 1, At, B1); PG8_BAR;
      PG8_LDB(B0, 1, 0); PG8_SCHED; PG8_LDA(At, 1, 0); PG8_STAGE(PG8_SA(0, 1), a2 + hstep, voffA);
      PG8_WAIT_L(8); PG8_BAR; PG8_WAIT_L(0); PG8_MMA(0, 0, At, B0); PG8_BAR; PG8_SCHED;
      PG8_LDB(B1, 1, 1); PG8_STAGE(PG8_SB(1, 0), b3, voffB);
      PG8_BAR; PG8_WAIT_L(0); PG8_MMA(0, 1, At, B1); PG8_BAR;
      PG8_LDA(At, 1, 1); PG8_STAGE(PG8_SA(1, 0), a3, voffA);
      PG8_BAR; PG8_WAIT_L(0); PG8_MMA(1, 0, At, B0); PG8_BAR; PG8_SCHED;
      PG8_STAGE(PG8_SB(1, 1), b3 + hstep, voffB);
      PG8_WAIT_V(6); PG8_BAR; PG8_MMA(1, 1, At, B1); PG8_BAR;
    }
    E(acc, cur, wr, wc, fr, fq);
    if (!has_next) break;
#pragma unroll
    for (int a = 0; a < 2; ++a)
#pragma unroll
      for (int b = 0; b < 2; ++b)
#pragma unroll
        for (int m = 0; m < 4; ++m)
#pragma unroll
          for (int n = 0; n < 2; ++n) acc[a][b][m][n] = (f32x4){0.f, 0.f, 0.f, 0.f};
    cur = nxt; cA = nA; cB = nB; ++ui;
  }
  PG8_WAIT_V(0);
  if (wr == 0) PG8_BAR;
  PG8_BAR;
#undef PG8_SA
#undef PG8_SB
#undef PG8_STAGE
#undef PG8_LDA
#undef PG8_LDB
#undef PG8_MMA
#undef PG8_WAIT_V
#undef PG8_WAIT_L
#undef PG8_BAR
#undef PG8_SCHED
}
}

struct EpiO {
  static constexpr bool PERM = true;
  u16* C;
  DI void operator()(const f32x4 (&acc)[2][2][4][2], const pg8::Unit& u, int wr, int wc, int fr, int fq) const {
    const int row0 = u.pm * 256 + wr * 64 + fr, col0 = u.pn * 256 + wc * 32 + 8 * fq;
#pragma unroll
    for (int ai = 0; ai < 2; ++ai)
#pragma unroll
      for (int m = 0; m < 4; ++m) {
        u16* rowp = C + (unsigned)(row0 + ai * 128 + m * 16) * 1024u + (unsigned)col0;
#pragma unroll
        for (int bj = 0; bj < 2; ++bj) {
          const f32x4 v0 = acc[ai][bj][m][0], v1 = acc[ai][bj][m][1];
          u32x4 w; w.x = pg8::cvt_pk_bf16(v0[0], v0[1]); w.y = pg8::cvt_pk_bf16(v0[2], v0[3]); w.z = pg8::cvt_pk_bf16(v1[0], v1[1]); w.w = pg8::cvt_pk_bf16(v1[2], v1[3]);
          *(u32x4*)(rowp + bj * 128) = w;
        }
      }
  }
};

struct EpiGU {
  static constexpr bool PERM = true;
  u16* act;
  DI void operator()(const f32x4 (&acc)[2][2][4][2], const pg8::Unit& u, int wr, int wc, int fr, int fq) const {
    const int row0 = u.pm * 256 + wr * 64 + fr, col0 = u.pn * 128 + wc * 32 + 8 * fq;
#pragma unroll
    for (int ai = 0; ai < 2; ++ai)
#pragma unroll
      for (int m = 0; m < 4; ++m) {
        float r[8];
#pragma unroll
        for (int n = 0; n < 2; ++n)
#pragma unroll
          for (int j = 0; j < 4; ++j) {
            const float g = acc[ai][0][m][n][j], up = acc[ai][1][m][n][j];
            r[n * 4 + j] = g * __builtin_amdgcn_rcpf(1.f + __expf(-g)) * up;
          }
        u32x4 w; w.x = pg8::cvt_pk_bf16(r[0], r[1]); w.y = pg8::cvt_pk_bf16(r[2], r[3]); w.z = pg8::cvt_pk_bf16(r[4], r[5]); w.w = pg8::cvt_pk_bf16(r[6], r[7]);
        *(u32x4*)(act + (size_t)(row0 + ai * 128 + m * 16) * FF + col0) = w;
      }
  }
};

struct EpiIn {
  static constexpr bool PERM = false;
  const P* pp; int l;
  DI void operator()(const f32x4 (&acc)[2][2][4][2], const pg8::Unit& u, int wr, int wc, int fr, int fq) const {
    const P& p = *pp;
    const int c0 = u.pn * 256 + wc * 64;
    const int rb = u.pm * 256 + wr * 64 + fr;
    const bool prm = u.pm * 256 < TP;
    int region, hh;
    if (c0 < 256) { region = 0; hh = c0 >> 6; }
    else if (c0 < 512) { region = 1; hh = (c0 - 256) >> 6; }
    else if (c0 < 768) { region = 2; hh = (c0 - 512) >> 6; }
    else if (c0 < 1280) { region = 3; hh = (c0 - 768) >> 6; }
    else if (c0 < 1408) { region = 4; hh = (c0 - 1280) >> 6; }
    else if (c0 < 1536) { region = 5; hh = (c0 - 1408) >> 6; }
    else if (c0 < 1792) { region = 6; hh = (c0 - 1536) >> 6; }
    else if (c0 < 2048) { region = 7; hh = (c0 - 1792) >> 6; }
    else if (c0 < 2304) { region = 8; hh = (c0 - 2048) >> 6; }
    else { region = 9; hh = (c0 - 2304) >> 6; }
    const unsigned dl = fq * 4;
    if (region == 2 || region == 5 || region == 8 || region == 7) {
      u16* vt = region == 2 ? p.vt_na() : (region == 5 ? p.vt_gqa() : (region == 7 ? p.kt_ml() : p.vt_ml()));
      const int H = region == 5 ? 2 : 4;
      const float mul = region == 7 ? 0.125f : 1.f;
      const unsigned Tlen = prm ? 256u : 1024u;
#pragma unroll
      for (int ai = 0; ai < 2; ++ai)
#pragma unroll
        for (int m = 0; m < 4; ++m) {
          const int row = rb + ai * 128 + m * 16;
          unsigned vbase;
          if (prm) vbase = (unsigned)(((row >> 8) * H + hh) * 64) * 256u + (unsigned)(row & 255);
          else { const int r = row - TP; vbase = (unsigned)(16 * H * 64 * 256) + (unsigned)((((r >> 10) * H + hh) * 64)) * 1024u + (unsigned)(r & 1023); }
          u16* vp = vt + vbase + dl * Tlen;
#pragma unroll
          for (int bj = 0; bj < 2; ++bj)
#pragma unroll
            for (int n = 0; n < 2; ++n)
#pragma unroll
              for (int j = 0; j < 4; ++j) vp[(unsigned)(bj * 32 + n * 16 + j) * Tlen] = f2bf(acc[ai][bj][m][n][j] * mul);
        }
    }
    if (prm && (region == 1 || region == 2 || region == 5)) {
#pragma unroll
      for (int ai = 0; ai < 2; ++ai)
#pragma unroll
        for (int m = 0; m < 4; ++m) {
          const int row = rb + ai * 128 + m * 16, b = row >> 8, t = row & 255;
          unsigned base;
          if (region == 5) base = (unsigned)O_GQA + (unsigned)((((b * 4 + l) * 2 + 1) * 2 + hh) * 256 + t) * 64u;
          else base = (unsigned)O_NA + (unsigned)((((b * 4 + l) * 2 + (region == 2 ? 1 : 0)) * 4 + hh) * 256 + t) * 64u;
          float* op = p.out + base + dl;
#pragma unroll
          for (int bj = 0; bj < 2; ++bj)
#pragma unroll
            for (int n = 0; n < 2; ++n) *(f32x4*)(op + bj * 32 + n * 16) = acc[ai][bj][m][n];
        }
    }
    if (region == 2 || region == 5 || region == 8) return;
    if (region == 3 || region == 4) {
      const float* gq = p.g_qk + (l * 2 + (region == 4 ? 1 : 0)) * 64 + dl;
      f32x4 gv[2][2];
#pragma unroll
      for (int bj = 0; bj < 2; ++bj)
#pragma unroll
        for (int n = 0; n < 2; ++n) gv[bj][n] = *(const f32x4*)(gq + bj * 32 + n * 16);
#pragma unroll
      for (int ai = 0; ai < 2; ++ai)
#pragma unroll
        for (int m = 0; m < 4; ++m) {
          const int row = rb + ai * 128 + m * 16;
          f32x4 v[2][2];
          float ss = 0.f;
#pragma unroll
          for (int bj = 0; bj < 2; ++bj)
#pragma unroll
            for (int n = 0; n < 2; ++n) {
              v[bj][n] = acc[ai][bj][m][n];
#pragma unroll
              for (int j = 0; j < 4; ++j) ss += v[bj][n][j] * v[bj][n][j];
            }
          ss += __shfl_xor(ss, 16);
          ss += __shfl_xor(ss, 32);
          const float rs = rsqrtf(ss * (1.f / 64.f) + EPS);
#pragma unroll
          for (int bj = 0; bj < 2; ++bj)
#pragma unroll
            for (int n = 0; n < 2; ++n) v[bj][n] = v[bj][n] * rs * gv[bj][n];
          if (prm) {
            if (region == 4) {
              const int b = row >> 8, t = row & 255;
              float* op = p.out + (unsigned)O_GQA + (unsigned)((((b * 4 + l) * 2 + 0) * 2 + hh) * 256 + t) * 64u + dl;
#pragma unroll
              for (int bj = 0; bj < 2; ++bj)
#pragma unroll
                for (int n = 0; n < 2; ++n) *(f32x4*)(op + bj * 32 + n * 16) = v[bj][n];
            }
          } else {
            const int t = (row - TP) & 1023, pr = t >> 6, pc = t & 63;
#pragma unroll
            for (int bj = 0; bj < 2; ++bj) {
              const int pos = bj ? pc : pr;
              const f32x4 cs = *(const f32x4*)(p.rope() + pos * 16 + dl), sn = *(const f32x4*)(p.rope() + 1024 + pos * 16 + dl);
              const f32x4 x1 = v[bj][0], x2 = v[bj][1];
              v[bj][0] = x1 * cs - x2 * sn;
              v[bj][1] = x2 * cs + x1 * sn;
            }
          }
          u16* zp = p.zb() + (unsigned)row * (unsigned)ZW + (unsigned)c0 + dl;
#pragma unroll
          for (int bj = 0; bj < 2; ++bj)
#pragma unroll
            for (int n = 0; n < 2; ++n) {
              uint2 w; w.x = pg8::cvt_pk_bf16(v[bj][n][0], v[bj][n][1]); w.y = pg8::cvt_pk_bf16(v[bj][n][2], v[bj][n][3]);
              *(uint2*)(zp + bj * 32 + n * 16) = w;
            }
        }
      return;
    }
    {
      const float mul = region == 7 ? 0.125f : 1.f;
#pragma unroll
      for (int ai = 0; ai < 2; ++ai)
#pragma unroll
        for (int m = 0; m < 4; ++m) {
          const int row = rb + ai * 128 + m * 16;
          u16* zp = p.zb() + (unsigned)row * (unsigned)ZW + (unsigned)c0 + dl;
#pragma unroll
          for (int bj = 0; bj < 2; ++bj)
#pragma unroll
            for (int n = 0; n < 2; ++n) {
              const f32x4 v = acc[ai][bj][m][n] * mul;
              uint2 w; w.x = pg8::cvt_pk_bf16(v[0], v[1]); w.y = pg8::cvt_pk_bf16(v[2], v[3]);
              *(uint2*)(zp + bj * 32 + n * 16) = w;
            }
        }
    }
  }
};

DI void phase_gemm(const P& p, int which, int l, char* smem) {
  PG8_LAS unsigned char* lds = (PG8_LAS unsigned char*)smem;
  pg8::StaticOrder S;
  pg8::Gemm g;
  if (which == 0) {
    g.A = p.hn(); g.Bt = p.wt_in() + (size_t)l * ZW * 1024; g.M = TT; g.N = ZW; g.K = 1024;
    S.init(g.M, g.N, p.nblk, blockIdx.x);
    EpiIn E; E.pp = &p; E.l = l;
    pg8::gemm_phase(lds, g, S, E);
  } else if (which == 1) {
    g.A = p.mix(); g.Bt = p.wt_out() + (size_t)l * 1024 * 1024; g.M = TT; g.N = 1024; g.K = 1024;
    S.init(g.M, g.N, p.nblk, blockIdx.x);
    EpiO E; E.C = (u16*)p.obuf();
    pg8::gemm_phase(lds, g, S, E);
  } else if (which == 2) {
    g.A = p.hn(); g.Bt = p.wt_gu() + (size_t)l * 5632 * 1024; g.M = TT; g.N = 5632; g.K = 1024;
    S.init(g.M, g.N, p.nblk, blockIdx.x);
    EpiGU E; E.act = p.act();
    pg8::gemm_phase(lds, g, S, E);
  } else {
    g.A = p.act(); g.Bt = p.wt_down() + (size_t)l * 1024 * FF; g.M = TT; g.N = 1024; g.K = FF;
    S.init(g.M, g.N, p.nblk, blockIdx.x);
    EpiO E; E.C = (u16*)p.obuf();
    pg8::gemm_phase(lds, g, S, E);
  }
}

template <bool WIN>
DI void attn_seg(const u16* __restrict__ K, int ldk, const u16* __restrict__ V, int ldv, int nkeys, const bf16x8 (&qf)[4][2],
                 f32x4 (&o)[4][4], float (&m)[4], float (&lsum)[4], const float* __restrict__ bias, int rdelta, int fr, int fq) {
  const float L2E = 1.44269504f;
  for (int key0 = 0; key0 < nkeys; key0 += 32) {
    bf16x8 kf[2][2];
#pragma unroll
    for (int mt = 0; mt < 2; ++mt)
#pragma unroll
      for (int ks = 0; ks < 2; ++ks) kf[mt][ks] = ld8(K + (size_t)(key0 + mt * 16 + fr) * ldk + ks * 32 + fq * 8);
    bf16x8 va[4];
#pragma unroll
    for (int dt = 0; dt < 4; ++dt) {
      const u16* vp = V + (size_t)(dt * 16 + fr) * ldv + key0 + fq * 4;
      va[dt] = ld4x2(vp, vp + 16);
    }
    f32x4 s[2][4];
#pragma unroll
    for (int mt = 0; mt < 2; ++mt)
#pragma unroll
      for (int nt = 0; nt < 4; ++nt) {
        s[mt][nt] = zero4();
#pragma unroll
        for (int ks = 0; ks < 2; ++ks) s[mt][nt] = MFMA16(kf[mt][ks], qf[nt][ks], s[mt][nt]);
      }
    const float SC = 0.125f * L2E;
    if (WIN) {
      const int krel = key0 >> 6, ckb = key0 & 63;
      const float* brow = bias + (rdelta + krel) * 31;
#pragma unroll
      for (int nt = 0; nt < 4; ++nt) {
        const int cq = nt * 16 + fr;
        const int cw = min(max(cq - 8, 0), 48);
#pragma unroll
        for (int mt = 0; mt < 2; ++mt)
#pragma unroll
          for (int j = 0; j < 4; ++j) {
            const int ck = ckb + mt * 16 + fq * 4 + j;
            const bool valid = (ck >= cw) && (ck < cw + 16);
            const int dc = min(max(ck - cq, -15), 15) + 15;
            const float bv = brow[dc];
            s[mt][nt][j] = valid ? (s[mt][nt][j] + bv * 8.f) : -INFINITY;
          }
      }
    }
    bf16x8 pb[4];
    float tmx[4];
    bool grow = false;
#pragma unroll
    for (int nt = 0; nt < 4; ++nt) {
      float tm = fmaxf(fmaxf(fmaxf(s[0][nt][0], s[0][nt][1]), fmaxf(s[0][nt][2], s[0][nt][3])),
                       fmaxf(fmaxf(s[1][nt][0], s[1][nt][1]), fmaxf(s[1][nt][2], s[1][nt][3])));
      tm = fmaxf(tm, __shfl_xor(tm, 16));
      tm = fmaxf(tm, __shfl_xor(tm, 32));
      tm *= SC;
      tmx[nt] = tm;
      grow = grow || (tm > m[nt] + 11.5f);
    }
    if (__any(grow)) {
#pragma unroll
      for (int nt = 0; nt < 4; ++nt) {
        const float mn = fmaxf(m[nt], tmx[nt]);
        const float alpha = __builtin_amdgcn_exp2f(m[nt] - mn);
        m[nt] = mn;
        lsum[nt] *= alpha;
#pragma unroll
        for (int dt = 0; dt < 4; ++dt) o[dt][nt] *= alpha;
      }
    }
#pragma unroll
    for (int nt = 0; nt < 4; ++nt) {
      const float nm = -m[nt];
      float ps = 0.f;
#pragma unroll
      for (int mt = 0; mt < 2; ++mt)
#pragma unroll
        for (int j = 0; j < 4; ++j) { float pv = __builtin_amdgcn_exp2f(__builtin_fmaf(s[mt][nt][j], SC, nm)); s[mt][nt][j] = pv; ps += pv; }
      lsum[nt] += ps;
      pb[nt] = pack8(s[0][nt], s[1][nt]);
    }
#pragma unroll
    for (int dt = 0; dt < 4; ++dt)
#pragma unroll
      for (int nt = 0; nt < 4; ++nt) o[dt][nt] = MFMA16(va[dt], pb[nt], o[dt][nt]);
  }
}

template <bool WIN>
DI void attn_wave(const u16* Q, int ldq, const u16* K0, int ldk0, const u16* V0, int ldv0, int n0, const u16* K1, int ldk1,
                  const u16* V1, int ldv1, int n1, u16* O, int ldo, const float* bias, int rdelta, int lane) {
  const int fr = lane & 15, fq = lane >> 4;
  bf16x8 qf[4][2];
#pragma unroll
  for (int nt = 0; nt < 4; ++nt)
#pragma unroll
    for (int ks = 0; ks < 2; ++ks) qf[nt][ks] = ld8(Q + (size_t)(nt * 16 + fr) * ldq + ks * 32 + fq * 8);
  f32x4 o[4][4];
  float m[4], lsum[4];
#pragma unroll
  for (int i = 0; i < 4; ++i) {
    m[i] = -1e30f; lsum[i] = 0.f;
#pragma unroll
    for (int j = 0; j < 4; ++j) o[i][j] = zero4();
  }
  attn_seg<WIN>(K0, ldk0, V0, ldv0, n0, qf, o, m, lsum, bias, rdelta, fr, fq);
  if (n1 > 0) attn_seg<false>(K1, ldk1, V1, ldv1, n1, qf, o, m, lsum, bias, rdelta, fr, fq);
#pragma unroll
  for (int nt = 0; nt < 4; ++nt) {
    float lt = lsum[nt];
    lt += __shfl_xor(lt, 16);
    lt += __shfl_xor(lt, 32);
    const float inv = 1.f / lt;
#pragma unroll
    for (int dt = 0; dt < 4; ++dt) {
      uint2 w; w.x = pack2(o[dt][nt][0] * inv, o[dt][nt][1] * inv); w.y = pack2(o[dt][nt][2] * inv, o[dt][nt][3] * inv);
      *(uint2*)(O + (size_t)(nt * 16 + fr) * ldo + dt * 16 + fq * 4) = w;
    }
  }
}

template <bool WIN>
DI void attn_block(LAS unsigned char* lds, int tid, const u16* Q, int ldq,
                   const u16* K0, int ldk0, const u16* V0, int ldv0, int nt0,
                   const u16* K1, int ldk1, const u16* V1, int ldv1, int nt1,
                   u16* O, int ldo, const LAS float* bias, int rdelta, int wlo) {
  const int lane = tid & 63, fr = lane & 15, fq = lane >> 4;
  const int wid = __builtin_amdgcn_readfirstlane(tid >> 6);
  const float L2E = 1.44269504f, SC = 0.125f * L2E;
  bf16x8 qf[4][2];
#pragma unroll
  for (int nt = 0; nt < 4; ++nt)
#pragma unroll
    for (int ks = 0; ks < 2; ++ks) qf[nt][ks] = ld8(Q + (size_t)(nt * 16 + fr) * ldq + ks * 32 + fq * 8);
  f32x4 o[4][4];
  float m[4], lsum[4];
#pragma unroll
  for (int i = 0; i < 4; ++i) {
    m[i] = -1e30f; lsum[i] = 0.f;
#pragma unroll
    for (int j = 0; j < 4; ++j) o[i][j] = zero4();
  }
  const int ntl = nt0 + nt1;
  const int rr = tid >> 3, pp = tid & 7, part = pp ^ (rr & 7);
#define AB_ISSUE(t) do { const int _t = (t); const u16* _k; const u16* _v; \
    if (_t < nt0) { _k = K0 + (size_t)(_t * 64 + rr) * ldk0 + part * 8; _v = V0 + (size_t)rr * ldv0 + _t * 64 + part * 8; } \
    else { _k = K1 + (size_t)((_t - nt0) * 64 + rr) * ldk1 + part * 8; _v = V1 + (size_t)rr * ldv1 + (_t - nt0) * 64 + part * 8; } \
    LAS unsigned char* _s = lds + (_t & 3) * 16384 + wid * 1024; \
    __builtin_amdgcn_global_load_lds((const unsigned*)_k, (LAS unsigned*)_s, 16, 0, 0); \
    __builtin_amdgcn_global_load_lds((const unsigned*)_v, (LAS unsigned*)(_s + 8192), 16, 0, 0); } while (0)
  if (0 < ntl) AB_ISSUE(0);
  if (1 < ntl) AB_ISSUE(1);
  if (2 < ntl) AB_ISSUE(2);
  for (int t = 0; t < ntl; ++t) {
    const int rem = ntl - 1 - t;
    if (rem >= 2) asm volatile("s_waitcnt vmcnt(4)" ::: "memory");
    else if (rem == 1) asm volatile("s_waitcnt vmcnt(2)" ::: "memory");
    else asm volatile("s_waitcnt vmcnt(0)" ::: "memory");
    __builtin_amdgcn_s_barrier();
    asm volatile("" ::: "memory");
    if (t + 3 < ntl) AB_ISSUE(t + 3);
    const bool win_tile = WIN && (t < nt0);
    if (win_tile && (t < wlo || t >= wlo + 8)) continue;
    const LAS unsigned char* sk = lds + (t & 3) * 16384;
    const LAS unsigned char* sv = sk + 8192;
    f32x4 s[2][2][4];
#pragma unroll
    for (int sub = 0; sub < 2; ++sub) {
      bf16x8 kf[2][2];
#pragma unroll
      for (int mt = 0; mt < 2; ++mt)
#pragma unroll
        for (int ks = 0; ks < 2; ++ks) {
          const int key = sub * 32 + mt * 16 + fr;
          kf[mt][ks] = *(const LAS bf16x8*)(sk + key * 128 + (((ks * 4 + fq) ^ (key & 7)) << 4));
        }
#pragma unroll
      for (int mt = 0; mt < 2; ++mt)
#pragma unroll
        for (int nt = 0; nt < 4; ++nt) {
          s[sub][mt][nt] = zero4();
#pragma unroll
          for (int ks = 0; ks < 2; ++ks) s[sub][mt][nt] = MFMA16(kf[mt][ks], qf[nt][ks], s[sub][mt][nt]);
        }
    }
    if (win_tile) {
      const LAS float* brow = bias + (rdelta + (t - wlo)) * 31;
#pragma unroll
      for (int sub = 0; sub < 2; ++sub)
#pragma unroll
        for (int nt = 0; nt < 4; ++nt) {
          const int cq = nt * 16 + fr;
          const int cw = min(max(cq - 8, 0), 48);
#pragma unroll
          for (int mt = 0; mt < 2; ++mt)
#pragma unroll
            for (int j = 0; j < 4; ++j) {
              const int ck = sub * 32 + mt * 16 + fq * 4 + j;
              const bool valid = (ck >= cw) && (ck < cw + 16);
              const int dc = min(max(ck - cq, -15), 15) + 15;
              const float bv = brow[dc];
              s[sub][mt][nt][j] = valid ? (s[sub][mt][nt][j] + bv * 8.f) : -INFINITY;
            }
        }
    }
    float tmx[4];
    bool grow = false;
#pragma unroll
    for (int nt = 0; nt < 4; ++nt) {
      float tm = -INFINITY;
#pragma unroll
      for (int sub = 0; sub < 2; ++sub)
#pragma unroll
        for (int mt = 0; mt < 2; ++mt)
          tm = fmaxf(tm, fmaxf(fmaxf(s[sub][mt][nt][0], s[sub][mt][nt][1]), fmaxf(s[sub][mt][nt][2], s[sub][mt][nt][3])));
      tm = fmaxf(tm, __shfl_xor(tm, 16));
      tm = fmaxf(tm, __shfl_xor(tm, 32));
      tm *= SC;
      tmx[nt] = tm;
      grow = grow || (tm > m[nt] + 11.5f);
    }
    if (__any(grow)) {
#pragma unroll
      for (int nt = 0; nt < 4; ++nt) {
        const float mn = fmaxf(m[nt], tmx[nt]);
        const float alpha = __builtin_amdgcn_exp2f(m[nt] - mn);
        m[nt] = mn;
        lsum[nt] *= alpha;
#pragma unroll
        for (int dt = 0; dt < 4; ++dt) o[dt][nt] *= alpha;
      }
    }
#pragma unroll
    for (int sub = 0; sub < 2; ++sub) {
      bf16x8 pb[4];
#pragma unroll
      for (int nt = 0; nt < 4; ++nt) {
        const float nm = -m[nt];
        float ps = 0.f;
#pragma unroll
        for (int mt = 0; mt < 2; ++mt)
#pragma unroll
          for (int j = 0; j < 4; ++j) { float pv = __builtin_amdgcn_exp2f(__builtin_fmaf(s[sub][mt][nt][j], SC, nm)); s[sub][mt][nt][j] = pv; ps += pv; }
        lsum[nt] += ps;
        pb[nt] = pack8(s[sub][0][nt], s[sub][1][nt]);
      }
      bf16x8 va[4];
#pragma unroll
      for (int dt = 0; dt < 4; ++dt) {
        const int d = dt * 16 + fr, q1 = sub * 4 + (fq >> 1);
        const u32x2 a = *(const LAS u32x2*)(sv + d * 128 + ((q1 ^ (d & 7)) << 4) + (fq & 1) * 8);
        const u32x2 b = *(const LAS u32x2*)(sv + d * 128 + (((q1 + 2) ^ (d & 7)) << 4) + (fq & 1) * 8);
        u32x4 r4; r4.x = a.x; r4.y = a.y; r4.z = b.x; r4.w = b.y;
        va[dt] = __builtin_bit_cast(bf16x8, r4);
      }
#pragma unroll
      for (int dt = 0; dt < 4; ++dt)
#pragma unroll
        for (int nt = 0; nt < 4; ++nt) o[dt][nt] = MFMA16(va[dt], pb[nt], o[dt][nt]);
    }
  }
#undef AB_ISSUE
#pragma unroll
  for (int nt = 0; nt < 4; ++nt) {
    float lt = lsum[nt];
    lt += __shfl_xor(lt, 16);
    lt += __shfl_xor(lt, 32);
    const float inv = 1.f / lt;
#pragma unroll
    for (int dt = 0; dt < 4; ++dt) {
      uint2 w; w.x = pack2(o[dt][nt][0] * inv, o[dt][nt][1] * inv); w.y = pack2(o[dt][nt][2] * inv, o[dt][nt][3] * inv);
      *(uint2*)(O + (size_t)(nt * 16 + fr) * ldo + dt * 16 + fq * 4) = w;
    }
  }
}

DI float logsig(float x) { return fminf(x, 0.f) - __logf(1.f + __expf(-fabsf(x))); }

DI void mlstm_item(const P& p, int l, int u, char* smem, int tid, int stages, int cdbase, int ugrp) {
  const int wid = tid >> 6;
  const bool samp = u < 32;
  int b, h, NC, rowbase, ldT, cs0;
  size_t tb;
  if (samp) { b = u >> 2; h = u & 3; NC = 16; rowbase = TP + b * 1024; ldT = 1024; tb = 1048576 + (size_t)((b * 4 + h) * 64) * 1024; cs0 = u * 32; }
  else { int v = u - 32; b = v >> 2; h = v & 3; NC = 4; rowbase = b * 256; ldT = 256; tb = (size_t)((b * 4 + h) * 64) * 256; cs0 = 1024 + v * 8; }
  float* fl = (float*)smem + wid * 768;
  float* W = fl;
  float* U = fl + 64;
  float* MX = fl + 192;
  float* DEC = fl + 320;
  float* EN = fl + 448;
  float* NQ = fl + 576;

  if (stages & 1)
  for (int cd = cdbase + wid; cd < NC * 2 && cd < cdbase + 8; cd += 8) {
    int lane = tid & 63;
    asm volatile("" : "+v"(lane));
    const int fr = lane & 15, fq = lane >> 4;
    const int j = cd >> 1, dir = cd & 1;
    const int cs = cs0 + dir * NC + j;
    const int row = rowbase + j * 64 + lane;
    const float gi = p.gates()[(size_t)row * 16 + dir * 8 + h], gf = p.gates()[(size_t)row * 16 + dir * 8 + 4 + h];
    float bb = logsig(gf);
    if (dir == 0) {
#pragma unroll
      for (int off = 1; off < 64; off <<= 1) { float t = __shfl_up(bb, off); if (lane >= off) bb += t; }
    } else {
#pragma unroll
      for (int off = 1; off < 64; off <<= 1) { float t = __shfl_down(bb, off); if (lane + off < 64) bb += t; }
    }
    const float bend = __shfl(bb, dir ? 0 : 63);
    const float lw = bend - bb + gi;
    const float a = wave_max(lw);
    W[lane] = __expf(lw - a);
    wave_sync();
    f32x4 acc[4][4];
#pragma unroll
    for (int i = 0; i < 4; ++i)
#pragma unroll
      for (int jj = 0; jj < 4; ++jj) acc[i][jj] = zero4();
    const u16* vt = p.vt_ml() + tb + j * 64;
    const u16* kt = p.kt_ml() + tb + j * 64;
#pragma unroll 1
    for (int ks = 0; ks < 2; ++ks) {
      const float4 w0 = *(const float4*)(W + ks * 32 + fq * 8), w1 = *(const float4*)(W + ks * 32 + fq * 8 + 4);
      bf16x8 af[4], bfr[4];
#pragma unroll
      for (int mt = 0; mt < 4; ++mt) {
        bf16x8 raw = ld8(vt + (size_t)(mt * 16 + fr) * ldT + ks * 32 + fq * 8);
        f32x4 lo, hi;
        lo[0] = bf2f((u16)raw[0]) * w0.x; lo[1] = bf2f((u16)raw[1]) * w0.y; lo[2] = bf2f((u16)raw[2]) * w0.z; lo[3] = bf2f((u16)raw[3]) * w0.w;
        hi[0] = bf2f((u16)raw[4]) * w1.x; hi[1] = bf2f((u16)raw[5]) * w1.y; hi[2] = bf2f((u16)raw[6]) * w1.z; hi[3] = bf2f((u16)raw[7]) * w1.w;
        af[mt] = pack8(lo, hi);
      }
#pragma unroll
      for (int nt = 0; nt < 4; ++nt) bfr[nt] = ld8(kt + (size_t)(nt * 16 + fr) * ldT + ks * 32 + fq * 8);
#pragma unroll
      for (int mt = 0; mt < 4; ++mt)
#pragma unroll
        for (int nt = 0; nt < 4; ++nt) acc[mt][nt] = MFMA16(af[mt], bfr[nt], acc[mt][nt]);
    }
    float* ch = p.ml_chat() + (size_t)cs * 4096;
#pragma unroll
    for (int mt = 0; mt < 4; ++mt)
#pragma unroll
      for (int nt = 0; nt < 4; ++nt)
#pragma unroll
        for (int jj = 0; jj < 4; ++jj) ch[(mt * 16 + fq * 4 + jj) * 64 + nt * 16 + fr] = acc[mt][nt][jj];
    float nh = 0.f;
    const u16* kr = kt + (size_t)lane * ldT;
#pragma unroll 1
    for (int c8 = 0; c8 < 8; ++c8) {
      bf16x8 kk = ld8(kr + c8 * 8);
      const float4 wa = *(const float4*)(W + c8 * 8), wb = *(const float4*)(W + c8 * 8 + 4);
      nh += bf2f((u16)kk[0]) * wa.x + bf2f((u16)kk[1]) * wa.y + bf2f((u16)kk[2]) * wa.z + bf2f((u16)kk[3]) * wa.w;
      nh += bf2f((u16)kk[4]) * wb.x + bf2f((u16)kk[5]) * wb.y + bf2f((u16)kk[6]) * wb.z + bf2f((u16)kk[7]) * wb.w;
    }
    p.ml_nhat()[(size_t)cs * 64 + lane] = nh;
    if (lane == 0) { p.ml_ab()[cs * 2] = a; p.ml_ab()[cs * 2 + 1] = bend; }
    wave_sync();
  }
  __syncthreads();

  if (stages & 2) {
    const int dir = tid >> 8, tt = tid & 255, e0 = tt * 16;
    float C[16];
    float n = 0.f, m = 0.f;
    const int sidx = ((b * 4 + l) * 2 + dir) * 4 + h;
    if (samp) {
#pragma unroll
      for (int i = 0; i < 4; ++i) {
        float4 v = *(const float4*)(p.stC + (size_t)sidx * 4096 + e0 + i * 4);
        C[i * 4] = v.x; C[i * 4 + 1] = v.y; C[i * 4 + 2] = v.z; C[i * 4 + 3] = v.w;
      }
      if (tt < 64) n = p.stn[sidx * 64 + tt];
      m = p.stm[sidx];
    } else {
#pragma unroll
      for (int i = 0; i < 16; ++i) { float z = 0.f; asm volatile("" : "+v"(z)); C[i] = z; }
    }
    for (int c4 = 0; c4 < NC; c4 += 4) {
      float4 chv[4][4];
      float av[4], bev[4], nhv[4];
#pragma unroll
      for (int q = 0; q < 4; ++q) {
        const int c = c4 + q, j = dir ? NC - 1 - c : c, cs = cs0 + dir * NC + j;
        av[q] = p.ml_ab()[cs * 2]; bev[q] = p.ml_ab()[cs * 2 + 1];
        nhv[q] = tt < 64 ? p.ml_nhat()[(size_t)cs * 64 + tt] : 0.f;
        const float* ch = p.ml_chat() + (size_t)cs * 4096 + e0;
#pragma unroll
        for (int i = 0; i < 4; ++i) chv[q][i] = *(const float4*)(ch + i * 4);
      }
#pragma unroll
      for (int q = 0; q < 4; ++q) {
        const int c = c4 + q, j = dir ? NC - 1 - c : c, cs = cs0 + dir * NC + j;
        uint4 w0, w1;
        w0.x = pack2(C[0], C[1]); w0.y = pack2(C[2], C[3]); w0.z = pack2(C[4], C[5]); w0.w = pack2(C[6], C[7]);
        w1.x = pack2(C[8], C[9]); w1.y = pack2(C[10], C[11]); w1.z = pack2(C[12], C[13]); w1.w = pack2(C[14], C[15]);
        *(uint4*)(p.ml_cst() + (size_t)cs * 4096 + e0) = w0;
        *(uint4*)(p.ml_cst() + (size_t)cs * 4096 + e0 + 8) = w1;
        if (tt < 64) p.ml_nst()[(size_t)cs * 64 + tt] = n;
        if (tt == 0) p.ml_mst()[cs] = m;
        const float mn = fmaxf(bev[q] + m, av[q]);
        const float carry = __expf(bev[q] + m - mn), beta = __expf(av[q] - mn);
#pragma unroll
        for (int i = 0; i < 4; ++i) {
          C[i * 4] = carry * C[i * 4] + beta * chv[q][i].x; C[i * 4 + 1] = carry * C[i * 4 + 1] + beta * chv[q][i].y;
          C[i * 4 + 2] = carry * C[i * 4 + 2] + beta * chv[q][i].z; C[i * 4 + 3] = carry * C[i * 4 + 3] + beta * chv[q][i].w;
        }
        n = carry * n + beta * nhv[q];
        m = mn;
      }
    }
    if (!samp) {
      float* oc = p.out + O_C + (size_t)sidx * 4096 + e0;
#pragma unroll
      for (int i = 0; i < 4; ++i) { float4 v; v.x = C[i * 4]; v.y = C[i * 4 + 1]; v.z = C[i * 4 + 2]; v.w = C[i * 4 + 3]; *(float4*)(oc + i * 4) = v; }
      if (tt < 64) p.out[O_N + (size_t)sidx * 64 + tt] = n;
      if (tt == 0) p.out[O_M + sidx] = m;
    }
  }
  __syncthreads();

  if (stages & 4)
  for (int uu = ugrp * 8 + wid; uu < NC * 2 && uu < ugrp * 8 + 8; uu += 8) {
    const int j = uu >> 1, half0 = uu & 1;
    int lane = tid & 63;
    asm volatile("" : "+v"(lane));
    const int fr = lane & 15, fq = lane >> 4;
    const int row = rowbase + j * 64 + lane;
    for (int dir = 0; dir < 2; ++dir) {
      const int cs = cs0 + dir * NC + j;
      const float m0 = p.ml_mst()[cs];
      const float gi = p.gates()[(size_t)row * 16 + dir * 8 + h], gf = p.gates()[(size_t)row * 16 + dir * 8 + 4 + h];
      float bb = logsig(gf);
      if (dir == 0) {
#pragma unroll
        for (int off = 1; off < 64; off <<= 1) { float t = __shfl_up(bb, off); if (lane >= off) bb += t; }
      } else {
#pragma unroll
        for (int off = 1; off < 64; off <<= 1) { float t = __shfl_down(bb, off); if (lane + off < 64) bb += t; }
      }
      const float uu = gi - bb;
      float cm = uu;
      if (dir == 0) {
#pragma unroll
        for (int off = 1; off < 64; off <<= 1) { float t = __shfl_up(cm, off); if (lane >= off) cm = fmaxf(cm, t); }
      } else {
#pragma unroll
        for (int off = 1; off < 64; off <<= 1) { float t = __shfl_down(cm, off); if (lane + off < 64) cm = fmaxf(cm, t); }
      }
      const float M = fmaxf(cm, m0);
      U[dir * 64 + lane] = uu;
      MX[dir * 64 + lane] = M;
      DEC[dir * 64 + lane] = __expf(m0 - M);
      EN[dir * 64 + lane] = __expf(-(bb + M));
      const u16* qr = p.zb() + (size_t)row * ZW + 1536 + h * 64;
      const float* ns = p.ml_nst() + (size_t)cs * 64;
      float nq = 0.f;
#pragma unroll
      for (int c8 = 0; c8 < 8; ++c8) {
        bf16x8 qq = ld8(qr + c8 * 8);
#pragma unroll
        for (int jj = 0; jj < 8; ++jj) nq += bf2f((u16)qq[jj]) * ns[c8 * 8 + jj];
      }
      NQ[dir * 64 + lane] = nq;
    }
    wave_sync();
#pragma unroll 1
    for (int half = half0; half < half0 + 1; ++half) {
      int lane_h = lane;
      asm volatile("" : "+v"(lane_h));
      const int fr = lane_h & 15, fq = lane_h >> 4;
      bf16x8 qf[2][2];
#pragma unroll
      for (int nt = 0; nt < 2; ++nt)
#pragma unroll
        for (int ks = 0; ks < 2; ++ks)
          qf[nt][ks] = ld8(p.zb() + (size_t)(rowbase + j * 64 + half * 32 + nt * 16 + fr) * ZW + 1536 + h * 64 + ks * 32 + fq * 8);
      f32x4 hs[4][2];
#pragma unroll
      for (int i = 0; i < 4; ++i) { hs[i][0] = zero4(); hs[i][1] = zero4(); }
#pragma unroll 1
      for (int dir = 0; dir < 2; ++dir) {
        const int cs = cs0 + dir * NC + j;
        f32x4 acc[4][2];
#pragma unroll
        for (int i = 0; i < 4; ++i) { acc[i][0] = zero4(); acc[i][1] = zero4(); }
        const u16* cst = p.ml_cst() + (size_t)cs * 4096;
#pragma unroll
        for (int ks = 0; ks < 2; ++ks)
#pragma unroll
          for (int dt = 0; dt < 4; ++dt) {
            bf16x8 cf = ld8(cst + (dt * 16 + fr) * 64 + ks * 32 + fq * 8);
#pragma unroll
            for (int nt = 0; nt < 2; ++nt) acc[dt][nt] = MFMA16(cf, qf[nt][ks], acc[dt][nt]);
          }
        float dec[2], Mt[2], dsum[2];
#pragma unroll
        for (int nt = 0; nt < 2; ++nt) {
          const int t = half * 32 + nt * 16 + fr;
          dec[nt] = DEC[dir * 64 + t]; Mt[nt] = MX[dir * 64 + t]; dsum[nt] = 0.f;
#pragma unroll
          for (int dt = 0; dt < 4; ++dt) acc[dt][nt] *= dec[nt];
        }
#pragma unroll 1
        for (int sk = 0; sk < 2; ++sk) {
          bf16x8 kf[2][2];
#pragma unroll
          for (int mt = 0; mt < 2; ++mt)
#pragma unroll
            for (int ks = 0; ks < 2; ++ks)
              kf[mt][ks] = ld8(p.zb() + (size_t)(rowbase + j * 64 + sk * 32 + mt * 16 + fr) * ZW + 1792 + h * 64 + ks * 32 + fq * 8);
          f32x4 s[2][2];
#pragma unroll
          for (int mt = 0; mt < 2; ++mt)
#pragma unroll
            for (int nt = 0; nt < 2; ++nt) {
              s[mt][nt] = zero4();
#pragma unroll
              for (int ks = 0; ks < 2; ++ks) s[mt][nt] = MFMA16(kf[mt][ks], qf[nt][ks], s[mt][nt]);
            }
#pragma unroll
          for (int mt = 0; mt < 2; ++mt) {
            const float4 u4 = *(const float4*)(U + dir * 64 + sk * 32 + mt * 16 + fq * 4);
            const float uv[4] = {u4.x, u4.y, u4.z, u4.w};
#pragma unroll
            for (int jj = 0; jj < 4; ++jj) {
              const int stok = sk * 32 + mt * 16 + fq * 4 + jj;
#pragma unroll
              for (int nt = 0; nt < 2; ++nt) {
                const int t = half * 32 + nt * 16 + fr;
                const bool valid = dir ? (stok >= t) : (stok <= t);
                const float w = valid ? __expf(uv[jj] - Mt[nt]) : 0.f;
                const float pv = s[mt][nt][jj] * w;
                s[mt][nt][jj] = pv;
                dsum[nt] += pv;
              }
            }
          }
          bf16x8 pb[2];
#pragma unroll
          for (int nt = 0; nt < 2; ++nt) pb[nt] = pack8(s[0][nt], s[1][nt]);
#pragma unroll
          for (int dt = 0; dt < 4; ++dt) {
            const u16* vp = p.vt_ml() + tb + (size_t)(dt * 16 + fr) * ldT + j * 64 + sk * 32 + fq * 4;
            bf16x8 va = ld4x2(vp, vp + 16);
#pragma unroll
            for (int nt = 0; nt < 2; ++nt) acc[dt][nt] = MFMA16(va, pb[nt], acc[dt][nt]);
          }
        }
#pragma unroll
        for (int nt = 0; nt < 2; ++nt) {
          const int t = half * 32 + nt * 16 + fr;
          float ds = dsum[nt];
          ds += __shfl_xor(ds, 16);
          ds += __shfl_xor(ds, 32);
          const float den = ds + dec[nt] * NQ[dir * 64 + t];
          const float dv = 1.f / fmaxf(fabsf(den), EN[dir * 64 + t]);
#pragma unroll
          for (int dt = 0; dt < 4; ++dt) hs[dt][nt] += acc[dt][nt] * dv;
        }
      }
#pragma unroll
      for (int nt = 0; nt < 2; ++nt) {
        float ss = 0.f;
#pragma unroll
        for (int dt = 0; dt < 4; ++dt)
#pragma unroll
          for (int jj = 0; jj < 4; ++jj) ss += hs[dt][nt][jj] * hs[dt][nt][jj];
        ss += __shfl_xor(ss, 16);
        ss += __shfl_xor(ss, 32);
        const float rs = rsqrtf(ss * (1.f / 64.f) + EPS);
        const int orow = rowbase + j * 64 + half * 32 + nt * 16 + fr;
#pragma unroll
        for (int dt = 0; dt < 4; ++dt) {
          const int v0 = dt * 16 + fq * 4;
          const float4 gn = *(const float4*)(p.g_ml + l * 256 + h * 64 + v0);
          const uint2 mo = *(const uint2*)(p.zb() + (size_t)orow * ZW + 2304 + h * 64 + v0);
          const float o0 = bf2f((u16)(mo.x & 0xffff)), o1 = bf2f((u16)(mo.x >> 16)), o2 = bf2f((u16)(mo.y & 0xffff)), o3 = bf2f((u16)(mo.y >> 16));
          const float r0 = hs[dt][nt][0] * rs * gn.x / (1.f + __expf(-o0));
          const float r1 = hs[dt][nt][1] * rs * gn.y / (1.f + __expf(-o1));
          const float r2 = hs[dt][nt][2] * rs * gn.z / (1.f + __expf(-o2));
          const float r3 = hs[dt][nt][3] * rs * gn.w / (1.f + __expf(-o3));
          uint2 w; w.x = pack2(r0, r1); w.y = pack2(r2, r3);
          *(uint2*)(p.mix() + (size_t)orow * 1024 + 768 + h * 64 + v0) = w;
        }
      }
    }
    wave_sync();
  }
  __syncthreads();
}

#define QCTR_BASE XCD_BAR_WORDS
#define BAR_TOTAL_WORDS (XCD_BAR_WORDS + 4 * 64)
DI void phase_mix(const P& p, int l, char* smem, int tid0) {
  volatile LAS int* sit = (volatile LAS int*)((LAS char*)smem + STAGE_LDS + 64);
  for (;;) {
    __syncthreads();
    if (tid0 == 0) *sit = (int)atomicAdd(&p.bar()[QCTR_BASE + l * 64], 1u);
    __syncthreads();
    const int it = *sit;
    if (it >= 480) break;
    int tv = tid0;
    asm volatile("" : "+v"(tv));
    const int wid = tv >> 6, lane = tv & 63;
    if (it >= 192 && it < 320) {
      mlstm_item(p, l, (it - 192) >> 2, smem, tv, 6, 0, (it - 192) & 3);
    } else if (it < 128) {
      const int x = it, b = x >> 4, kvh = (x >> 3) & 1, qt = (x & 7) * 2 + (wid >> 2), head = kvh * 4 + (wid & 3);
      const int rowbase = TP + b * 1024;
      const int ci = (b * 4 + l) * 2 + kvh;
      attn_block<false>((LAS unsigned char*)smem, tv, p.zb() + (size_t)(rowbase + qt * 64) * ZW + 768 + head * 64, ZW,
                        p.zb() + (size_t)rowbase * ZW + 1280 + kvh * 64, ZW, p.vt_gqa() + 524288 + (size_t)((b * 2 + kvh) * 64) * 1024, 1024, 16,
                        p.kc_gqa() + (size_t)ci * 16384, 64, p.vct_gqa() + (size_t)ci * 16384, 256, 4,
                        p.mix() + (size_t)(rowbase + qt * 64) * 1024 + 256 + head * 64, 1024, nullptr, 0, 0);
    } else if (it < 192) {
      const int x = it - 128, b = x >> 3, h = (x >> 1) & 3, rg = x & 1, r = rg * 8 + wid;
      const int rowbase = TP + b * 1024;
      const int r0 = min(max(r - 4, 0), 8);
      const int ulo = rg ? 4 : 0, nt0 = rg ? 12 : 11;
      const int ci = (b * 4 + l) * 4 + h;
      LAS float* btab = (LAS float*)((LAS char*)smem + 65536);
      for (int i = tv; i < 15 * 31; i += NTHR) btab[i] = p.na_bias[(size_t)(l * 4 + h) * 15 * 31 + i];
      __syncthreads();
      attn_block<true>((LAS unsigned char*)smem, tv, p.zb() + (size_t)(rowbase + r * 64) * ZW + h * 64, ZW,
                       p.zb() + (size_t)(rowbase + ulo * 64) * ZW + 256 + h * 64, ZW, p.vt_na() + 1048576 + (size_t)((b * 4 + h) * 64) * 1024 + ulo * 64, 1024, nt0,
                       p.kc_na() + (size_t)ci * 16384, 64, p.vct_na() + (size_t)ci * 16384, 256, 4,
                       p.mix() + (size_t)(rowbase + r * 64) * 1024 + h * 64, 1024, btab, r0 - r + 7, r0 - ulo);
    } else if (it < 384) {
      mlstm_item(p, l, 32 + (it - 320), smem, tv, 6, 0, 0);
    } else if (it < 448) {
      const int x = it - 384, b = x >> 2, kvh = (x >> 1) & 1, qt = (x & 1) * 2 + (wid >> 2), head = kvh * 4 + (wid & 3);
      const int rowbase = b * 256;
      attn_block<false>((LAS unsigned char*)smem, tv, p.zb() + (size_t)(rowbase + qt * 64) * ZW + 768 + head * 64, ZW,
                        p.zb() + (size_t)rowbase * ZW + 1280 + kvh * 64, ZW, p.vt_gqa() + (size_t)((b * 2 + kvh) * 64) * 256, 256, 4,
                        nullptr, 0, nullptr, 0, 0,
                        p.mix() + (size_t)(rowbase + qt * 64) * 1024 + 256 + head * 64, 1024, nullptr, 0, 0);
    } else {
      const int x = it - 448, b = x >> 1, h = (x & 1) * 2 + (wid >> 2), qt = wid & 3;
      const int rowbase = b * 256;
      attn_wave<false>(p.zb() + (size_t)(rowbase + qt * 64) * ZW + h * 64, ZW,
                       p.zb() + (size_t)rowbase * ZW + 256 + h * 64, ZW, p.vt_na() + (size_t)((b * 4 + h) * 64) * 256, 256, 256,
                       nullptr, 0, nullptr, 0, 0,
                       p.mix() + (size_t)(rowbase + qt * 64) * 1024 + h * 64, 1024, nullptr, 0, lane);
    }
  }
}

DI void phase_ml1(const P& p, int l, char* smem, int tid0) {
  for (int bi = blockIdx.x; bi < 192; bi += p.nblk) {
    int tv = tid0;
    asm volatile("" : "+v"(tv));
    if (bi < 128) mlstm_item(p, l, bi >> 2, smem, tv, 1, (bi & 3) * 8, 0);
    else mlstm_item(p, l, 32 + (bi - 128), smem, tv, 1, 0, 0);
  }
}

DI void run_phase(const P& p, int ph, int l, char* smem) {
  int tid = threadIdx.x;
  asm volatile("" : "+v"(tid));
  switch (ph) {
    case 0: phase_init(p, smem, tid); break;
    case 1: phase_row(p, 0, 0, smem, tid); break;
    case 2: phase_gemm(p, 0, l, smem); break;
    case 3: phase_ml1(p, l, smem, tid); break;
    case 4: phase_mix(p, l, smem, tid); break;
    case 5: phase_gemm(p, 1, l, smem); break;
    case 6: phase_row(p, 1, l, smem, tid); break;
    case 7: phase_gemm(p, 2, l, smem); break;
    case 8: phase_gemm(p, 3, l, smem); break;
    default: phase_row(p, 2, l, smem, tid); break;
  }
}

#if !ONE_LAUNCH
__global__ void __launch_bounds__(512, 2) k_phase(P p, int ph, int l) {
  extern __shared__ __attribute__((aligned(16))) char smem[];
  run_phase(p, ph, l, smem);
}
#else
__global__ void __launch_bounds__(512, 2) k_mega(P p) {
  extern __shared__ __attribute__((aligned(16))) char smem[];
  uint4* xbw = (uint4*)(smem + STAGE_LDS);
  if (threadIdx.x == 0) *xbw = make_uint4(0u, 0u, 0u, 0u);
  __syncthreads();
  XcdBarrier xb = xcd_barrier_post(p.bar(), (volatile LAS unsigned*)xbw, (unsigned)p.nblk);
#if TPROBE
  unsigned long long* ts = (unsigned long long*)(p.bar() + BAR_TOTAL_WORDS);
  const bool rec = blockIdx.x == 0 && threadIdx.x == 0;
  if (rec) ts[0] = __builtin_amdgcn_s_memrealtime();
#endif
  run_phase(p, 0, 0, smem);
  xcd_barrier(xb);
#if TPROBE
  if (rec) ts[1] = __builtin_amdgcn_s_memrealtime();
#endif
  run_phase(p, 1, 0, smem);
#if TPROBE
#define TSREC(ph) if (rec) ts[2 + l * 8 + ((ph) - 2)] = __builtin_amdgcn_s_memrealtime();
#else
#define TSREC(ph)
#endif
#pragma unroll 1
  for (int l = 0; l < 4; ++l) {
    xcd_barrier(xb); TSREC(2) run_phase(p, 2, l, smem);
    xcd_barrier(xb); TSREC(3) run_phase(p, 3, l, smem);
    xcd_barrier(xb); TSREC(4) run_phase(p, 4, l, smem);
    xcd_barrier(xb); TSREC(5) run_phase(p, 5, l, smem);
    xcd_barrier(xb); TSREC(6) run_phase(p, 6, l, smem);
    xcd_barrier(xb); TSREC(7) run_phase(p, 7, l, smem);
    xcd_barrier(xb); TSREC(8) run_phase(p, 8, l, smem);
    xcd_barrier(xb); TSREC(9) run_phase(p, 9, l, smem);
  }
#if TPROBE
  xcd_barrier(xb);
  if (rec) {
    ts[34] = __builtin_amdgcn_s_memrealtime();
    unsigned long long sum = 0;
    for (int i = 0; i < 34; ++i) {
      int ph = i < 2 ? i : 2 + (i - 2) % 8;
      if ((TPROBE >> ph) & 1) sum += ts[i + 1] - ts[i];
    }
    p.out[0] += TQ * floorf((float)sum * 0.01f * (1.f / TQ));
  }
#endif
}
#endif

extern "C" void kernel_launch(void* const* d_in, const int* in_sizes, int n_in, void* d_out, int out_size, void* d_ws,
                              size_t ws_size, hipStream_t stream) {
  P p{};
  p.x_prompt = (const float*)d_in[0]; p.x_sample = (const float*)d_in[1]; p.cache_na = (const float*)d_in[2];
  p.cache_gqa = (const float*)d_in[3]; p.stC = (const float*)d_in[4]; p.stn = (const float*)d_in[5]; p.stm = (const float*)d_in[6];
  p.c = (const float*)d_in[7]; p.c_ctx = (const float*)d_in[8]; p.w_in = (const float*)d_in[9]; p.b_gates = (const float*)d_in[10];
  p.w_out = (const float*)d_in[11]; p.g_norm = (const float*)d_in[12]; p.g_qk = (const float*)d_in[13]; p.g_ml = (const float*)d_in[14];
  p.na_bias = (const float*)d_in[15]; p.w_ada = (const float*)d_in[16]; p.b_ada = (const float*)d_in[17]; p.w_gu = (const float*)d_in[18];
  p.w_down = (const float*)d_in[19];
  p.out = (float*)d_out;
  p.ws = (char*)d_ws;
  if (WS_TOTAL_X > ws_size) { fprintf(stderr, "workspace too small: need %zu have %zu\n", (size_t)WS_TOTAL, ws_size); return; }

  static int grid_blocks = 0;
  if (!grid_blocks) {
    int dev = 0, cus = 0, per_cu = 0;
    (void)hipGetDevice(&dev);
    (void)hipDeviceGetAttribute(&cus, hipDeviceAttributeMultiprocessorCount, dev);
#if ONE_LAUNCH
    (void)hipFuncSetAttribute((const void*)k_mega, hipFuncAttributeMaxDynamicSharedMemorySize, DYN_LDS);
    (void)hipOccupancyMaxActiveBlocksPerMultiprocessor(&per_cu, k_mega, NTHR, DYN_LDS);
#else
    (void)hipFuncSetAttribute((const void*)k_phase, hipFuncAttributeMaxDynamicSharedMemorySize, DYN_LDS);
    (void)hipOccupancyMaxActiveBlocksPerMultiprocessor(&per_cu, k_phase, NTHR, DYN_LDS);
#endif
    if (per_cu < 1) { fprintf(stderr, "occupancy query returned %d\n", per_cu); per_cu = 1; }
    if (per_cu > 1) per_cu = 1;
    grid_blocks = cus * per_cu;
  }
  p.nblk = grid_blocks;
  (void)hipMemsetAsync(p.bar(), 0, (size_t)BAR_TOTAL_WORDS * 4, stream);
#if ONE_LAUNCH
  void* args[] = {&p};
  hipError_t e = hipLaunchCooperativeKernel((void*)k_mega, dim3(grid_blocks), dim3(NTHR), args, DYN_LDS, stream);
  if (e != hipSuccess) fprintf(stderr, "cooperative launch failed: %s (grid %d)\n", hipGetErrorString(e), grid_blocks);
#else
  k_phase<<<grid_blocks, NTHR, DYN_LDS, stream>>>(p, 0, 0);
  k_phase<<<grid_blocks, NTHR, DYN_LDS, stream>>>(p, 1, 0);
  for (int l = 0; l < 4; ++l)
    for (int ph = 2; ph <= 9; ++ph) k_phase<<<grid_blocks, NTHR, DYN_LDS, stream>>>(p, ph, l);
#endif
}
```
